# Optimizing an MI355X kernel written in HIP

```python
import math
import jax
import jax.numpy as jnp
from jax import lax
import numpy as np

D_MODEL = 2048
BATCH = 1
SEQ = 8192
DEPTH = 2

GRID_W = 64
CTX_LEN = 256
HEAD_DIM = 128
GLA_HEADS = 4
GLA_DK = 64
GLA_DV = 128
GLA_GATE_RANK = 16
GLA_TAU = 16.0
GLA_CHUNK = 64
GQA_HEADS = 8
GQA_KV_HEADS = 2
DIFF_HEADS = 4
DIFF_DQK = 64
DIFF_DV = 128
MIX_WIDTH = GLA_HEADS * GLA_DV + GQA_HEADS * HEAD_DIM + DIFF_HEADS * DIFF_DV
N_EXPERTS = 64
TOP_K = 8
EXPERT_HIDDEN = 512
SHARED_HIDDEN = 512
ROUTE_SCALE = 2.5
Q_BLOCK = 128
ROPE_THETA = 10000.0
NORM_EPS = 1e-6
IN_SIZES = (GLA_HEADS * GLA_DK, GLA_HEADS * GLA_DK, GLA_HEADS * GLA_DV, GLA_HEADS * GLA_DV,
            GLA_GATE_RANK, GLA_GATE_RANK,
            GQA_HEADS * HEAD_DIM, GQA_KV_HEADS * HEAD_DIM, GQA_KV_HEADS * HEAD_DIM,
            DIFF_HEADS * 2 * DIFF_DQK, DIFF_HEADS * 2 * DIFF_DQK, DIFF_HEADS * DIFF_DV)
IN_WIDTH = sum(IN_SIZES)

kernel_name = 'hybrid_gla_gqa_diffattn_moe_dit'


def rms_norm(x, g):
    xf = x.astype(jnp.float32)
    y = xf * lax.rsqrt(jnp.mean(xf * xf, axis=-1, keepdims=True) + NORM_EPS)
    return (y * g.astype(jnp.float32)).astype(x.dtype)


def modulate(x, g, shift, scale):
    return rms_norm(x, g) * (1.0 + scale) + shift


def to_heads(z, n_heads, head_dim):
    b, t, _ = z.shape
    return z.reshape(b, t, n_heads, head_dim).transpose(0, 2, 1, 3)


def merge_heads(o):
    b, n, t, d = o.shape
    return o.transpose(0, 2, 1, 3).reshape(b, t, n * d)


def split_input_columns(z):
    points = np.cumsum(IN_SIZES)[:-1].tolist()
    return jnp.split(z, points, axis=-1)


def axial_rope_tables(row, col, dim):
    half = dim // 2
    inv_freq = ROPE_THETA ** (-jnp.arange(0, half, 2, dtype=jnp.float32) / half)
    ang_r = row.astype(jnp.float32)[:, None] * inv_freq
    ang_c = col.astype(jnp.float32)[:, None] * inv_freq
    return (jnp.cos(ang_r), jnp.sin(ang_r), jnp.cos(ang_c), jnp.sin(ang_c))


def rope_1d(x, cos, sin):
    x1, x2 = jnp.split(x, 2, axis=-1)
    return jnp.concatenate([x1 * cos - x2 * sin, x2 * cos + x1 * sin], axis=-1)


def apply_axial_rope(x, tables):
    cos_r, sin_r, cos_c, sin_c = tables
    x_row, x_col = jnp.split(x.astype(jnp.float32), 2, axis=-1)
    y = jnp.concatenate([rope_1d(x_row, cos_r, sin_r), rope_1d(x_col, cos_c, sin_c)], axis=-1)
    return y.astype(x.dtype)


def sweep_query_blocks(fn, qs):
    t = qs[0].shape[-2]
    nb = t // Q_BLOCK
    blocks = tuple(jnp.moveaxis(q.reshape(q.shape[:-2] + (nb, Q_BLOCK, q.shape[-1])), -3, 0) for q in qs)
    o = lax.map(lambda blk: fn(*blk), blocks)
    o = jnp.moveaxis(o, 0, -3)
    return o.reshape(o.shape[:-3] + (t, o.shape[-1]))


def gqa_attention(q, k, v):
    b, h, tq, d = q.shape
    kv = k.shape[1]
    qg = q.reshape(b, kv, h // kv, tq, d)
    scale = d ** -0.5

    def block(qb):
        s = jnp.einsum('bkgqd,bksd->bkgqs', qb, k, preferred_element_type=jnp.float32) * scale
        p = jax.nn.softmax(s, axis=-1).astype(v.dtype)
        return jnp.einsum('bkgqs,bksd->bkgqd', p, v)

    return sweep_query_blocks(block, (qg,)).reshape(b, h, tq, d)


def diff_attention(q1, q2, k1, k2, v, lam):
    scale = q1.shape[-1] ** -0.5

    def block(a1, a2):
        p1 = jax.nn.softmax(jnp.einsum('bhqd,bhsd->bhqs', a1, k1, preferred_element_type=jnp.float32) * scale, axis=-1)
        p2 = jax.nn.softmax(jnp.einsum('bhqd,bhsd->bhqs', a2, k2, preferred_element_type=jnp.float32) * scale, axis=-1)
        w = (p1 - lam * p2).astype(v.dtype)
        return jnp.einsum('bhqs,bhsd->bhqd', w, v)

    return sweep_query_blocks(block, (q1, q2))


def gla_chunked(q, k, v, log_a, s0):
    b, h, t, dk = q.shape
    dv = v.shape[-1]
    n = t // GLA_CHUNK
    f32 = jnp.float32
    q, k, log_a = (a.astype(f32).reshape(b, h, n, GLA_CHUNK, dk) for a in (q, k, log_a))
    v = v.astype(f32).reshape(b, h, n, GLA_CHUNK, dv)
    cum = jnp.cumsum(log_a, axis=3)
    cum_last = cum[:, :, :, -1:, :]
    q_dec = q * jnp.exp(cum)
    k_inv = k * jnp.exp(-cum)
    k_end = k * jnp.exp(cum_last - cum)
    mask = jnp.tril(jnp.ones((GLA_CHUNK, GLA_CHUNK), f32))
    a_intra = jnp.einsum('bhncd,bhnsd->bhncs', q_dec, k_inv) * mask
    o_intra = jnp.einsum('bhncs,bhnsv->bhncv', a_intra, v)
    u = jnp.einsum('bhncd,bhncv->bhndv', k_end, v)
    g = jnp.exp(cum_last[:, :, :, 0, :])

    def step(s, inp):
        g_n, u_n = inp
        return g_n[..., None] * s + u_n, s

    s_fin, s_in = lax.scan(step, s0, (jnp.moveaxis(g, 2, 0), jnp.moveaxis(u, 2, 0)))
    s_in = jnp.moveaxis(s_in, 0, 2)
    o_inter = jnp.einsum('bhncd,bhndv->bhncv', q_dec, s_in)
    return (o_intra + o_inter).reshape(b, h, t, dv), s_fin


def gla_bidirectional(q, k, v, la_f, la_b, s0_f, s0_b):
    o_f, s_f = gla_chunked(q, k, v, la_f, s0_f)
    flip = lambda a: jnp.flip(a, axis=2)
    o_b, s_b = gla_chunked(flip(q), flip(k), flip(v), flip(la_b), s0_b)
    return o_f + flip(o_b), s_f, s_b


def token_mixers(hc, hx, w_in, gla_wa_f, gla_ba_f, gla_wa_b, gla_ba_b, gla_norm_g,
                 q_norm_g, k_norm_g, lq1, lk1, lq2, lk2, diff_norm_g, w_out,
                 lam_init, rope_gqa, rope_diff, need_ctx):
    zc = split_input_columns(hc @ w_in)
    zx = split_input_columns(hx @ w_in)

    def gla_inputs(z):
        q = to_heads(z[0], GLA_HEADS, GLA_DK) * (GLA_DK ** -0.5)
        k = to_heads(z[1], GLA_HEADS, GLA_DK)
        v = to_heads(z[2], GLA_HEADS, GLA_DV)
        la_f = jax.nn.log_sigmoid((z[4] @ gla_wa_f + gla_ba_f).astype(jnp.float32)) / GLA_TAU
        la_b = jax.nn.log_sigmoid((z[5] @ gla_wa_b + gla_ba_b).astype(jnp.float32)) / GLA_TAU
        return q, k, v, to_heads(la_f, GLA_HEADS, GLA_DK), to_heads(la_b, GLA_HEADS, GLA_DK)

    def gla_output(o, z):
        o = rms_norm(o, gla_norm_g).astype(z[3].dtype)
        return merge_heads(o) * jax.nn.silu(z[3])

    s0 = jnp.zeros((hx.shape[0], GLA_HEADS, GLA_DK, GLA_DV), jnp.float32)
    oc_gla, s_f, s_b = gla_bidirectional(*gla_inputs(zc), s0, s0)
    ox_gla, _, _ = gla_bidirectional(*gla_inputs(zx), s_f, s_b)

    def gqa_inputs(z):
        q = rms_norm(to_heads(z[6], GQA_HEADS, HEAD_DIM), q_norm_g)
        k = rms_norm(to_heads(z[7], GQA_KV_HEADS, HEAD_DIM), k_norm_g)
        v = to_heads(z[8], GQA_KV_HEADS, HEAD_DIM)
        return q, k, v

    qc, kc, vc = gqa_inputs(zc)
    qx, kx, vx = gqa_inputs(zx)
    qx = apply_axial_rope(qx, rope_gqa)
    kx = apply_axial_rope(kx, rope_gqa)
    ox_gqa = gqa_attention(qx, jnp.concatenate([kc, kx], axis=2), jnp.concatenate([vc, vx], axis=2))

    lam = (jnp.exp(jnp.sum(lq1.astype(jnp.float32) * lk1.astype(jnp.float32)))
           - jnp.exp(jnp.sum(lq2.astype(jnp.float32) * lk2.astype(jnp.float32))) + lam_init)

    def diff_inputs(z):
        q1, q2 = jnp.split(to_heads(z[9], DIFF_HEADS, 2 * DIFF_DQK), 2, axis=-1)
        k1, k2 = jnp.split(to_heads(z[10], DIFF_HEADS, 2 * DIFF_DQK), 2, axis=-1)
        v = to_heads(z[11], DIFF_HEADS, DIFF_DV)
        return q1, q2, k1, k2, v

    def diff_output(o):
        return merge_heads(rms_norm(o, diff_norm_g) * (1.0 - lam_init))

    q1c, q2c, k1c, k2c, vdc = diff_inputs(zc)
    q1x, q2x, k1x, k2x, vdx = diff_inputs(zx)
    q1x, q2x, k1x, k2x = (apply_axial_rope(a, rope_diff) for a in (q1x, q2x, k1x, k2x))
    ox_diff = diff_attention(q1x, q2x, jnp.concatenate([k1c, k1x], axis=2),
                             jnp.concatenate([k2c, k2x], axis=2),
                             jnp.concatenate([vdc, vdx], axis=2), lam)

    ox = jnp.concatenate([gla_output(ox_gla, zx), merge_heads(ox_gqa), diff_output(ox_diff)], axis=-1) @ w_out
    if not need_ctx:
        return None, ox
    oc_gqa = gqa_attention(qc, kc, vc)
    oc_diff = diff_attention(q1c, q2c, k1c, k2c, vdc, lam)
    oc = jnp.concatenate([gla_output(oc_gla, zc), merge_heads(oc_gqa), diff_output(oc_diff)], axis=-1) @ w_out
    return oc, ox


def moe_ffn(h, router_w, router_b, w_gate, w_up, w_down, sh_gate, sh_up, sh_down):
    shape = h.shape
    t = h.reshape(-1, shape[-1])
    scores = jax.nn.sigmoid(jnp.dot(t, router_w, preferred_element_type=jnp.float32))
    _, idx = lax.top_k(scores + router_b.astype(jnp.float32), TOP_K)
    sel = jnp.take_along_axis(scores, idx, axis=-1)
    weights = sel / jnp.sum(sel, axis=-1, keepdims=True) * ROUTE_SCALE
    gates = jnp.einsum('nk,nke->en', weights, jax.nn.one_hot(idx, N_EXPERTS, dtype=jnp.float32))

    def expert(acc, p):
        wg, wu, wd, g = p
        y = (jax.nn.silu(t @ wg) * (t @ wu)) @ wd
        return acc + g[:, None] * y, None

    routed, _ = lax.scan(expert, jnp.zeros(t.shape, jnp.float32), (w_gate, w_up, w_down, gates))
    shared = (jax.nn.silu(t @ sh_gate) * (t @ sh_up)) @ sh_down
    return (routed + shared).astype(h.dtype).reshape(shape)


def setup_inputs(seed: int = 0) -> dict:
    key = jax.random.key(seed)
    ks = iter(jax.random.split(key, 32))
    f32 = jnp.float32
    d = D_MODEL

    def nrm(shape, scale):
        return jax.random.normal(next(ks), shape, f32) * scale

    def gain(shape):
        return 1.0 + nrm(shape, 0.02)

    return {
        'x': nrm((BATCH, SEQ, d), 1.0),
        'c': nrm((BATCH, d), 1.0),
        'ctx': nrm((BATCH, CTX_LEN, d), 1.0),
        'c_ctx': nrm((d,), 1.0),
        'norm1_g': gain((DEPTH, d)),
        'norm2_g': gain((DEPTH, d)),
        'w_mod': nrm((DEPTH, d, 6 * d), 0.5 * d ** -0.5),
        'b_mod': nrm((DEPTH, 6 * d), 0.02),
        'w_in': nrm((DEPTH, d, IN_WIDTH), d ** -0.5),
        'gla_wa_f': nrm((DEPTH, GLA_GATE_RANK, GLA_HEADS * GLA_DK), GLA_GATE_RANK ** -0.5),
        'gla_ba_f': nrm((DEPTH, GLA_HEADS * GLA_DK), 0.1),
        'gla_wa_b': nrm((DEPTH, GLA_GATE_RANK, GLA_HEADS * GLA_DK), GLA_GATE_RANK ** -0.5),
        'gla_ba_b': nrm((DEPTH, GLA_HEADS * GLA_DK), 0.1),
        'gla_norm_g': gain((DEPTH, GLA_DV)),
        'q_norm_g': gain((DEPTH, HEAD_DIM)),
        'k_norm_g': gain((DEPTH, HEAD_DIM)),
        'diff_lq1': nrm((DEPTH, DIFF_DQK), 0.1),
        'diff_lk1': nrm((DEPTH, DIFF_DQK), 0.1),
        'diff_lq2': nrm((DEPTH, DIFF_DQK), 0.1),
        'diff_lk2': nrm((DEPTH, DIFF_DQK), 0.1),
        'diff_norm_g': gain((DEPTH, DIFF_DV)),
        'w_out': nrm((DEPTH, MIX_WIDTH, d), MIX_WIDTH ** -0.5),
        'router_w': nrm((DEPTH, d, N_EXPERTS), d ** -0.5),
        'router_b': nrm((DEPTH, N_EXPERTS), 0.01),
        'exp_w_gate': nrm((DEPTH, N_EXPERTS, d, EXPERT_HIDDEN), d ** -0.5),
        'exp_w_up': nrm((DEPTH, N_EXPERTS, d, EXPERT_HIDDEN), d ** -0.5),
        'exp_w_down': nrm((DEPTH, N_EXPERTS, EXPERT_HIDDEN, d), EXPERT_HIDDEN ** -0.5),
        'sh_w_gate': nrm((DEPTH, d, SHARED_HIDDEN), d ** -0.5),
        'sh_w_up': nrm((DEPTH, d, SHARED_HIDDEN), d ** -0.5),
        'sh_w_down': nrm((DEPTH, SHARED_HIDDEN, d), SHARED_HIDDEN ** -0.5),
        'final_g': gain((d,)),
    }


def reference(x, c, ctx, c_ctx, norm1_g, norm2_g, w_mod, b_mod, w_in,
              gla_wa_f, gla_ba_f, gla_wa_b, gla_ba_b, gla_norm_g, q_norm_g, k_norm_g,
              diff_lq1, diff_lk1, diff_lq2, diff_lk2, diff_norm_g, w_out,
              router_w, router_b, exp_w_gate, exp_w_up, exp_w_down,
              sh_w_gate, sh_w_up, sh_w_down, final_g):
    n_tokens = x.shape[1]
    ROWS = n_tokens // GRID_W
    row = jnp.repeat(jnp.arange(ROWS, dtype=jnp.int32), GRID_W)
    col = jnp.tile(jnp.arange(GRID_W, dtype=jnp.int32), ROWS)
    rope_gqa = axial_rope_tables(row, col, HEAD_DIM)
    rope_diff = axial_rope_tables(row, col, DIFF_DQK)

    h = ctx
    for l in range(DEPTH):
        need_ctx = l < DEPTH - 1
        lam_init = 0.8 - 0.6 * math.exp(-0.3 * l)
        mod_x = (jax.nn.silu(c) @ w_mod[l] + b_mod[l])[:, None, :]
        mod_c = jax.nn.silu(c_ctx) @ w_mod[l] + b_mod[l]
        shx1, scx1, gx1, shx2, scx2, gx2 = jnp.split(mod_x, 6, axis=-1)
        shc1, scc1, gc1, shc2, scc2, gc2 = jnp.split(mod_c, 6, axis=-1)

        oc, ox = token_mixers(modulate(h, norm1_g[l], shc1, scc1), modulate(x, norm1_g[l], shx1, scx1),
                              w_in[l], gla_wa_f[l], gla_ba_f[l], gla_wa_b[l], gla_ba_b[l], gla_norm_g[l],
                              q_norm_g[l], k_norm_g[l], diff_lq1[l], diff_lk1[l], diff_lq2[l], diff_lk2[l],
                              diff_norm_g[l], w_out[l], lam_init, rope_gqa, rope_diff, need_ctx)
        x = x + gx1 * ox

        ffn_w = (router_w[l], router_b[l], exp_w_gate[l], exp_w_up[l], exp_w_down[l],
                 sh_w_gate[l], sh_w_up[l], sh_w_down[l])
        if need_ctx:
            h = h + gc1 * oc
            n_ctx = h.shape[1]
            y = moe_ffn(jnp.concatenate([modulate(h, norm2_g[l], shc2, scc2),
                                         modulate(x, norm2_g[l], shx2, scx2)], axis=1), *ffn_w)
            h = h + gc2 * y[:, :n_ctx]
            x = x + gx2 * y[:, n_ctx:]
        else:
            x = x + gx2 * moe_ffn(modulate(x, norm2_g[l], shx2, scx2), *ffn_w)
    return rms_norm(x, final_g)
```

```cpp
#include <hip/hip_runtime.h>
#include <stdint.h>
#include <stdio.h>

#ifndef WC_MASK
#define WC_MASK 0
#endif
#ifndef WC_TAIL
#define WC_TAIL 0
#endif
#ifndef SM_NA
#define SM_NA 4096
#endif
#ifndef WC_ATT
#define WC_ATT 1
#endif
#ifndef AT_PLAN
#define AT_PLAN 1
#endif
#ifndef WC_NOUT
#define WC_NOUT 192
#endif
#ifndef REP_PH
#define REP_PH -1
#endif
#ifndef MK_PER_PHASE
#define MK_PER_PHASE 0
#endif

typedef unsigned short bf16_t;
typedef short bf16x8 __attribute__((ext_vector_type(8)));
typedef short s16x4 __attribute__((ext_vector_type(4)));
typedef float f32x4 __attribute__((ext_vector_type(4)));
typedef float f32x16 __attribute__((ext_vector_type(16)));
typedef unsigned u32x4 __attribute__((ext_vector_type(4)));
typedef unsigned u32x2 __attribute__((ext_vector_type(2)));
typedef int i32x4 __attribute__((ext_vector_type(4)));
typedef int i32x8 __attribute__((ext_vector_type(8)));
#define LAS __attribute__((address_space(3)))

constexpr int DM = 2048, SEQ = 8192, NCTX = 256, NTOK = SEQ + NCTX, DEPTH = 2;
constexpr int GRIDW = 64;
constexpr int IN_W = 4640, ZW = 4864;
constexpr int ZC_GQ = 0, ZC_GK = 256, ZC_GV = 512, ZC_GG = 1024, ZC_AQ = 1536, ZC_AK = 2560, ZC_AV = 2816, ZC_DQ = 3072, ZC_DK = 3584, ZC_DV = 4096, ZC_DEC = 4608;
constexpr int NEXP = 64, TOPK = 8, EH = 512;
constexpr int NCHUNK = NTOK / 64;
constexpr float NORM_EPS = 1e-6f;
constexpr int HROWS = 92416;
constexpr int NTHREADS = 512;

constexpr size_t al256(size_t x) { return (x + 255) / 256 * 256; }
constexpr size_t WS_CTL   = 0;
constexpr size_t CTL_BYTES = 65536;
constexpr size_t WS_MOD   = WS_CTL + CTL_BYTES;
constexpr size_t WS_ROPE  = WS_MOD + al256((size_t)2 * 2 * 6 * DM * 4);
constexpr size_t WS_RWT   = WS_ROPE + al256((size_t)(128 * 32 * 2 + 128 * 16 * 2) * 4);
constexpr size_t WS_BTIN  = WS_RWT + al256((size_t)2 * NEXP * DM * 4);
constexpr size_t WS_BTOUT = WS_BTIN + al256((size_t)2 * ZW * DM * 2);
constexpr size_t WS_BTGU  = WS_BTOUT + al256((size_t)2 * DM * DM * 2);
constexpr size_t WS_BTD   = WS_BTGU + al256((size_t)2 * 65 * 1024 * DM * 2);
constexpr size_t WS_X     = WS_BTD + al256((size_t)2 * 65 * DM * EH * 2);
constexpr size_t WS_A     = WS_X + al256((size_t)NTOK * DM * 4);
constexpr size_t WS_Z     = WS_A + al256((size_t)NTOK * DM * 2);
constexpr size_t WS_GQK   = WS_Z + al256((size_t)NTOK * ZW * 2);
constexpr size_t WS_GVT   = WS_GQK + al256((size_t)NTOK * 4 * 256 * 2);
constexpr size_t WS_GU    = WS_GVT + al256((size_t)NCHUNK * 4 * 128 * 64 * 2);
constexpr size_t WS_GG    = WS_GU + al256((size_t)NCHUNK * 4 * 2 * 128 * 64 * 4);
constexpr size_t WS_GS    = WS_GG + al256((size_t)NCHUNK * 4 * 2 * 64 * 4);
constexpr size_t WS_MIX   = WS_GS + al256((size_t)NCHUNK * 4 * 2 * 128 * 64 * 2);
constexpr size_t WS_DSCR  = WS_MIX + al256((size_t)NTOK * DM * 2);
constexpr size_t WS_LIST  = WS_DSCR + al256((size_t)256 * 256 * 128 * 4);
constexpr size_t WS_TOKE  = WS_LIST + al256((size_t)NEXP * NTOK * 4);
constexpr size_t WS_TOKP  = WS_TOKE + al256((size_t)NTOK * 8 * 4);
constexpr size_t WS_TOKW  = WS_TOKP + al256((size_t)NTOK * 8 * 4);
constexpr size_t WS_H     = WS_TOKW + al256((size_t)NTOK * 8 * 4);
constexpr size_t WS_Y     = WS_H + al256((size_t)HROWS * EH * 2);
constexpr size_t WS_AF    = WS_Y + al256((size_t)HROWS * DM * 2);
constexpr size_t WS_A8    = WS_AF + al256((size_t)NTOK * DM * 4);
constexpr size_t WS_END   = WS_A8 + al256((size_t)NTOK * DM);
constexpr size_t WS_DUMMY = WS_END - WS_X;
constexpr size_t WS_DUMMY_BYTES = WS_H - WS_X;

constexpr int CW_BAR = 0;
constexpr int CW_CNT = 4096;
constexpr int CW_Q   = 4352;
constexpr int CW_DONE = 4800;
constexpr int CW_CNTD = 4608;

constexpr int LDS_STAGE = 131072;
constexpr int LDS_MISC  = 8192;
constexpr int LDS_BYTES = 163840;
constexpr int MS_CNT = 64;
constexpr int MS_RB  = 64 + 68 * 4;
constexpr int MS_TE  = MS_RB + 68 * 4;
constexpr int MS_TM  = MS_TE + 1024;
constexpr int MS_NT  = MS_TM + 1024;
constexpr int MS_F   = MS_NT + 16;

__device__ __forceinline__ unsigned cvt_pk_bf16(float lo, float hi) { unsigned r; asm volatile("v_cvt_pk_bf16_f32 %0, %1, %2" : "=v"(r) : "v"(lo), "v"(hi)); return r; }
__device__ __forceinline__ bf16_t f2bf(float x) { return (bf16_t)(cvt_pk_bf16(x, 0.f) & 0xffffu); }
__device__ __forceinline__ float clamp448(float x) { return __builtin_fminf(__builtin_fmaxf(x, -448.f), 448.f); }
__device__ __forceinline__ unsigned cvt4_fp8(float a, float b, float c, float d) { a = clamp448(a); b = clamp448(b); c = clamp448(c); d = clamp448(d); int w = __builtin_amdgcn_cvt_pk_fp8_f32(a, b, 0, false); w = __builtin_amdgcn_cvt_pk_fp8_f32(c, d, w, true); return (unsigned)w; }
__device__ __forceinline__ unsigned char f2fp8_x16(float x) { return (unsigned char)(__builtin_amdgcn_cvt_pk_fp8_f32(clamp448(x * 16.f), 0.f, 0, false) & 0xff); }
__device__ __forceinline__ float bf2f(bf16_t b) { return __uint_as_float(((unsigned)b) << 16); }
__device__ __forceinline__ float bflo(unsigned w) { return __uint_as_float(w << 16); }
__device__ __forceinline__ float bfhi(unsigned w) { return __uint_as_float(w & 0xffff0000u); }
__device__ __forceinline__ float wave_sum(float v) {
#pragma unroll
    for (int o = 32; o >= 1; o >>= 1) v += __shfl_xor(v, o, 64);
    return v;
}
__device__ __forceinline__ float wave_max(float v) {
#pragma unroll
    for (int o = 32; o >= 1; o >>= 1) v = fmaxf(v, __shfl_xor(v, o, 64));
    return v;
}
__device__ __forceinline__ float silu_f(float x) { return x / (1.f + __expf(-x)); }
__device__ __forceinline__ float sigmoid_f(float x) { return 1.f / (1.f + expf(-x)); }
__device__ __forceinline__ float logsigmoid_f(float x) { return fminf(x, 0.f) - __logf(1.f + __expf(-fabsf(x))); }
#define VM_WAIT() asm volatile("s_waitcnt vmcnt(0)" ::: "memory")

#define XB_TMO      128
#define XB_XCNT(j)  (256  + 64 * (j))
#define XB_XSUB(j)  (1280 + 64 * (j))
#define XB_XGEN(j)  (2304 + 64 * (j))
#define XB_TOP      3328
#define XB_TOPGEN   3392
#define XCD_BAR_WORDS 3456
#define XB_SPIN_CAP (1u << 22)
__device__ __forceinline__ unsigned xb_ld(unsigned* p)              { return __hip_atomic_load(p, __ATOMIC_RELAXED, __HIP_MEMORY_SCOPE_AGENT); }
__device__ __forceinline__ unsigned xb_add(unsigned* p, unsigned v) { return __hip_atomic_fetch_add(p, v, __ATOMIC_RELAXED, __HIP_MEMORY_SCOPE_AGENT); }
__device__ __forceinline__ unsigned xb_xcc_id() { return (unsigned)__builtin_amdgcn_s_getreg((3 << 11) | 20) & 0xFu; }
#define XB_SPIN(cond, bar) do { unsigned _sp = 0; while (cond) { __builtin_amdgcn_s_sleep(1); \
    if ((++_sp & 255u) == 0u) { if (xb_ld(&(bar)[XB_TMO])) break; if (_sp > XB_SPIN_CAP) { atomicAdd(&(bar)[XB_TMO], 1u); break; } } } } while (0)
struct XcdBarrier { unsigned* bar; unsigned x; volatile LAS unsigned* st; };
__device__ __forceinline__ XcdBarrier xcd_barrier_post(unsigned* bar, volatile LAS unsigned* st) {
    XcdBarrier b; b.bar = bar; b.x = xb_xcc_id(); b.st = st;
    if (threadIdx.x == 0) (void)xb_add(&bar[XB_XCNT(b.x)], 1u);
    return b;
}
__device__ __forceinline__ void xcd_barrier_complete(unsigned* bar, unsigned x, unsigned& nloc, unsigned& nx) {
    const unsigned G = gridDim.x * gridDim.y * gridDim.z;
    unsigned sum, cnt, mine, sp = 0u;
    for (;;) {
        sum = 0u; cnt = 0u; mine = 0u;
#pragma unroll
        for (unsigned j = 0; j < 16; ++j) { const unsigned c = xb_ld(&bar[XB_XCNT(j)]); sum += c; cnt += (c > 0u) ? 1u : 0u; mine = (j == x) ? c : mine; }
        if (sum == G) break;
        __builtin_amdgcn_s_sleep(1);
        if ((++sp & 255u) == 0u) { if (xb_ld(&bar[XB_TMO])) break; if (sp > XB_SPIN_CAP) { atomicAdd(&bar[XB_TMO], 1u); break; } }
    }
    nloc = mine > 0u ? mine : 1u; nx = cnt > 0u ? cnt : 1u;
}
__device__ __forceinline__ void xcd_barrier(const XcdBarrier& b) {
    asm volatile("s_waitcnt vmcnt(0)" ::: "memory");
    __syncthreads();
    if (threadIdx.x == 0) {
        unsigned* bar = b.bar;
        __builtin_amdgcn_s_waitcnt(0);
        unsigned nloc = b.st[0], nx = b.st[1];
        if (nloc == 0u) { xcd_barrier_complete(bar, b.x, nloc, nx); b.st[0] = nloc; b.st[1] = nx; }
        const unsigned old = xb_add(&bar[XB_XSUB(b.x)], 1u);
        const unsigned gen = old / nloc;
        if (old + 1u == (gen + 1u) * nloc) {
            __builtin_amdgcn_fence(__ATOMIC_RELEASE, "agent");
            asm volatile("s_waitcnt vmcnt(0)" ::: "memory");
            const unsigned og = xb_add(&bar[XB_TOP], 1u);
            const unsigned tg = og / nx;
            if (og + 1u == (tg + 1u) * nx) xb_add(&bar[XB_TOPGEN], 1u);
            else XB_SPIN(xb_ld(&bar[XB_TOPGEN]) == tg, bar);
            __builtin_amdgcn_fence(__ATOMIC_ACQUIRE, "agent");
            xb_add(&bar[XB_XGEN(b.x)], 1u);
            asm volatile("s_waitcnt vmcnt(0)" ::: "memory");
        } else {
            XB_SPIN(xb_ld(&bar[XB_XGEN(b.x)]) == gen, bar);
            __builtin_amdgcn_fence(__ATOMIC_ACQUIRE, "agent");
            asm volatile("s_waitcnt vmcnt(0)" ::: "memory");
        }
    }
    __syncthreads();
}

struct Args {
    const float* in[31];
    float* out;
    unsigned char* ws;
    int ph_lo, ph_hi;
};
struct Frame {
    LAS unsigned char* lds;
    unsigned char* ws;
    int tid, lane, wave, G, bid, vcu;
};
#define LOCAL_FRAME(F, F_) Frame F = F_; { int tz_ = threadIdx.x; asm volatile("" : "+v"(tz_)); F.tid = tz_; F.lane = tz_ & 63; }
enum { I_X = 0, I_C, I_CTX, I_CCTX, I_N1G, I_N2G, I_WMOD, I_BMOD, I_WIN, I_WAF, I_BAF, I_WAB, I_BAB, I_GLAG, I_QNG, I_KNG,
       I_LQ1, I_LK1, I_LQ2, I_LK2, I_DNG, I_WOUT, I_RW, I_RB, I_EWG, I_EWU, I_EWD, I_SWG, I_SWU, I_SWD, I_FG };
constexpr int WC_CH_E = 128;
constexpr int WC_CH_GU = 2 * 65 * WC_CH_E, WC_CH_D = 65 * WC_CH_E, WC_CH_LAYER = WC_CH_GU + WC_CH_D, WC_CH_TOTAL = DEPTH * WC_CH_LAYER;
constexpr int WC_TROW = 80, WC_TILE = 128 * WC_TROW;
struct WConv {};
__device__ __forceinline__ void wc_chunk(const Args& a, unsigned char* ws, LAS unsigned char* T, int c, int lane) {
    const int l = c / WC_CH_LAYER, r = c % WC_CH_LAYER;
    int kind, e, cb, kb, ld;
    if (r < WC_CH_GU) { kind = r / WC_CH_D; const int rr = r % WC_CH_D; e = rr / WC_CH_E; const int q = rr % WC_CH_E; cb = q >> 5; kb = q & 31; ld = EH; }
    else { kind = 2; const int rr = r - WC_CH_GU; e = rr / WC_CH_E; const int q = rr % WC_CH_E; cb = q >> 3; kb = q & 7; ld = DM; }
    const float* src = (kind == 0) ? ((e < NEXP) ? a.in[I_EWG] + ((size_t)l * NEXP + e) * DM * EH : a.in[I_SWG] + (size_t)l * DM * EH)
                     : (kind == 1) ? ((e < NEXP) ? a.in[I_EWU] + ((size_t)l * NEXP + e) * DM * EH : a.in[I_SWU] + (size_t)l * DM * EH)
                                   : ((e < NEXP) ? a.in[I_EWD] + ((size_t)l * NEXP + e) * EH * DM : a.in[I_SWD] + (size_t)l * EH * DM);
    const uintptr_t pb = (uintptr_t)src; const unsigned pl = __builtin_amdgcn_readfirstlane((unsigned)pb), ph = __builtin_amdgcn_readfirstlane((unsigned)(pb >> 32));
    const __amdgpu_buffer_rsrc_t rs = __builtin_amdgcn_make_buffer_rsrc((void*)(((uintptr_t)ph << 32) | pl), 0, 0x7fffffff, 0x00020000);
    const int h = lane >> 5, c4 = (lane & 31) * 4, ld4 = ld * 4;
    const int soff = __builtin_amdgcn_readfirstlane((kb * 64 * ld + cb * 128) * 4), vofs = (h * 32 * ld + c4) * 4;
    f32x4 v[32];
#pragma unroll
    for (int j = 0; j < 32; ++j) { const u32x4 t = __builtin_amdgcn_raw_buffer_load_b128(rs, vofs, soff + j * ld4, 2); v[j] = *reinterpret_cast<const f32x4*>(&t); }
    const float scale = (kind < 2) ? 64.f : 32.f;
#pragma unroll
    for (int jc = 0; jc < 4; ++jc) {
#pragma unroll
        for (int hh = 0; hh < 2; ++hh) { u32x4 w;
#pragma unroll
            for (int d = 0; d < 4; ++d) { const int j = hh * 16 + d * 4; w[d] = cvt4_fp8(v[j][jc] * scale, v[j + 1][jc] * scale, v[j + 2][jc] * scale, v[j + 3][jc] * scale); }
            *(LAS u32x4*)(T + (c4 + jc) * WC_TROW + h * 32 + hh * 16) = w; } }
    unsigned char* d0 = (kind < 2) ? ws + WS_BTGU + (((size_t)l * 65 + e) * 1024 + 8 * (cb * 32) + 4 * kind) * DM + kb * 64
                                   : ws + WS_BTD + (((size_t)l * 65 + e) * DM + cb * 128) * EH + kb * 64;
#pragma unroll
    for (int half = 0; half < 2; ++half) { const int n = lane + half * 64;
        unsigned char* dp = d0 + ((kind < 2) ? (size_t)(8 * (n >> 2) + (n & 3)) * DM : (size_t)n * EH);
        u32x4 w[4];
#pragma unroll
        for (int i = 0; i < 4; ++i) w[i] = *(const LAS u32x4*)(T + n * WC_TROW + i * 16);
#pragma unroll
        for (int i = 0; i < 4; ++i) *(u32x4*)(dp + i * 16) = w[i]; }
}
__device__ __forceinline__ void wc_work(const Args& a, unsigned char* ws, LAS unsigned char* lds, unsigned* ctl, int limit, unsigned* done, unsigned need) {
    int tz = threadIdx.x; asm volatile("" : "+v"(tz));
    const int tid = tz, lane = tz & 63, wave = __builtin_amdgcn_readfirstlane(tz >> 6); LAS unsigned char* T = lds + wave * WC_TILE;
    LAS int* slot = (LAS int*)(lds + 8 * WC_TILE);
    unsigned* q = ctl + CW_Q;
    unsigned tk = 0, dn = 0; bool have = false;
    if (tid == 0) { const unsigned hd = __hip_atomic_load(q, __ATOMIC_RELAXED, __HIP_MEMORY_SCOPE_AGENT);
        if ((int)(hd * 8u) < limit) { tk = __hip_atomic_fetch_add(q, 1u, __ATOMIC_RELAXED, __HIP_MEMORY_SCOPE_AGENT); have = true; } }
    for (int it = 0;; ++it) {
        if (tid == 0) {
            int c0 = -1, more = 0;
            if (have) { c0 = (int)(tk * 8u); if (c0 >= WC_CH_TOTAL) c0 = -1; }
            if (c0 >= 0) { more = (c0 < limit) ? 1 : 0; if (done && dn >= need) more = 0;
                if (more) { tk = __hip_atomic_fetch_add(q, 1u, __ATOMIC_RELAXED, __HIP_MEMORY_SCOPE_AGENT); if (done) dn = __hip_atomic_load(done, __ATOMIC_RELAXED, __HIP_MEMORY_SCOPE_AGENT); } }
            slot[(it & 1) * 2] = c0; slot[(it & 1) * 2 + 1] = more;
        }
        __syncthreads();
        const int c0 = __builtin_amdgcn_readfirstlane(slot[(it & 1) * 2]), more = __builtin_amdgcn_readfirstlane(slot[(it & 1) * 2 + 1]);
        if (c0 < 0) break;
        wc_chunk(a, ws, T, c0 + wave, lane);
        if (!more) break;
    }
    __syncthreads();
}
__device__ __forceinline__ int wc_geff(int units, int G) {
    if (G % 8 != 0 || units <= 0) return G;
    const int k = (units + G - 1) / G; int ge = (((units + k - 1) / k) + 7) & ~7;
    return ge < G ? ge : G;
}
namespace pg8 {
constexpr int BM = 256, BK = 64, HALF = 128, HTB = HALF * BK * 2, STAGE_BYTES = 8 * HTB;
__device__ __forceinline__ int lds_byte(int r, int c) { const int st = (r >> 4) * 2 + (c >> 5), rr = r & 15, cc = c & 31, ob = rr * 64 + cc * 2; return st * 1024 + (ob ^ (((ob >> 9) & 1) << 5)); }
__device__ __forceinline__ void stage_rc(int b, int& R, int& C) { const int st = b / 1024, sb = b % 1024, swz = sb ^ (((sb >> 9) & 1) << 5); R = (st >> 1) * 16 + swz / 64; C = (st & 1) * 32 + (swz % 64) / 2; }
__device__ __forceinline__ int perm32(int rho) { const int n = rho >> 4, i = rho & 15; return 8 * (i >> 2) + 4 * n + (i & 3); }

template <class Epi, class Sched, bool F8>
__device__ __forceinline__ void gemm_phase(LAS unsigned char* lds, const void* Aptr, const int RB, const Sched& S, const Epi& E) {
    typedef typename Sched::Unit Unit;
    int tz0 = threadIdx.x; asm volatile("" : "+v"(tz0));
    const int tid = tz0, wid = __builtin_amdgcn_readfirstlane(tid >> 6), lane = tid & 63, wr = wid >> 2, wc = wid & 3, fr = lane & 15, fq = lane >> 4;
    const int nt = RB / 128;
    int sR[2], sC[2]; unsigned voffB[2][2];
#pragma unroll
    for (int i = 0; i < 2; ++i) { int R, C; stage_rc(tid * 16 + i * 8192, R, C); sR[i] = R; sC[i] = C;
        if (Epi::PERM == 2) {
#pragma unroll
            for (int h = 0; h < 2; ++h) voffB[h][i] = (unsigned)((64 * (R >> 5) + 16 * ((R >> 2) & 3) + 8 * h + 4 * ((R >> 4) & 1) + (R & 3)) * RB + C * 2); }
        else { const int Rb = Epi::PERM ? ((R & ~31) + perm32(R & 31)) : R; voffB[0][i] = (unsigned)(Rb * RB + C * 2); voffB[1][i] = voffB[0][i] + (unsigned)HALF * (unsigned)RB; } }
    const unsigned kstep = 128u;
    __amdgpu_buffer_rsrc_t rsA, rsB;
    { const uintptr_t pa = (uintptr_t)Aptr, pb = (uintptr_t)S.Bbase();
      const unsigned al = __builtin_amdgcn_readfirstlane((unsigned)pa), ah = __builtin_amdgcn_readfirstlane((unsigned)(pa >> 32));
      const unsigned bl = __builtin_amdgcn_readfirstlane((unsigned)pb), bh = __builtin_amdgcn_readfirstlane((unsigned)(pb >> 32));
      rsA = __builtin_amdgcn_make_buffer_rsrc((void*)(((uintptr_t)ah << 32) | al), 0, 0x7fffffff, 0x00020000);
      rsB = __builtin_amdgcn_make_buffer_rsrc((void*)(((uintptr_t)bh << 32) | bl), 0, 0x7fffffff, 0x00020000); }
    const unsigned ldsw = (unsigned)wid * 1024u;
    const int aoff = lds_byte(wr * 64 + fr, fq * 8), boff = lds_byte(wc * 32 + fr, fq * 8);
#define PG8_SA(b, h) (((b) * 2 + (h)) * HTB)
#define PG8_SB(b, h) ((4 + (b) * 2 + (h)) * HTB)
#define PG8_STAGEB(bufoff, soff, h) do { _Pragma("unroll") for (int _i = 0; _i < 2; ++_i) \
        __builtin_amdgcn_raw_ptr_buffer_load_lds(rsB, (LAS void*)(lds + (bufoff) + ldsw + _i * 8192), 16, voffB[h][_i], (int)(soff), 0, 0); } while (0)
#define PG8_STAGEA(bufoff, soff, v0, v1) do { \
        __builtin_amdgcn_raw_ptr_buffer_load_lds(rsA, (LAS void*)(lds + (bufoff) + ldsw), 16, (v0), (int)(soff), 0, 0); \
        __builtin_amdgcn_raw_ptr_buffer_load_lds(rsA, (LAS void*)(lds + (bufoff) + ldsw + 8192), 16, (v1), (int)(soff), 0, 0); } while (0)
#define PG8_LDA(dst, b, h) do { _Pragma("unroll") for (int m = 0; m < 4; ++m) dst[m] = __builtin_shufflevector(*(const LAS i32x4*)(lds + PG8_SA(b, h) + aoff + m * 2048), *(const LAS i32x4*)(lds + PG8_SA(b, h) + aoff + m * 2048 + 1024), 0, 1, 2, 3, 4, 5, 6, 7); } while (0)
#define PG8_LDB(dst, b, h) do { _Pragma("unroll") for (int n = 0; n < 2; ++n) dst[n] = __builtin_shufflevector(*(const LAS i32x4*)(lds + PG8_SB(b, h) + boff + n * 2048), *(const LAS i32x4*)(lds + PG8_SB(b, h) + boff + n * 2048 + 1024), 0, 1, 2, 3, 4, 5, 6, 7); } while (0)
#define PG8_H0(x) ({ i32x4 t_ = __builtin_shufflevector(x, x, 0, 1, 2, 3); *reinterpret_cast<bf16x8*>(&t_); })
#define PG8_H1(x) ({ i32x4 t_ = __builtin_shufflevector(x, x, 4, 5, 6, 7); *reinterpret_cast<bf16x8*>(&t_); })
#define PG8_MMA(ai, bj, At, Bt) do { __builtin_amdgcn_s_setprio(1); \
        if (F8) { _Pragma("unroll") for (int m = 0; m < 4; ++m) _Pragma("unroll") for (int n = 0; n < 2; ++n) \
            asm volatile("v_mfma_scale_f32_16x16x128_f8f6f4 %0, %1, %2, %0, %3, %4 op_sel_hi:[0,0,0]" : "+v"(acc[ai][bj][m][n]) : "v"(Bt[n]), "v"(At[m]), "v"(sclW), "v"(sclA)); } \
        else { _Pragma("unroll") for (int m = 0; m < 4; ++m) _Pragma("unroll") for (int n = 0; n < 2; ++n) { \
            acc[ai][bj][m][n] = __builtin_amdgcn_mfma_f32_16x16x32_bf16(PG8_H0(Bt[n]), PG8_H0(At[m]), acc[ai][bj][m][n], 0, 0, 0); \
            acc[ai][bj][m][n] = __builtin_amdgcn_mfma_f32_16x16x32_bf16(PG8_H1(Bt[n]), PG8_H1(At[m]), acc[ai][bj][m][n], 0, 0, 0); } } \
        __builtin_amdgcn_s_setprio(0); } while (0)
#define PG8_WAIT_V(n) asm volatile("s_waitcnt vmcnt(" #n ")" ::: "memory")
#define PG8_WAIT_L(n) asm volatile("s_waitcnt lgkmcnt(" #n ")" ::: "memory")
#define PG8_BAR __builtin_amdgcn_s_barrier()
#define PG8_SCHED __builtin_amdgcn_sched_barrier(0)
#define PG8_AOFFS(u, o00, o01, o10, o11) do { o00 = (unsigned)(S.row(u, sR[0]) * RB + sC[0] * 2); o01 = (unsigned)(S.row(u, sR[1]) * RB + sC[1] * 2); \
        o10 = (unsigned)(S.row(u, sR[0] + HALF) * RB + sC[0] * 2); o11 = (unsigned)(S.row(u, sR[1] + HALF) * RB + sC[1] * 2); } while (0)
    int sclW = E.wscale, sclA = E.ascale; if (F8) { asm volatile("" : "+v"(sclW), "+v"(sclA)); }
    Unit cur, nxt; int ui = 0;
    if (!S.next(0, cur)) return;
    f32x4 acc[2][2][4][2];
#pragma unroll
    for (int a = 0; a < 2; ++a)
#pragma unroll
        for (int b = 0; b < 2; ++b)
#pragma unroll
            for (int m = 0; m < 4; ++m)
#pragma unroll
                for (int n = 0; n < 2; ++n) acc[a][b][m][n] = (f32x4){0.f, 0.f, 0.f, 0.f};
    i32x8 At[4], B0[2], B1[2];
    unsigned cB = (unsigned)__builtin_amdgcn_readfirstlane((int)cur.boff);
    unsigned c00, c01, c10, c11, n00, n01, n10, n11;
    PG8_AOFFS(cur, c00, c01, c10, c11);
    n00 = c00; n01 = c01; n10 = c10; n11 = c11;
    PG8_STAGEB(PG8_SB(0, 0), cB, 0); PG8_STAGEA(PG8_SA(0, 0), 0u, c00, c01); PG8_STAGEB(PG8_SB(0, 1), cB, 1); PG8_STAGEA(PG8_SA(0, 1), 0u, c10, c11);
    if (wr == 1) PG8_BAR;
    PG8_WAIT_V(4); PG8_BAR;
    PG8_STAGEB(PG8_SB(1, 0), cB + kstep, 0); PG8_STAGEA(PG8_SA(1, 0), kstep, c00, c01); PG8_STAGEB(PG8_SB(1, 1), cB + kstep, 1);
    PG8_WAIT_V(6); PG8_BAR;
    for (;;) {
        const bool has_next = S.next(ui + 1, nxt);
        const unsigned nB = (unsigned)__builtin_amdgcn_readfirstlane((int)(has_next ? nxt.boff : cB));
        if (has_next) { PG8_AOFFS(nxt, n00, n01, n10, n11); } else { n00 = c00; n01 = c01; n10 = c10; n11 = c11; }
#pragma clang loop unroll(disable)
        for (int t = 0; t < nt; t += 2) {
            const bool last = (t == nt - 2);
            const unsigned a1 = (unsigned)__builtin_amdgcn_readfirstlane((int)((unsigned)(t + 1) * kstep));
            const unsigned a2 = (unsigned)__builtin_amdgcn_readfirstlane((int)(last ? 0u : (unsigned)(t + 2) * kstep)), b2 = (unsigned)__builtin_amdgcn_readfirstlane((int)(last ? nB : cB + (unsigned)(t + 2) * kstep));
            const unsigned a3 = a2 + kstep, b3 = b2 + kstep;
            const unsigned x00 = last ? n00 : c00, x01 = last ? n01 : c01, x10 = last ? n10 : c10, x11 = last ? n11 : c11;
            PG8_LDB(B0, 0, 0); PG8_SCHED; PG8_LDA(At, 0, 0); PG8_STAGEA(PG8_SA(1, 1), a1, c10, c11);
            PG8_WAIT_L(8); PG8_BAR; PG8_WAIT_L(0); PG8_MMA(0, 0, At, B0); PG8_BAR; PG8_SCHED;
            PG8_LDB(B1, 0, 1); PG8_STAGEB(PG8_SB(0, 0), b2, 0);
            PG8_BAR; PG8_WAIT_L(0); PG8_MMA(0, 1, At, B1); PG8_BAR;
            PG8_LDA(At, 0, 1); PG8_STAGEA(PG8_SA(0, 0), a2, x00, x01);
            PG8_BAR; PG8_WAIT_L(0); PG8_MMA(1, 0, At, B0); PG8_BAR; PG8_SCHED;
            PG8_STAGEB(PG8_SB(0, 1), b2, 1);
            PG8_WAIT_V(6); PG8_BAR; PG8_MMA(1, 1, At, B1); PG8_BAR;
            PG8_LDB(B0, 1, 0); PG8_SCHED; PG8_LDA(At, 1, 0); PG8_STAGEA(PG8_SA(0, 1), a2, x10, x11);
            PG8_WAIT_L(8); PG8_BAR; PG8_WAIT_L(0); PG8_MMA(0, 0, At, B0); PG8_BAR; PG8_SCHED;
            PG8_LDB(B1, 1, 1); PG8_STAGEB(PG8_SB(1, 0), b3, 0);
            PG8_BAR; PG8_WAIT_L(0); PG8_MMA(0, 1, At, B1); PG8_BAR;
            PG8_LDA(At, 1, 1); PG8_STAGEA(PG8_SA(1, 0), a3, x00, x01);
            PG8_BAR; PG8_WAIT_L(0); PG8_MMA(1, 0, At, B0); PG8_BAR; PG8_SCHED;
            PG8_STAGEB(PG8_SB(1, 1), b3, 1);
            PG8_WAIT_V(6); PG8_BAR; PG8_MMA(1, 1, At, B1); PG8_BAR;
        }
        if (F8) asm volatile("s_nop 15\n\ts_nop 15" ::: "memory");
        { int tz1 = threadIdx.x; asm volatile("" : "+v"(tz1));
          const int wid1 = __builtin_amdgcn_readfirstlane(tz1 >> 6), lane1 = tz1 & 63;
          E(acc, cur, wid1 >> 2, wid1 & 3, lane1 & 15, lane1 >> 4); }
        if (!has_next) break;
#pragma unroll
        for (int a = 0; a < 2; ++a)
#pragma unroll
            for (int b = 0; b < 2; ++b)
#pragma unroll
                for (int m = 0; m < 4; ++m)
#pragma unroll
                    for (int n = 0; n < 2; ++n) acc[a][b][m][n] = (f32x4){0.f, 0.f, 0.f, 0.f};
        cur = nxt; cB = nB; c00 = n00; c01 = n01; c10 = n10; c11 = n11; ++ui;
    }
    PG8_WAIT_V(0);
    if (wr == 0) PG8_BAR;
    PG8_BAR;
#undef PG8_SA
#undef PG8_SB
#undef PG8_STAGEA
#undef PG8_STAGEB
#undef PG8_LDA
#undef PG8_LDB
#undef PG8_MMA
#undef PG8_H0
#undef PG8_H1
#undef PG8_WAIT_V
#undef PG8_WAIT_L
#undef PG8_BAR
#undef PG8_SCHED
#undef PG8_AOFFS
}
}

struct DenseSched {
    struct Unit { unsigned boff; int pm, pn, m0; };
    int nM, nN, nwg, G, c, row0, RB  ; const void* Bt;
    __device__ void init(int M, int N, int RB_, int G_, int c_, int row0_, const void* Bt_) { nM = M / 256; nN = N / 256; nwg = nM * nN; G = G_; c = c_; row0 = row0_; RB = RB_; Bt = Bt_; }
    __device__ __forceinline__ bool next(int i, Unit& u) const {
        const long L = (long)i * G + c; if (L >= nwg) return false;
        int wgid = (int)L; { const int q = nwg / 8, r = nwg % 8, xcd = wgid % 8, off = wgid / 8; wgid = (xcd < r ? xcd * (q + 1) : r * (q + 1) + (xcd - r) * q) + off; }
        const int nig = 8 * nN, gid = wgid / nig, fm = gid * 8, gsz = (nM - fm) < 8 ? (nM - fm) : 8;
        u.pm = fm + ((wgid % nig) % gsz); u.pn = (wgid % nig) / gsz; u.m0 = row0 + u.pm * 256;
        u.boff = (unsigned)u.pn * 256u * (unsigned)RB; return true;
    }
    __device__ __forceinline__ int row(const Unit& u, int r) const { return u.m0 + r; }
    __device__ __forceinline__ int nrows(const Unit&) const { return 256; }
    __device__ __forceinline__ const void* Bbase() const { return Bt; }
};
template <int NTS, bool GATHER>
struct MoeSched {
    struct Unit { unsigned boff; int e, mt, pn, rows, hrow0; };
    LAS unsigned char* misc; int G, c, RB  , tok0; const unsigned char* Bt; size_t bstride  ; const int* list;
    __device__ __forceinline__ bool next(int i, Unit& u) const {
        const int ntiles = *(const LAS int*)(misc + MS_NT);
        const long L = (long)i * G + c; if (L >= (long)ntiles * NTS) return false;
        const int t = (int)(L / NTS); u.pn = (int)(L % NTS);
        u.e = ((const LAS short*)(misc + MS_TE))[t]; u.mt = ((const LAS short*)(misc + MS_TM))[t];
        const int cnt = ((const LAS int*)(misc + MS_CNT))[u.e]; const int rem = cnt - u.mt * 256; u.rows = rem < 256 ? rem : 256;
        u.hrow0 = ((const LAS int*)(misc + MS_RB))[u.e] + u.mt * 256;
        u.boff = (unsigned)u.e * (unsigned)bstride + (unsigned)u.pn * 256u * (unsigned)RB; return true;
    }
    __device__ __forceinline__ int row(const Unit& u, int r) const {
        if (GATHER) {
            const int rr = r < u.rows ? r : u.rows - 1;
            if (u.e == NEXP) return tok0 + u.mt * 256 + rr;
            return list[(size_t)u.e * NTOK + u.mt * 256 + rr];
        } else return u.hrow0 + r;
    }
    __device__ __forceinline__ int nrows(const Unit& u) const { return u.rows; }
    __device__ __forceinline__ const void* Bbase() const { return Bt; }
};

struct EpiZ {
    static constexpr int PERM = 1; static constexpr int wscale = 127, ascale = 127;
    bf16_t* O; int ldc;
    template <class U> __device__ __forceinline__ void operator()(const f32x4 (&acc)[2][2][4][2], const U& u, int wr, int wc, int fr, int fq) const {
        const int row0 = u.m0 + wr * 64 + fr, col0 = u.pn * 256 + wc * 32 + 8 * fq;
#pragma unroll
        for (int ai = 0; ai < 2; ++ai)
#pragma unroll
            for (int m = 0; m < 4; ++m) { bf16_t* rowp = O + (size_t)(row0 + ai * 128 + m * 16) * ldc + col0;
#pragma unroll
                for (int bj = 0; bj < 2; ++bj) { const f32x4 v0 = acc[ai][bj][m][0], v1 = acc[ai][bj][m][1];
                    u32x4 w; w.x = cvt_pk_bf16(v0[0], v0[1]); w.y = cvt_pk_bf16(v0[2], v0[3]); w.z = cvt_pk_bf16(v1[0], v1[1]); w.w = cvt_pk_bf16(v1[2], v1[3]);
                    *(u32x4*)(rowp + bj * 128) = w; } }
    }
};
struct EpiOut {
    static constexpr int PERM = 1; static constexpr int wscale = 121, ascale = 123;
    bf16_t* X; const float* gctx; const float* gx; bf16_t* Xo;
    template <class U> __device__ __forceinline__ void operator()(const f32x4 (&acc)[2][2][4][2], const U& u, int wr, int wc, int fr, int fq) const {
        const int row0 = u.m0 + wr * 64 + fr, col0 = u.pn * 256 + wc * 32 + 8 * fq;
        const float* g = (u.m0 < NCTX) ? gctx : gx;
        f32x4 gv[2][2];
#pragma unroll
        for (int bj = 0; bj < 2; ++bj)
#pragma unroll
            for (int n = 0; n < 2; ++n) gv[bj][n] = *(const f32x4*)(g + col0 + bj * 128 + n * 4);
#pragma unroll
        for (int ai = 0; ai < 2; ++ai)
#pragma unroll
            for (int m = 0; m < 4; ++m) { const size_t ro = (size_t)(row0 + ai * 128 + m * 16) * DM + col0; const bf16_t* rowp = X + ro; bf16_t* rowo = Xo + ro;
#pragma unroll
                for (int bj = 0; bj < 2; ++bj) { const u32x4 b = *(const u32x4*)(rowp + bj * 128);
                    const f32x4 v0 = (f32x4){bflo(b.x), bfhi(b.x), bflo(b.y), bfhi(b.y)} + gv[bj][0] * acc[ai][bj][m][0], v1 = (f32x4){bflo(b.z), bfhi(b.z), bflo(b.w), bfhi(b.w)} + gv[bj][1] * acc[ai][bj][m][1];
                    u32x4 w; w.x = cvt_pk_bf16(v0[0], v0[1]); w.y = cvt_pk_bf16(v0[2], v0[3]); w.z = cvt_pk_bf16(v1[0], v1[1]); w.w = cvt_pk_bf16(v1[2], v1[3]);
                    *(u32x4*)(rowo + bj * 128) = w; } }
    }
};
struct EpiUp {
    static constexpr int PERM = 2; static constexpr int wscale = 121, ascale = 127;
    unsigned char* H; int nostore;
    template <class U> __device__ __forceinline__ void operator()(const f32x4 (&acc)[2][2][4][2], const U& u, int wr, int wc, int fr, int fq) const {
        if (nostore) return;
        const int r0 = wr * 64 + fr, col0 = u.pn * 128 + wc * 32 + 8 * fq;
#pragma unroll
        for (int ai = 0; ai < 2; ++ai)
#pragma unroll
            for (int m = 0; m < 4; ++m) { const int r = r0 + ai * 128 + m * 16;
                if (r < u.rows) { u32x2 w;
                    { const f32x4 g = acc[ai][0][m][0], up = acc[ai][0][m][1]; w.x = cvt4_fp8(silu_f(g[0]) * up[0], silu_f(g[1]) * up[1], silu_f(g[2]) * up[2], silu_f(g[3]) * up[3]); }
                    { const f32x4 g = acc[ai][1][m][0], up = acc[ai][1][m][1]; w.y = cvt4_fp8(silu_f(g[0]) * up[0], silu_f(g[1]) * up[1], silu_f(g[2]) * up[2], silu_f(g[3]) * up[3]); }
                    *(u32x2*)(H + (size_t)(u.hrow0 + r) * EH + col0) = w; } }
    }
};
struct EpiDown {
    static constexpr int PERM = 2; static constexpr int wscale = 122, ascale = 127;
    unsigned char* Y; int nostore;
    template <class U> __device__ __forceinline__ void operator()(const f32x4 (&acc)[2][2][4][2], const U& u, int wr, int wc, int fr, int fq) const {
        const int r0 = wr * 64 + fr, col0 = u.pn * 256 + wc * 64 + 16 * fq;
#pragma unroll
        for (int ai = 0; ai < 2; ++ai)
#pragma unroll
            for (int m = 0; m < 4; ++m) { const int r = r0 + ai * 128 + m * 16;
                if (r < u.rows && !nostore) { u32x4 w;
                    w.x = cvt4_fp8(acc[ai][0][m][0][0], acc[ai][0][m][0][1], acc[ai][0][m][0][2], acc[ai][0][m][0][3]); w.y = cvt4_fp8(acc[ai][0][m][1][0], acc[ai][0][m][1][1], acc[ai][0][m][1][2], acc[ai][0][m][1][3]);
                    w.z = cvt4_fp8(acc[ai][1][m][0][0], acc[ai][1][m][0][1], acc[ai][1][m][0][2], acc[ai][1][m][0][3]); w.w = cvt4_fp8(acc[ai][1][m][1][0], acc[ai][1][m][1][1], acc[ai][1][m][1][2], acc[ai][1][m][1][3]);
                    *(u32x4*)(Y + (size_t)(u.hrow0 + r) * DM + col0) = w; } }
    }
};

__device__ __forceinline__ void moe_tables(const Frame& F_, const unsigned* cnt_g, int ntok) {
    LOCAL_FRAME(F, F_);
    LAS unsigned char* misc = F.lds + LDS_STAGE;
    LAS int* cntS = (LAS int*)(misc + MS_CNT); LAS int* rbS = (LAS int*)(misc + MS_RB);
    LAS short* te = (LAS short*)(misc + MS_TE); LAS short* tm = (LAS short*)(misc + MS_TM);
    __syncthreads();
    if (F.tid < 64) {
        const int c = (int)cnt_g[F.tid]; const int nt = (c + 255) >> 8;
        int inc = nt;
#pragma unroll
        for (int o = 1; o < 64; o <<= 1) { const int v = __shfl_up(inc, o, 64); if (F.lane >= o) inc += v; }
        const int first = inc - nt;
        cntS[F.tid] = c; rbS[F.tid] = first * 256;
        for (int m = 0; m < nt; ++m) { te[first + m] = (short)F.tid; tm[first + m] = (short)m; }
        if (F.tid == 63) { const int nts = (ntok + 255) >> 8; cntS[NEXP] = ntok; rbS[NEXP] = inc * 256; rbS[NEXP + 1] = (inc + nts) * 256; *(LAS int*)(misc + MS_NT) = inc + nts;
            for (int m = 0; m < nts; ++m) { te[inc + m] = (short)NEXP; tm[inc + m] = (short)m; } }
    }
    __syncthreads();
}
namespace attn {
constexpr int NW = 8, QBLK = 32, KVBLK = 64;
constexpr float THR = 8.f;
constexpr int SHM_V = KVBLK * 128 * 2, SHM_K = KVBLK * 128 * 2;
constexpr int OFF_K = 2 * SHM_V, OFF_WS = 2 * SHM_V + 2 * SHM_K, LDS_ATTN = OFF_WS + NW * 64 * 4;
#define KSWZ128(row, colB) ((row) * 256 + ((colB) ^ (((row) & 7) << 4)))
#define KSWZ64(row, colB)  ((row) * 128 + ((colB) ^ ((((row) >> 1) & 7) << 4)))
#define SBAR() __builtin_amdgcn_sched_barrier(0)
__device__ __forceinline__ int crow(int r, int hi) { return (r & 3) + 8 * (r >> 2) + 4 * hi; }

template <int DQK>
__device__ __forceinline__ void partialSM(f32x16& p0, f32x16& p1, float& m_reg, float& mn, float& alpha) {
    constexpr float SCALE = (DQK == 128) ? 0.088388347648318440f : 0.125f;
    constexpr float C = SCALE * 1.4426950408889634f;
    float pmax = p0[0];
#pragma unroll
    for (int r = 1; r < 16; ++r) pmax = fmaxf(pmax, p0[r]);
#pragma unroll
    for (int r = 0; r < 16; ++r) pmax = fmaxf(pmax, p1[r]);
    { auto rr = __builtin_amdgcn_permlane32_swap(__float_as_uint(pmax), __float_as_uint(pmax), false, false);
      pmax = fmaxf(__uint_as_float(rr[0]), __uint_as_float(rr[1])); }
    if (__builtin_expect(__all(pmax - m_reg <= THR / SCALE), 1)) { mn = m_reg; alpha = 1.f; }
    else { mn = fmaxf(m_reg, pmax); alpha = __builtin_amdgcn_exp2f((m_reg - mn) * C); m_reg = mn; }
    const float mnC = -mn * C;
#pragma unroll
    for (int r = 0; r < 16; ++r) p0[r] = fmaf(p0[r], C, mnC);
#pragma unroll
    for (int r = 0; r < 16; ++r) p1[r] = fmaf(p1[r], C, mnC);
#pragma unroll
    for (int r = 0; r < 16; ++r) p0[r] = __builtin_amdgcn_exp2f(p0[r]);
}
__device__ __forceinline__ void finishSM(f32x16& p0, f32x16& p1, float alpha, float& l_reg, bf16x8& pa0, bf16x8& pa1, bf16x8& pa2, bf16x8& pa3) {
#pragma unroll
    for (int r = 0; r < 16; ++r) p1[r] = __builtin_amdgcn_exp2f(p1[r]);
    float ps = 0;
#pragma unroll
    for (int r = 0; r < 16; ++r) ps += p0[r];
#pragma unroll
    for (int r = 0; r < 16; ++r) ps += p1[r];
    { auto rr = __builtin_amdgcn_permlane32_swap(__float_as_uint(ps), __float_as_uint(ps), false, false);
      ps = __uint_as_float(rr[0]) + __uint_as_float(rr[1]); }
    l_reg = l_reg * alpha + ps;
#define PK4(P, BASE, OUT) do { unsigned a0 = cvt_pk_bf16(P[BASE + 0], P[BASE + 1]), a1 = cvt_pk_bf16(P[BASE + 2], P[BASE + 3]);   \
    unsigned b0 = cvt_pk_bf16(P[BASE + 4], P[BASE + 5]), b1 = cvt_pk_bf16(P[BASE + 6], P[BASE + 7]);                              \
    auto r0 = __builtin_amdgcn_permlane32_swap(a0, b0, false, false); auto r1 = __builtin_amdgcn_permlane32_swap(a1, b1, false, false); \
    u32x4 w = {r0[0], r1[0], r0[1], r1[1]}; OUT = *reinterpret_cast<bf16x8*>(&w); } while (0)
    PK4(p0, 0, pa0); PK4(p0, 8, pa1); PK4(p1, 0, pa2); PK4(p1, 8, pa3);
#undef PK4
}
template <int DQK>
__device__ __forceinline__ void qkt(f32x16& p0, f32x16& p1, const char* Ks, const bf16x8* qr, int r32, int hi) {
    p0 = f32x16{}; p1 = f32x16{};
#pragma unroll
    for (int d0 = 0; d0 < DQK / 16; ++d0) { const int cb = (d0 * 16 + hi * 8) * 2;
        bf16x8 b0, b1;
        if (DQK == 128) { b0 = *reinterpret_cast<const bf16x8*>(Ks + KSWZ128(r32, cb)); b1 = *reinterpret_cast<const bf16x8*>(Ks + KSWZ128(32 + r32, cb)); }
        else            { b0 = *reinterpret_cast<const bf16x8*>(Ks + KSWZ64(r32, cb));  b1 = *reinterpret_cast<const bf16x8*>(Ks + KSWZ64(32 + r32, cb)); }
        p0 = __builtin_amdgcn_mfma_f32_32x32x16_bf16(b0, qr[d0], p0, 0, 0, 0);
        p1 = __builtin_amdgcn_mfma_f32_32x32x16_bf16(b1, qr[d0], p1, 0, 0, 0); }
}
__device__ __forceinline__ int v_st(int k, int c) { const int kk = (k & ~0xC) | ((k & 4) << 1) | ((k & 8) >> 1); return ((kk >> 3) * 4 + (c >> 5)) * 512 + ((kk & 7) * 32 + (c & 31)) * 2; }
__device__ __forceinline__ int v_rd_base(int lane) { return ((lane & 3) << 3) | (((lane >> 2) & 3) << 6) | (((lane >> 4) & 1) << 5) | (((lane >> 5) & 1) << 8); }
constexpr int v_rd_off(int d0, int ks, int half) { return d0 * 512 + ks * 4096 + half * 2048; }
template <int OFF> __device__ __forceinline__ s16x4 tr_read(int vb) {
    s16x4 r; asm volatile("ds_read_b64_tr_b16 %0, %1 offset:%2" : "=&v"(r) : "v"(vb), "i"(OFF) : "memory"); return r;
}
template <int D0> __device__ __forceinline__ void pv_one(f32x16& od, int vb, bf16x8 pa0, bf16x8 pa1, bf16x8 pa2, bf16x8 pa3) {
    const s16x4 l0 = tr_read<v_rd_off(D0, 0, 0)>(vb), h0 = tr_read<v_rd_off(D0, 0, 1)>(vb), l1 = tr_read<v_rd_off(D0, 1, 0)>(vb), h1 = tr_read<v_rd_off(D0, 1, 1)>(vb);
    const s16x4 l2 = tr_read<v_rd_off(D0, 2, 0)>(vb), h2 = tr_read<v_rd_off(D0, 2, 1)>(vb), l3 = tr_read<v_rd_off(D0, 3, 0)>(vb), h3 = tr_read<v_rd_off(D0, 3, 1)>(vb);
    asm volatile("s_waitcnt lgkmcnt(0)" ::: "memory"); SBAR();
#define PK(L, H) (bf16x8){L[0], L[1], L[2], L[3], H[0], H[1], H[2], H[3]}
    od = __builtin_amdgcn_mfma_f32_32x32x16_bf16(pa0, PK(l0, h0), od, 0, 0, 0);
    od = __builtin_amdgcn_mfma_f32_32x32x16_bf16(pa1, PK(l1, h1), od, 0, 0, 0);
    od = __builtin_amdgcn_mfma_f32_32x32x16_bf16(pa2, PK(l2, h2), od, 0, 0, 0);
    od = __builtin_amdgcn_mfma_f32_32x32x16_bf16(pa3, PK(l3, h3), od, 0, 0, 0);
#undef PK
}
__device__ __forceinline__ void pv_d0(f32x16* o, int vb, bf16x8 pa0, bf16x8 pa1, bf16x8 pa2, bf16x8 pa3) {
    pv_one<0>(o[0], vb, pa0, pa1, pa2, pa3); pv_one<1>(o[1], vb, pa0, pa1, pa2, pa3); pv_one<2>(o[2], vb, pa0, pa1, pa2, pa3); pv_one<3>(o[3], vb, pa0, pa1, pa2, pa3);
}

struct OutArgs { unsigned char* mix; float* scr; float lam; float osc; const float* ng; };

struct BgArgs { WConv* c; const Args* a; unsigned char* ws; LAS unsigned char* ldsl; };
template <int DQK, int MODE, int BGL>
__device__ __forceinline__ void body(const bf16_t* __restrict__ Qb, const bf16_t* __restrict__ Kh, const bf16_t* __restrict__ Vh, int seq, char* lds, const OutArgs oa, const BgArgs bg) {
    constexpr int ND = DQK / 16;
    int tz0 = threadIdx.x; asm volatile("" : "+v"(tz0));
    const int tid = tz0, wid = tid >> 6, lane = tid & 63, r32 = lane & 31, hi = lane >> 5;
    __syncthreads();
    char* V_lds = lds; char* K_lds = lds + OFF_K;
    float* ws = (float*)(lds + OFF_WS) + wid * 64; float* li_l = ws; float* al_l = ws + 32;
    float m_reg = -1e30f, l_reg = 0; f32x16 o[4] = {}; bf16x8 qr[ND];
    const bf16_t* Qw = Qb + (size_t)(wid * QBLK + r32) * ZW + hi * 8;
#pragma unroll
    for (int d0 = 0; d0 < ND; ++d0) qr[d0] = *reinterpret_cast<const bf16x8*>(Qw + d0 * 16);
    const int sr = tid >> 4, sc = (tid & 15) * 8, vst0 = v_st(sr, sc), vst1 = v_st(32 + sr, sc);
    const int kr64 = tid >> 3, kc64 = (tid & 7) * 8;
    const int vb0 = (int)(uintptr_t)V_lds + v_rd_base(lane);
#ifndef WC_MODE
#define WC_MODE 0
#endif
    constexpr int SD = (BGL >= 0 && WC_MODE != 1) ? 1 : 2;
    struct { bf16x8 vs0, vs1, ks0, ks1; } sr_[SD];
    const unsigned voffS = (unsigned)(sr * ZW + sc) * 2u, voffK64 = (unsigned)(kr64 * ZW + kc64) * 2u;
    __amdgpu_buffer_rsrc_t rsK, rsV;
    { const uintptr_t pk = (uintptr_t)Kh, pv = (uintptr_t)Vh;
      const unsigned kl = __builtin_amdgcn_readfirstlane((unsigned)pk), kh = __builtin_amdgcn_readfirstlane((unsigned)(pk >> 32));
      const unsigned vl = __builtin_amdgcn_readfirstlane((unsigned)pv), vh = __builtin_amdgcn_readfirstlane((unsigned)(pv >> 32));
      rsK = __builtin_amdgcn_make_buffer_rsrc((void*)(((uintptr_t)kh << 32) | kl), 0, NTOK * ZW * 2, 0x00020000);
      rsV = __builtin_amdgcn_make_buffer_rsrc((void*)(((uintptr_t)vh << 32) | vl), 0, NTOK * ZW * 2, 0x00020000); }
#define BLD(rs, vo, so) ({ u32x4 t_ = __builtin_amdgcn_raw_buffer_load_b128(rs, vo, so, 0); *reinterpret_cast<bf16x8*>(&t_); })
#define SLOAD(i, k0) do { const int so_ = (k0) * (ZW * 2); \
    sr_[i].vs0 = BLD(rsV, voffS, so_); sr_[i].vs1 = BLD(rsV, voffS, so_ + 32 * ZW * 2); \
    if (DQK == 128) { sr_[i].ks0 = BLD(rsK, voffS, so_); sr_[i].ks1 = BLD(rsK, voffS, so_ + 32 * ZW * 2); } \
    else { sr_[i].ks0 = BLD(rsK, voffK64, so_); } } while (0)
#define SWRITE(b, i) do { *(bf16x8*)(V_lds + (b) * SHM_V + vst0) = sr_[i].vs0; *(bf16x8*)(V_lds + (b) * SHM_V + vst1) = sr_[i].vs1; \
    if (DQK == 128) { const int kc = sc * 2; *(bf16x8*)(K_lds + (b) * SHM_K + KSWZ128(sr, kc)) = sr_[i].ks0; *(bf16x8*)(K_lds + (b) * SHM_K + KSWZ128(32 + sr, kc)) = sr_[i].ks1; } \
    else { *(bf16x8*)(K_lds + (b) * SHM_K + KSWZ64(kr64, kc64 * 2)) = sr_[i].ks0; } } while (0)
#define SWAIT() do { if (SD == 2) { if (DQK == 128) asm volatile("s_waitcnt vmcnt(4)" ::: "memory"); else asm volatile("s_waitcnt vmcnt(3)" ::: "memory"); } \
    else if (BGL >= 0 && WC_MODE == 0) asm volatile("s_waitcnt vmcnt(2)" ::: "memory"); else asm volatile("s_waitcnt vmcnt(0)" ::: "memory"); } while (0)
#define BGSTEP(X) do { } while (0)
#define RESC(a) do { if (__any((a) < 1.f)) { if (hi == 0) al_l[r32] = (a); asm volatile("s_waitcnt lgkmcnt(0)" ::: "memory"); \
    _Pragma("unroll") for (int d = 0; d < 4; ++d) _Pragma("unroll") for (int r = 0; r < 16; ++r) o[d][r] *= al_l[crow(r, hi)]; } } while (0)
    f32x16 pA0, pA1, pB0, pB1; float mnA, mnB, alA, alB; bf16x8 pa0, pa1, pa2, pa3; const int NT = seq / KVBLK;
    constexpr int SE = 0, SO = SD - 1;
    SLOAD(SE, 0); asm volatile("s_waitcnt vmcnt(0)" ::: "memory"); SWRITE(0, SE); __syncthreads();
    qkt<DQK>(pA0, pA1, K_lds, qr, r32, hi); partialSM<DQK>(pA0, pA1, m_reg, mnA, alA);
    SLOAD(SO, KVBLK); if (SD == 2) { if (2 < NT) SLOAD(SE, 2 * KVBLK); }
    SWAIT(); SWRITE(1, SO); __syncthreads();
    for (int j = 1; j + 1 < NT; j += 2) {
        SBAR(); qkt<DQK>(pB0, pB1, K_lds + SHM_K, qr, r32, hi);
        finishSM(pA0, pA1, alA, l_reg, pa0, pa1, pa2, pa3); SBAR();
        SLOAD(SO, (j + SD) * KVBLK); BGSTEP(0); SBAR();
        pv_d0(o, vb0, pa0, pa1, pa2, pa3); partialSM<DQK>(pB0, pB1, m_reg, mnB, alB);
        __syncthreads(); SWAIT(); SWRITE(0, SE);
        RESC(alB); __syncthreads();
        SBAR(); qkt<DQK>(pA0, pA1, K_lds, qr, r32, hi);
        finishSM(pB0, pB1, alB, l_reg, pa0, pa1, pa2, pa3); SBAR();
        if (SD == 1 || j + 3 < NT) SLOAD(SE, (j + 1 + SD) * KVBLK); BGSTEP(1); SBAR();
        pv_d0(o, vb0 + SHM_V, pa0, pa1, pa2, pa3); partialSM<DQK>(pA0, pA1, m_reg, mnA, alA);
        __syncthreads(); SWAIT(); SWRITE(1, SO);
        RESC(alA); __syncthreads();
    }
    SBAR(); qkt<DQK>(pB0, pB1, K_lds + SHM_K, qr, r32, hi);
    finishSM(pA0, pA1, alA, l_reg, pa0, pa1, pa2, pa3); SBAR();
    pv_d0(o, vb0, pa0, pa1, pa2, pa3); partialSM<DQK>(pB0, pB1, m_reg, mnB, alB);
    __syncthreads(); RESC(alB);
    finishSM(pB0, pB1, alB, l_reg, pa0, pa1, pa2, pa3); SBAR();
    pv_d0(o, vb0 + SHM_V, pa0, pa1, pa2, pa3);
    if (hi == 0) li_l[r32] = l_reg; asm volatile("s_waitcnt lgkmcnt(0)" ::: "memory");
    float rli[16];
#pragma unroll
    for (int r = 0; r < 16; ++r) rli[r] = __builtin_amdgcn_rcpf(li_l[crow(r, hi)]);
    int tz = threadIdx.x; asm volatile("" : "+v"(tz));
    const int tid_e = tz, wid_e = tz >> 6, r32_e = tz & 31, hi_e = (tz >> 5) & 1;
#define tid tid_e
#define wid wid_e
#define r32 r32_e
#define hi hi_e
    if (MODE == 0) {
        unsigned char* Ow = oa.mix + (size_t)(wid * QBLK) * DM;
#pragma unroll
        for (int r = 0; r < 16; ++r) { const int orow = crow(r, hi);
#pragma unroll
            for (int d0 = 0; d0 < 4; ++d0) Ow[(size_t)orow * DM + d0 * 32 + r32] = f2fp8_x16(o[d0][r] * rli[r]); }
    } else if (MODE == 1) {
#pragma unroll
        for (int r = 0; r < 16; ++r)
#pragma unroll
            for (int d0 = 0; d0 < 4; ++d0) oa.scr[(r * 4 + d0) * 512 + tid] = o[d0][r] * rli[r];
    } else {
        unsigned char* Ow = oa.mix + (size_t)(wid * QBLK) * DM;
        float gn[4];
#pragma unroll
        for (int d0 = 0; d0 < 4; ++d0) gn[d0] = oa.ng[d0 * 32 + r32] * oa.osc;
#pragma unroll
        for (int r = 0; r < 16; ++r) { const int orow = crow(r, hi); float v[4]; float ss = 0.f;
#pragma unroll
            for (int d0 = 0; d0 < 4; ++d0) { v[d0] = oa.scr[(r * 4 + d0) * 512 + tid] - oa.lam * (o[d0][r] * rli[r]); ss += v[d0] * v[d0]; }
#pragma unroll
            for (int s = 16; s >= 1; s >>= 1) ss += __shfl_xor(ss, s, 64);
            const float rs = rsqrtf(ss * (1.f / 128.f) + NORM_EPS);
#pragma unroll
            for (int d0 = 0; d0 < 4; ++d0) Ow[(size_t)orow * DM + d0 * 32 + r32] = f2fp8_x16(v[d0] * rs * gn[d0]); }
    }
#undef tid
#undef wid
#undef r32
#undef hi
    asm volatile("s_waitcnt vmcnt(0) lgkmcnt(0)" ::: "memory");
    __syncthreads();
#undef SLOAD
#undef BGSTEP
#undef BLD
#undef SWRITE
#undef SWAIT
#undef RESC
}
}
__device__ __forceinline__ void mod_gemv(const Frame& F_, const float* c, const float* cctx, const float* wmod, const float* bmod, float* mod) {
    LOCAL_FRAME(F, F_);
    LAS float* sx = (LAS float*)F.lds;
    LAS float* sc = sx + DM;
    LAS float* red = sc + DM;
    __syncthreads();
    for (int i = F.tid; i < DM; i += NTHREADS) { const float a = c[i], b = cctx[i]; sx[i] = a / (1.f + expf(-a)); sc[i] = b / (1.f + expf(-b)); }
    __syncthreads();
    for (int item = F.bid; item < 256; item += F.G) {
        const int l = item >> 7, col0 = (item & 127) * 96;
        const float* W = wmod + (size_t)l * DM * (6 * DM) + col0;
        const int c4 = F.tid % 24, rg = F.tid / 24;
        if (rg < 21) {
            f32x4 ax = {0.f, 0.f, 0.f, 0.f}, ac = {0.f, 0.f, 0.f, 0.f};
            for (int d0 = rg; d0 < DM; d0 += 21 * 7) {
                f32x4 w[7];
#pragma unroll
                for (int u = 0; u < 7; ++u) { const int d = d0 + 21 * u; w[u] = (d < DM) ? *(const f32x4*)(W + (size_t)d * (6 * DM) + c4 * 4) : (f32x4){0.f, 0.f, 0.f, 0.f}; }
#pragma unroll
                for (int u = 0; u < 7; ++u) { const int d = d0 + 21 * u; if (d < DM) { ax += sx[d] * w[u]; ac += sc[d] * w[u]; } }
            }
#pragma unroll
            for (int j = 0; j < 4; ++j) { red[(rg * 2 + 0) * 96 + c4 * 4 + j] = ac[j]; red[(rg * 2 + 1) * 96 + c4 * 4 + j] = ax[j]; }
        }
        __syncthreads();
        if (F.tid < 192) { const int w = F.tid / 96, col = F.tid % 96; float s = 0.f;
            for (int r = 0; r < 21; ++r) s += red[(r * 2 + w) * 96 + col];
            mod[((size_t)l * 2 + w) * (6 * DM) + col0 + col] = s + bmod[(size_t)l * 6 * DM + col0 + col]; }
        __syncthreads();
    }
}
__device__ __forceinline__ void small_tables(const Frame& F_, float* rope, const float* rw, float* rwT) {
    LOCAL_FRAME(F, F_);
    for (int i = F.bid * NTHREADS + F.tid; i < 128 * 32 + 128 * 16; i += F.G * NTHREADS) {
        if (i < 128 * 32) { const int pos = i >> 5, j = i & 31; const float inv = powf(10000.f, -(float)j / 32.f); const float a = (float)pos * inv; rope[i] = cosf(a); rope[128 * 32 + i] = sinf(a); }
        else { const int k = i - 128 * 32, pos = k >> 4, j = k & 15; const float inv = powf(10000.f, -(float)j / 16.f); const float a = (float)pos * inv; rope[2 * 128 * 32 + k] = cosf(a); rope[2 * 128 * 32 + 128 * 16 + k] = sinf(a); }
    }
    bf16_t* rh = (bf16_t*)rwT;
    for (int i = F.bid * NTHREADS + F.tid; i < 2 * DM * NEXP; i += F.G * NTHREADS) { const int l = i / (DM * NEXP), r = i % (DM * NEXP), d = r / NEXP, e = r % NEXP;
        const float w = rw[i]; const bf16_t hi = f2bf(w); rh[((size_t)(l * 2 + 0) * NEXP + e) * DM + d] = hi; rh[((size_t)(l * 2 + 1) * NEXP + e) * DM + d] = f2bf(w - bf2f(hi)); }
}
struct CvtTile { const float* src0; const float* src1; unsigned char* dst; int ld, dstrb  ; float scale; int ilv, f8; };
__device__ __forceinline__ void cvt_decode(int idx, const Args& a, unsigned char* ws, CvtTile& t) {
    constexpr int N_IN = 76 * 16, N_OUT = 32 * 16, N_GU = 65 * 16 * 16, N_DN = 65 * 32 * 4, PER_L = N_IN + N_OUT;
    const int l = idx / PER_L; int r = idx % PER_L;
    t.scale = 1.f; t.ilv = 0; t.f8 = 0;
    if (r < N_IN) { const int nt = r / 16, kt = r % 16; const float* W = a.in[I_WIN] + (size_t)l * DM * IN_W + (size_t)kt * 128 * IN_W;
        t.ld = IN_W; t.dstrb = DM * 2; t.dst = ws + WS_BTIN + (((size_t)l * ZW + nt * 64) * DM + kt * 128) * 2;
        if (nt < 24) { t.src0 = W + nt * 64; t.src1 = t.src0 + 32; if (nt < 4) t.scale = 0.125f; }
        else if (nt < 72) { t.src0 = W + nt * 64 + 32; t.src1 = t.src0 + 32; }
        else if (nt == 72) { t.src0 = W + 1536; t.src1 = nullptr; }
        else { t.src0 = nullptr; t.src1 = nullptr; }
        return; }
    r -= N_IN;
    if (r < N_OUT) { const int nt = r / 16, kt = r % 16; const float* W = a.in[I_WOUT] + (size_t)l * DM * DM + (size_t)kt * 128 * DM;
        t.ld = DM; t.dstrb = DM; t.f8 = 1; t.scale = 64.f; t.dst = ws + WS_BTOUT + ((size_t)l * DM + nt * 64) * DM + kt * 128; t.src0 = W + nt * 64; t.src1 = t.src0 + 32; return; }
    r -= N_OUT;
    if (r < N_GU) { const int e = r / 256, q = r % 256, nt = q / 16, kt = q % 16;
        const float* Wg = (e < NEXP) ? a.in[I_EWG] + ((size_t)l * NEXP + e) * DM * EH : a.in[I_SWG] + (size_t)l * DM * EH;
        const float* Wu = (e < NEXP) ? a.in[I_EWU] + ((size_t)l * NEXP + e) * DM * EH : a.in[I_SWU] + (size_t)l * DM * EH;
        t.ld = EH; t.dstrb = DM; t.ilv = 1; t.f8 = 1; t.scale = 64.f; t.dst = ws + WS_BTGU + (((size_t)l * 65 + e) * 1024 + nt * 64) * DM + kt * 128;
        t.src0 = Wg + (size_t)kt * 128 * EH + nt * 32; t.src1 = Wu + (size_t)kt * 128 * EH + nt * 32; return; }
    r -= N_GU;
    { const int e = r / 128, q = r % 128, nt = q / 4, kt = q % 4;
        const float* Wd = (e < NEXP) ? a.in[I_EWD] + ((size_t)l * NEXP + e) * EH * DM : a.in[I_SWD] + (size_t)l * EH * DM;
        t.ld = DM; t.dstrb = EH; t.f8 = 1; t.scale = 32.f; t.dst = ws + WS_BTD + (((size_t)l * 65 + e) * DM + nt * 64) * EH + kt * 128;
        t.src0 = Wd + (size_t)kt * 128 * DM + nt * 64; t.src1 = t.src0 + 32; }
}
constexpr int CVT_ITEMS = 2 * (76 * 16 + 32 * 16);
__device__ __forceinline__ void convert_weights(const Frame& F_, const Args& a) {
    LOCAL_FRAME(F, F_);
    constexpr int TSB = 272;
    LAS unsigned char* tile = F.lds;
    const int kq = F.tid >> 4, s4 = (F.tid & 15) * 4;
    const int rs = F.tid >> 3, rk = (F.tid & 7) * 16;
    f32x4 v[2][4]; CvtTile t[2];
    __syncthreads();
    int it = F.bid, par = 0;
#define CV_LOAD(p, T) do { const float* s_ = (s4 < 32) ? (T).src0 : (T).src1; const int so_ = (s4 < 32) ? s4 : s4 - 32; \
        _Pragma("unroll") for (int i = 0; i < 4; ++i) v[p][i] = s_ ? __builtin_nontemporal_load((const f32x4*)(s_ + (size_t)(4 * kq + i) * (T).ld + so_)) : (f32x4){0.f, 0.f, 0.f, 0.f}; } while (0)
    if (it < CVT_ITEMS) { cvt_decode(it, a, F.ws, t[0]); CV_LOAD(0, t[0]); }
    while (it < CVT_ITEMS) {
        const int nx = it + F.G;
        if (par == 0) { if (nx < CVT_ITEMS) { cvt_decode(nx, a, F.ws, t[1]); CV_LOAD(1, t[1]); } }
        else          { if (nx < CVT_ITEMS) { cvt_decode(nx, a, F.ws, t[0]); CV_LOAD(0, t[0]); } }
        LAS unsigned char* tb = tile + par * 64 * TSB;
#define CV_PROC(p) do { const float sc_ = t[p].scale; \
        const int drow_ = t[p].ilv ? ((rs < 32) ? (8 * (rs >> 2) + (rs & 3)) : (8 * ((rs - 32) >> 2) + 4 + (rs & 3))) : rs; \
        if (t[p].f8) { _Pragma("unroll") for (int j = 0; j < 4; ++j) *(LAS unsigned*)(tb + (s4 + j) * TSB + 4 * kq) = cvt4_fp8(v[p][0][j] * sc_, v[p][1][j] * sc_, v[p][2][j] * sc_, v[p][3][j] * sc_); \
            __syncthreads(); \
            *(u32x4*)(t[p].dst + (size_t)drow_ * t[p].dstrb + rk) = *(const LAS u32x4*)(tb + rs * TSB + rk); } \
        else { _Pragma("unroll") for (int j = 0; j < 4; ++j) { u32x2 w_; w_.x = cvt_pk_bf16(v[p][0][j] * sc_, v[p][1][j] * sc_); w_.y = cvt_pk_bf16(v[p][2][j] * sc_, v[p][3][j] * sc_); *(LAS u32x2*)(tb + (s4 + j) * TSB + 8 * kq) = w_; } \
            __syncthreads(); \
            const u32x4 w0_ = *(const LAS u32x4*)(tb + rs * TSB + rk * 2), w1_ = *(const LAS u32x4*)(tb + rs * TSB + rk * 2 + 16); \
            u32x4* dp_ = (u32x4*)(t[p].dst + (size_t)drow_ * t[p].dstrb + rk * 2); dp_[0] = w0_; dp_[1] = w1_; } } while (0)
        if (par == 0) CV_PROC(0); else CV_PROC(1);
        it = nx; par ^= 1;
    }
    __syncthreads();
#undef CV_LOAD
#undef CV_PROC
}

__device__ __forceinline__ void norm_mod_row(const float* xr, bf16_t* xcopy, const float* g, const float* sh, const float* sc, bf16_t* out, int lane) {
    f32x4 v[8]; float ss = 0.f;
#pragma unroll
    for (int k = 0; k < 8; ++k) { v[k] = *(const f32x4*)(xr + k * 256 + lane * 4); ss += v[k][0] * v[k][0] + v[k][1] * v[k][1] + v[k][2] * v[k][2] + v[k][3] * v[k][3]; }
    ss = wave_sum(ss);
    const float rs = rsqrtf(ss * (1.f / DM) + NORM_EPS);
#pragma unroll
    for (int k = 0; k < 8; ++k) { const int i = k * 256 + lane * 4;
        const f32x4 gg = *(const f32x4*)(g + i), s0 = *(const f32x4*)(sh + i), s1 = *(const f32x4*)(sc + i);
        const f32x4 y = v[k] * rs * gg * (s1 + 1.f) + s0;
        u32x2 w; w.x = cvt_pk_bf16(y[0], y[1]); w.y = cvt_pk_bf16(y[2], y[3]);
        *(u32x2*)(out + i) = w;
        if (xcopy) { u32x2 xw; xw.x = cvt_pk_bf16(v[k][0], v[k][1]); xw.y = cvt_pk_bf16(v[k][2], v[k][3]); *(u32x2*)(xcopy + i) = xw; } }
}
__device__ __forceinline__ void phase_norm1(const Frame& F_, const Args& a) {
    LOCAL_FRAME(F, F_);
    bf16_t* X = (bf16_t*)(F.ws + WS_X); bf16_t* A = (bf16_t*)(F.ws + WS_A); const float* mod = (const float*)(F.ws + WS_MOD);
    for (int r = F.bid * 8 + F.wave; r < NTOK; r += F.G * 8) {
        const bool isctx = r < NCTX;
        const float* src = isctx ? a.in[I_CTX] + (size_t)r * DM : a.in[I_X] + (size_t)(r - NCTX) * DM;
        const float* m = mod + (size_t)(isctx ? 0 : 1) * 6 * DM;
        norm_mod_row(src, X + (size_t)r * DM, a.in[I_N1G], m, m + DM, A + (size_t)r * DM, F.lane);
    }
}

__device__ __forceinline__ void qk_prep(const Frame& F_, const Args& a, int l, int dummy) {
    LOCAL_FRAME(F, F_);
    const bf16_t* Z = (const bf16_t*)(F.ws + WS_Z); bf16_t* Zo = (bf16_t*)(F.ws + (dummy ? WS_DUMMY : 0) + WS_Z);
    const float* rope = (const float*)(F.ws + WS_ROPE);
    const float* cg = rope; const float* sg = rope + 128 * 32; const float* cd = rope + 2 * 128 * 32; const float* sd = cd + 128 * 16;
    const float* qng = a.in[I_QNG] + l * 128; const float* kng = a.in[I_KNG] + l * 128;
#define QK_UNPACK(W_, X_) do { X_[0] = bflo(W_[0]); X_[1] = bfhi(W_[0]); X_[2] = bflo(W_[1]); X_[3] = bfhi(W_[1]); X_[4] = bflo(W_[2]); X_[5] = bfhi(W_[2]); X_[6] = bflo(W_[3]); X_[7] = bfhi(W_[3]); } while (0)
    { const int sub = F.tid & 7, half = sub >> 2, j0 = (sub & 3) * 8;
      for (int g0 = F.bid * 64; g0 < NTOK * 10; g0 += F.G * 64) {
        const int g = g0 + (F.tid >> 3);
        if (g < NTOK * 10) {
            const int t = g / 10, hv = g - t * 10; const int col = ((hv < 8) ? ZC_AQ + hv * 128 : ZC_AK + (hv - 8) * 128) + half * 64 + j0;
            const float* gn = ((hv < 8) ? qng : kng) + half * 64 + j0;
            const u32x4 w1 = *(const u32x4*)(Z + (size_t)t * ZW + col), w2 = *(const u32x4*)(Z + (size_t)t * ZW + col + 32);
            const f32x4 ga = *(const f32x4*)gn, gb = *(const f32x4*)(gn + 4), gc = *(const f32x4*)(gn + 32), gd = *(const f32x4*)(gn + 36);
            const bool lat = t >= NCTX; const int p = t - NCTX, pos = lat ? (half == 0 ? (p >> 6) : (p & 63)) : 0;
            const f32x4 ca = *(const f32x4*)(cg + pos * 32 + j0), cb = *(const f32x4*)(cg + pos * 32 + j0 + 4), sa = *(const f32x4*)(sg + pos * 32 + j0), sb = *(const f32x4*)(sg + pos * 32 + j0 + 4);
            float x1[8], x2[8]; QK_UNPACK(w1, x1); QK_UNPACK(w2, x2);
            float ss = 0.f;
#pragma unroll
            for (int i = 0; i < 8; ++i) ss += x1[i] * x1[i] + x2[i] * x2[i];
            ss += __shfl_xor(ss, 1, 64); ss += __shfl_xor(ss, 2, 64); ss += __shfl_xor(ss, 4, 64);
            const float rs = rsqrtf(ss * (1.f / 128.f) + NORM_EPS);
            float o1[8], o2[8];
#pragma unroll
            for (int i = 0; i < 8; ++i) { const float g1 = (i < 4) ? ga[i & 3] : gb[i & 3], g2 = (i < 4) ? gc[i & 3] : gd[i & 3];
                const float cs = lat ? ((i < 4) ? ca[i & 3] : cb[i & 3]) : 1.f, sn = lat ? ((i < 4) ? sa[i & 3] : sb[i & 3]) : 0.f;
                const float y1 = x1[i] * rs * g1, y2 = x2[i] * rs * g2; o1[i] = y1 * cs - y2 * sn; o2[i] = y2 * cs + y1 * sn; }
            u32x4 r1, r2; r1.x = cvt_pk_bf16(o1[0], o1[1]); r1.y = cvt_pk_bf16(o1[2], o1[3]); r1.z = cvt_pk_bf16(o1[4], o1[5]); r1.w = cvt_pk_bf16(o1[6], o1[7]);
            r2.x = cvt_pk_bf16(o2[0], o2[1]); r2.y = cvt_pk_bf16(o2[2], o2[3]); r2.z = cvt_pk_bf16(o2[4], o2[5]); r2.w = cvt_pk_bf16(o2[6], o2[7]);
            *(u32x4*)(Zo + (size_t)t * ZW + col) = r1; *(u32x4*)(Zo + (size_t)t * ZW + col + 32) = r2;
        } } }
    { const int sub = F.tid & 3, half = sub >> 1, j0 = (sub & 1) * 8;
      for (int g0 = F.bid * 128; g0 < (NTOK - NCTX) * 16; g0 += F.G * 128) {
        const int g = g0 + (F.tid >> 2);
        if (g < (NTOK - NCTX) * 16) {
            const int p = g >> 4, vi = g & 15, t = p + NCTX; const int col = ((vi < 8) ? ZC_DQ + vi * 64 : ZC_DK + (vi - 8) * 64) + half * 32 + j0;
            const u32x4 w1 = *(const u32x4*)(Z + (size_t)t * ZW + col), w2 = *(const u32x4*)(Z + (size_t)t * ZW + col + 16);
            const int pos = half == 0 ? (p >> 6) : (p & 63);
            const f32x4 ca = *(const f32x4*)(cd + pos * 16 + j0), cb = *(const f32x4*)(cd + pos * 16 + j0 + 4), sa = *(const f32x4*)(sd + pos * 16 + j0), sb = *(const f32x4*)(sd + pos * 16 + j0 + 4);
            float x1[8], x2[8]; QK_UNPACK(w1, x1); QK_UNPACK(w2, x2);
            float o1[8], o2[8];
#pragma unroll
            for (int i = 0; i < 8; ++i) { const float cs = (i < 4) ? ca[i & 3] : cb[i & 3], sn = (i < 4) ? sa[i & 3] : sb[i & 3]; o1[i] = x1[i] * cs - x2[i] * sn; o2[i] = x2[i] * cs + x1[i] * sn; }
            u32x4 r1, r2; r1.x = cvt_pk_bf16(o1[0], o1[1]); r1.y = cvt_pk_bf16(o1[2], o1[3]); r1.z = cvt_pk_bf16(o1[4], o1[5]); r1.w = cvt_pk_bf16(o1[6], o1[7]);
            r2.x = cvt_pk_bf16(o2[0], o2[1]); r2.y = cvt_pk_bf16(o2[2], o2[3]); r2.z = cvt_pk_bf16(o2[4], o2[5]); r2.w = cvt_pk_bf16(o2[6], o2[7]);
            *(u32x4*)(Zo + (size_t)t * ZW + col) = r1; *(u32x4*)(Zo + (size_t)t * ZW + col + 16) = r2;
        } } }
#undef QK_UNPACK
}

__device__ __forceinline__ void gla_prep_unit(const Frame& F, const Args& a, int l, int n, int h) {
    const bf16_t* Z = (const bf16_t*)(F.ws + WS_Z); bf16_t* GQK = (bf16_t*)(F.ws + WS_GQK); bf16_t* GVT = (bf16_t*)(F.ws + WS_GVT);
    float* GU = (float*)(F.ws + WS_GU); float* GG = (float*)(F.ws + WS_GG);
    LAS unsigned char* L = F.lds;
    LAS float* zz = (LAS float*)L;
    LAS float* waf = (LAS float*)(L + 8192);
    LAS float* wab = (LAS float*)(L + 12288);
    LAS float* baf = (LAS float*)(L + 16384);
    LAS float* bab = (LAS float*)(L + 16640);
    LAS float* LF = (LAS float*)(L + 17408);
    LAS float* LB = (LAS float*)(L + 34304);
    LAS float* segF = (LAS float*)(L + 51200);
    LAS float* segB = (LAS float*)(L + 53248);
    LAS bf16_t* keTf = (LAS bf16_t*)(L + 55296);
    LAS bf16_t* keTb = (LAS bf16_t*)(L + 64512);
    LAS bf16_t* vT = (LAS bf16_t*)(L + 73728);
    int tz0 = threadIdx.x; asm volatile("" : "+v"(tz0));
    const int tid = tz0, tok0 = n * 64;
    __syncthreads();
    if (tid < 256) { const int c = tid >> 2, p8 = (tid & 3) * 8; const u32x4 w = *(const u32x4*)(Z + (size_t)(tok0 + c) * ZW + ZC_DEC + p8);
        LAS float* d = zz + c * 32 + p8; d[0] = bflo(w.x); d[1] = bfhi(w.x); d[2] = bflo(w.y); d[3] = bfhi(w.y); d[4] = bflo(w.z); d[5] = bfhi(w.z); d[6] = bflo(w.w); d[7] = bfhi(w.w); }
    for (int i = tid; i < 1024; i += NTHREADS) { const int r = i >> 6, d = i & 63; waf[i] = a.in[I_WAF][((size_t)l * 16 + r) * 256 + h * 64 + d]; wab[i] = a.in[I_WAB][((size_t)l * 16 + r) * 256 + h * 64 + d]; }
    if (tid < 64) { baf[tid] = a.in[I_BAF][l * 256 + h * 64 + tid]; bab[tid] = a.in[I_BAB][l * 256 + h * 64 + tid]; }
    __syncthreads();
    const int c = tid >> 3, d8 = (tid & 7) * 8;
    { float af[8], ab[8];
#pragma unroll
      for (int e = 0; e < 8; ++e) { af[e] = baf[d8 + e]; ab[e] = bab[d8 + e]; }
#pragma unroll
      for (int r = 0; r < 16; ++r) { const float zf = zz[c * 32 + r], zb = zz[c * 32 + 16 + r];
#pragma unroll
          for (int e = 0; e < 8; ++e) { af[e] += zf * waf[r * 64 + d8 + e]; ab[e] += zb * wab[r * 64 + d8 + e]; } }
#pragma unroll
      for (int e = 0; e < 8; ++e) { LF[c * 65 + d8 + e] = logsigmoid_f(af[e]) * (1.f / 16.f); LB[c * 65 + d8 + e] = logsigmoid_f(ab[e]) * (1.f / 16.f); } }
    __syncthreads();
    { const int d = tid & 63, seg = tid >> 6; float run = 0.f;
#pragma unroll
      for (int i = 0; i < 8; ++i) { run += LF[(8 * seg + i) * 65 + d]; LF[(8 * seg + i) * 65 + d] = run; }
      segF[seg * 64 + d] = run; run = 0.f;
#pragma unroll
      for (int i = 7; i >= 0; --i) { run += LB[(8 * seg + i) * 65 + d]; LB[(8 * seg + i) * 65 + d] = run; }
      segB[seg * 64 + d] = run; }
    __syncthreads();
    { const int d = tid & 63, seg = tid >> 6; float of = 0.f, ob = 0.f;
      for (int s = 0; s < 8; ++s) { if (s < seg) of += segF[s * 64 + d]; if (s > seg) ob += segB[s * 64 + d]; }
#pragma unroll
      for (int i = 0; i < 8; ++i) { LF[(8 * seg + i) * 65 + d] += of; LB[(8 * seg + i) * 65 + d] += ob; } }
    __syncthreads();
    { const size_t zrow = (size_t)(tok0 + c) * ZW;
      const u32x4 qw = *(const u32x4*)(Z + zrow + ZC_GQ + h * 64 + d8), kw = *(const u32x4*)(Z + zrow + ZC_GK + h * 64 + d8);
      float q[8] = {bflo(qw.x), bfhi(qw.x), bflo(qw.y), bfhi(qw.y), bflo(qw.z), bfhi(qw.z), bflo(qw.w), bfhi(qw.w)};
      float k[8] = {bflo(kw.x), bfhi(kw.x), bflo(kw.y), bfhi(kw.y), bflo(kw.z), bfhi(kw.z), bflo(kw.w), bfhi(kw.w)};
      float qdf[8], kif[8], qdb[8], kib[8];
#pragma unroll
      for (int e = 0; e < 8; ++e) { const float cf = LF[c * 65 + d8 + e], cb = LB[c * 65 + d8 + e];
          qdf[e] = q[e] * __expf(cf); kif[e] = k[e] * __expf(-cf); qdb[e] = q[e] * __expf(cb); kib[e] = k[e] * __expf(-cb);
          keTf[(d8 + e) * 72 + c] = f2bf(k[e] * __expf(LF[63 * 65 + d8 + e] - cf)); keTb[(d8 + e) * 72 + c] = f2bf(k[e] * __expf(LB[d8 + e] - cb)); }
      bf16_t* go = GQK + (size_t)(tok0 + c) * 1024 + h * 64 + d8;
#define PK8(x) (u32x4){cvt_pk_bf16(x[0], x[1]), cvt_pk_bf16(x[2], x[3]), cvt_pk_bf16(x[4], x[5]), cvt_pk_bf16(x[6], x[7])}
      *(u32x4*)(go) = PK8(qdf); *(u32x4*)(go + 256) = PK8(kif); *(u32x4*)(go + 512) = PK8(qdb); *(u32x4*)(go + 768) = PK8(kib);
#undef PK8
#pragma unroll
      for (int i = 0; i < 2; ++i) { const int p = tid + NTHREADS * i, cc = p >> 4, v8 = (p & 15) * 8; const u32x4 w = *(const u32x4*)(Z + (size_t)(tok0 + cc) * ZW + ZC_GV + h * 128 + v8);
          vT[(v8 + 0) * 72 + cc] = (bf16_t)(w.x & 0xffff); vT[(v8 + 1) * 72 + cc] = (bf16_t)(w.x >> 16); vT[(v8 + 2) * 72 + cc] = (bf16_t)(w.y & 0xffff); vT[(v8 + 3) * 72 + cc] = (bf16_t)(w.y >> 16);
          vT[(v8 + 4) * 72 + cc] = (bf16_t)(w.z & 0xffff); vT[(v8 + 5) * 72 + cc] = (bf16_t)(w.z >> 16); vT[(v8 + 6) * 72 + cc] = (bf16_t)(w.w & 0xffff); vT[(v8 + 7) * 72 + cc] = (bf16_t)(w.w >> 16); }
      if (tid < 64) GG[((size_t)(n * 4 + h) * 2 + 0) * 64 + tid] = __expf(LF[63 * 65 + tid]);
      else if (tid < 128) GG[((size_t)(n * 4 + h) * 2 + 1) * 64 + tid - 64] = __expf(LB[tid - 64]); }
    __syncthreads();
    { const int v = tid >> 2, c16 = (tid & 3) * 16; const u32x4 w0 = *(const LAS u32x4*)(vT + v * 72 + c16), w1 = *(const LAS u32x4*)(vT + v * 72 + c16 + 8);
      u32x4* dp = (u32x4*)(GVT + ((size_t)(n * 4 + h) * 128 + v) * 64 + c16); dp[0] = w0; dp[1] = w1; }
    { const int w = tid >> 6, vb = w >> 1, db = w & 1, r32 = tid & 31, hi = (tid >> 5) & 1;
#pragma unroll
      for (int dir = 0; dir < 2; ++dir) { LAS bf16_t* keT = dir ? keTb : keTf; f32x16 acc = {};
#pragma unroll
          for (int ks = 0; ks < 4; ++ks) { const bf16x8 A = *(const LAS bf16x8*)(vT + (vb * 32 + r32) * 72 + 16 * ks + 8 * hi), B = *(const LAS bf16x8*)(keT + (db * 32 + r32) * 72 + 16 * ks + 8 * hi);
              acc = __builtin_amdgcn_mfma_f32_32x32x16_bf16(A, B, acc, 0, 0, 0); }
          float* up = GU + ((size_t)(n * 4 + h) * 2 + dir) * 8192;
#pragma unroll
          for (int r = 0; r < 16; ++r) up[(vb * 32 + attn::crow(r, hi)) * 64 + db * 32 + r32] = acc[r]; } }
}
__device__ __forceinline__ void gla_scan(const Frame& F_) {
    LOCAL_FRAME(F, F_);
    const float* GU = (const float*)(F.ws + WS_GU); const float* GG = (const float*)(F.ws + WS_GG); bf16_t* GS = (bf16_t*)(F.ws + WS_GS);
    constexpr int NS = 4, HS = NCHUNK / NS; static_assert(NCHUNK % NS == 0, "equal segments");
    LAS float* cs = (LAS float*)F.lds;
    LAS float* cp = cs + NS * 128;
    const int per = (4 * 2 * 8192 + F.G - 1) / F.G;
    __syncthreads();
    for (int base = 0; base < per; base += 128) {
        const int cl = F.tid & 127, ci = base + cl, seg = F.tid >> 7, g = F.bid * per + ci; const bool ok = ci < per && g < 4 * 2 * 8192;
        const int d = g & 63, vd = g & 8191, dir = (g >> 13) & 1, h = g >> 14;
        float uu[HS], gg[HS];
#define GS_OFF(i) ({ const int step_ = seg * HS + (i); const int nn_ = dir == 0 ? step_ : (step_ < 4 ? 3 - step_ : NCHUNK + 3 - step_); (nn_ * 4 + h) * 2 + dir; })
#pragma unroll
        for (int i = 0; i < HS; ++i) { const int ob = ok ? GS_OFF(i) : 0; uu[i] = GU[(size_t)ob * 8192 + vd]; gg[i] = GG[ob * 64 + d]; }
        float s = 0.f, P = 1.f;
#pragma unroll
        for (int i = 0; i < HS; ++i) { const float u = uu[i], gd = gg[i]; uu[i] = s; gg[i] = P; s = gd * s + u; P *= gd; }
        cs[seg * 128 + cl] = s; cp[seg * 128 + cl] = P;
        __syncthreads();
        float s_in = 0.f;
        for (int k = 0; k < seg; ++k) s_in = cp[k * 128 + cl] * s_in + cs[k * 128 + cl];
        if (ok) {
#pragma unroll
            for (int i = 0; i < HS; ++i) GS[(size_t)GS_OFF(i) * 8192 + vd] = f2bf(uu[i] + gg[i] * s_in); }
        __syncthreads();
#undef GS_OFF
    }
}
__device__ __forceinline__ void gla_out_unit(const Frame& F, const Args& a, int l, int n, int h, int dummy = 0) {
    const bf16_t* Z = (const bf16_t*)(F.ws + WS_Z); const bf16_t* GQK = (const bf16_t*)(F.ws + WS_GQK); const bf16_t* GVT = (const bf16_t*)(F.ws + WS_GVT);
    const bf16_t* GS = (const bf16_t*)(F.ws + WS_GS); unsigned char* MIX = F.ws + (dummy ? WS_DUMMY : 0) + WS_MIX;
    LAS bf16_t* T = (LAS bf16_t*)F.lds;
    LAS float* ssq = (LAS float*)(F.lds + 92160);
    int tz0 = threadIdx.x; asm volatile("" : "+v"(tz0));
    const int tid = tz0, tok0 = n * 64;
    __syncthreads();
    { const int c = tid >> 3, d8 = (tid & 7) * 8; const bf16_t* gp = GQK + (size_t)(tok0 + c) * 1024 + h * 64 + d8;
#pragma unroll
      for (int kd = 0; kd < 4; ++kd) *(LAS u32x4*)(T + kd * 4608 + c * 72 + d8) = *(const u32x4*)(gp + kd * 256);
#pragma unroll
      for (int i = 0; i < 2; ++i) { const int p = tid + NTHREADS * i, v = p >> 3, c8 = (p & 7) * 8;
          *(LAS u32x4*)(T + 18432 + v * 72 + c8) = *(const u32x4*)(GVT + ((size_t)(n * 4 + h) * 128 + v) * 64 + c8);
          *(LAS u32x4*)(T + 27648 + v * 72 + c8) = *(const u32x4*)(GS + ((size_t)(n * 4 + h) * 2 + 0) * 8192 + v * 64 + c8);
          *(LAS u32x4*)(T + 36864 + v * 72 + c8) = *(const u32x4*)(GS + ((size_t)(n * 4 + h) * 2 + 1) * 8192 + v * 64 + c8); } }
    __syncthreads();
    const int w = tid >> 6, cb = w & 1, vb = w >> 1, r32 = tid & 31, hi = (tid >> 5) & 1;
    f32x16 O = {};
#pragma unroll
    for (int dir = 0; dir < 2; ++dir) {
        LAS bf16_t* Q = T + (dir ? 9216 : 0); LAS bf16_t* Kt = T + (dir ? 13824 : 4608); LAS bf16_t* ST = T + (dir ? 36864 : 27648); LAS bf16_t* vT = T + 18432;
        bf16x8 qf[4];
#pragma unroll
        for (int ks = 0; ks < 4; ++ks) qf[ks] = *(const LAS bf16x8*)(Q + (cb * 32 + r32) * 72 + 16 * ks + 8 * hi);
#pragma unroll
        for (int ks = 0; ks < 4; ++ks) { const bf16x8 B = *(const LAS bf16x8*)(ST + (vb * 32 + r32) * 72 + 16 * ks + 8 * hi); O = __builtin_amdgcn_mfma_f32_32x32x16_bf16(qf[ks], B, O, 0, 0, 0); }
#pragma unroll
        for (int sb = 0; sb < 2; ++sb) {
            if ((dir == 0 && sb > cb) || (dir == 1 && sb < cb)) continue;
            f32x16 X = {};
#pragma unroll
            for (int ks = 0; ks < 4; ++ks) { const bf16x8 A = *(const LAS bf16x8*)(Kt + (sb * 32 + r32) * 72 + 16 * ks + 8 * hi); X = __builtin_amdgcn_mfma_f32_32x32x16_bf16(A, qf[ks], X, 0, 0, 0); }
            if (sb == cb) {
#pragma unroll
                for (int r = 0; r < 16; ++r) { const int s = attn::crow(r, hi); const bool keep = dir == 0 ? (s <= r32) : (s >= r32); X[r] = keep ? X[r] : 0.f; } }
#pragma unroll
            for (int kk = 0; kk < 2; ++kk) {
                u32x4 pw = {cvt_pk_bf16(X[8 * kk + 0], X[8 * kk + 1]), cvt_pk_bf16(X[8 * kk + 2], X[8 * kk + 3]), cvt_pk_bf16(X[8 * kk + 4], X[8 * kk + 5]), cvt_pk_bf16(X[8 * kk + 6], X[8 * kk + 7])};
                const bf16x8 pa = *reinterpret_cast<bf16x8*>(&pw);
                const u32x2 lo = *(const LAS u32x2*)(vT + (vb * 32 + r32) * 72 + sb * 32 + 16 * kk + 4 * hi), hh = *(const LAS u32x2*)(vT + (vb * 32 + r32) * 72 + sb * 32 + 16 * kk + 8 + 4 * hi);
                u32x4 bw = {lo.x, lo.y, hh.x, hh.y};
                O = __builtin_amdgcn_mfma_f32_32x32x16_bf16(pa, *reinterpret_cast<bf16x8*>(&bw), O, 0, 0, 0); }
        }
    }
#pragma unroll
    for (int r = 0; r < 16; ++r) { float ss = O[r] * O[r];
#pragma unroll
        for (int s = 16; s >= 1; s >>= 1) ss += __shfl_xor(ss, s, 64);
        if (r32 == 0) ssq[(cb * 32 + attn::crow(r, hi)) * 4 + vb] = ss; }
    __syncthreads();
    const float gn = a.in[I_GLAG][l * 128 + vb * 32 + r32];
#pragma unroll
    for (int r = 0; r < 16; ++r) { const int c = cb * 32 + attn::crow(r, hi); const f32x4 q4 = *(const LAS f32x4*)(ssq + c * 4);
        const float rs = rsqrtf((q4[0] + q4[1] + q4[2] + q4[3]) * (1.f / 128.f) + NORM_EPS);
        const float gate = bf2f(Z[(size_t)(tok0 + c) * ZW + ZC_GG + h * 128 + vb * 32 + r32]);
        const float on = O[r] * rs * gn;
        MIX[(size_t)(tok0 + c) * DM + h * 128 + vb * 32 + r32] = f2fp8_x16(on * silu_f(gate)); }
}
__device__ __forceinline__ void phase_router(const Frame& F_, const Args& a, int l, int tok0, int ntok, int dummy) {
    LOCAL_FRAME(F, F_);
    unsigned char* wso = F.ws + (dummy ? WS_DUMMY : 0);
    const bf16_t* X = (const bf16_t*)(F.ws + WS_X); unsigned char* A8 = F.ws + WS_A8;
    const float* mod = (const float*)(F.ws + WS_MOD) + (size_t)l * 2 * 6 * DM;
    const bf16_t* RH = (const bf16_t*)(F.ws + WS_RWT) + (size_t)l * 2 * NEXP * DM; const bf16_t* RL = RH + (size_t)NEXP * DM;
    const float* rb = a.in[I_RB] + l * NEXP; const float* n2g = a.in[I_N2G] + (size_t)l * DM;
    unsigned* cnt = (unsigned*)(F.ws + WS_CTL) + (dummy ? CW_CNTD : CW_CNT) + l * NEXP;
    int* list = (int*)(wso + WS_LIST); int* toke = (int*)(wso + WS_TOKE); int* tokp = (int*)(wso + WS_TOKP); float* tokw = (float*)(wso + WS_TOKW);
    constexpr int BT = 17;
    LAS unsigned char* up = F.lds + LDS_STAGE + LDS_MISC;
#define RT_HI(r) (F.lds + (r) * 4096)
#define RT_LO(r) (((r) < 15) ? F.lds + 69632 + (r) * 4096 : up + ((r) - 15) * 4096)
    LAS float* part = (LAS float*)(up + 8192);
    LAS int* selE = (LAS int*)(up + 8192 + 8704);
    LAS float* selW = (LAS float*)(up + 8192 + 8704 + 1536);
    LAS int* selR = (LAS int*)(up + 8192 + 8704 + 3072);
    LAS int* hist = (LAS int*)(up + 8192 + 8704 + 4608);
    LAS int* base = (LAS int*)(up + 8192 + 8704 + 4864);
    const int lane = F.lane;
    const int per = (ntok + F.G - 1) / F.G;
    const int t0 = F.bid * per, t1 = (t0 + per < ntok) ? t0 + per : ntok, nmine = t1 > t0 ? t1 - t0 : 0;
    __syncthreads();
    if (F.tid < 64) hist[F.tid] = 0;
    u32x2 xw[3][8];
#define RT_LOADX(b) do { _Pragma("unroll") for (int q = 0; q < 3; ++q) { const int jl_ = F.wave + 8 * q, j_ = (b) * BT + jl_; if (jl_ < BT) { \
        const bf16_t* xr_ = X + (size_t)(tok0 + t0 + (j_ < nmine ? j_ : 0)) * DM; \
        _Pragma("unroll") for (int k = 0; k < 8; ++k) xw[q][k] = *(const u32x2*)(xr_ + k * 256 + lane * 4); } } } while (0)
    if (nmine > 0) RT_LOADX(0);
    for (int b = 0; b * BT < nmine; ++b) {
#pragma unroll
        for (int q = 0; q < 3; ++q) { const int jl = F.wave + 8 * q, j = b * BT + jl;
            if (jl < BT && j < nmine) { const int t = tok0 + t0 + j; const float* m = mod + (size_t)(t < NCTX ? 0 : 1) * 6 * DM;
                LAS unsigned char* hr = RT_HI(jl); LAS unsigned char* lr = RT_LO(jl);
                f32x4 v[8]; float ss = 0.f;
#pragma unroll
                for (int k = 0; k < 8; ++k) { v[k] = (f32x4){bflo(xw[q][k].x), bfhi(xw[q][k].x), bflo(xw[q][k].y), bfhi(xw[q][k].y)}; ss += v[k][0] * v[k][0] + v[k][1] * v[k][1] + v[k][2] * v[k][2] + v[k][3] * v[k][3]; }
                ss = wave_sum(ss); const float rs = rsqrtf(ss * (1.f / DM) + NORM_EPS);
#pragma unroll
                for (int k = 0; k < 8; ++k) { const int i = k * 256 + lane * 4;
                    const f32x4 gg = *(const f32x4*)(n2g + i), s0 = *(const f32x4*)(m + 3 * DM + i), s1 = *(const f32x4*)(m + 4 * DM + i);
                    const f32x4 y = v[k] * rs * gg * (s1 + 1.f) + s0;
                    u32x2 wh; wh.x = cvt_pk_bf16(y[0], y[1]); wh.y = cvt_pk_bf16(y[2], y[3]);
                    u32x2 wl; wl.x = cvt_pk_bf16(y[0] - bflo(wh.x), y[1] - bfhi(wh.x)); wl.y = cvt_pk_bf16(y[2] - bflo(wh.y), y[3] - bfhi(wh.y));
                    const int sb = (i * 2) ^ ((jl & 15) << 4);
                    *(LAS u32x2*)(hr + sb) = wh; *(LAS u32x2*)(lr + sb) = wl;
                    *(unsigned*)(A8 + (size_t)t * DM + i) = cvt4_fp8(y[0], y[1], y[2], y[3]); } } }
        if ((b + 1) * BT < nmine) RT_LOADX(b + 1);
        __syncthreads();
        { const int i16 = lane & 15, k4 = lane >> 4, nt = F.wave & 3, kh = F.wave >> 2;
          const bool two = (b * BT + 16) < nmine;
          f32x4 acc0 = {0.f, 0.f, 0.f, 0.f}, acc1 = acc0;
          const bf16_t* bhp = RH + (size_t)(nt * 16 + i16) * DM + kh * 1024 + 8 * k4; const bf16_t* blp = RL + (size_t)(nt * 16 + i16) * DM + kh * 1024 + 8 * k4;
          LAS unsigned char* h0 = RT_HI(i16); LAS unsigned char* l0 = RT_LO(i16); LAS unsigned char* h1 = RT_HI(16); LAS unsigned char* l1 = RT_LO(16);
          constexpr int PG = 4;
          bf16x8 bh[PG], bl[PG];
#pragma unroll
          for (int u = 0; u < PG; ++u) { bh[u] = *(const bf16x8*)(bhp + u * 32); bl[u] = *(const bf16x8*)(blp + u * 32); }
#pragma unroll
          for (int g = 0; g < 32 / PG; ++g) { bf16x8 nh[PG], nl[PG];
              if (g + 1 < 32 / PG) {
#pragma unroll
                  for (int u = 0; u < PG; ++u) { nh[u] = *(const bf16x8*)(bhp + ((g + 1) * PG + u) * 32); nl[u] = *(const bf16x8*)(blp + ((g + 1) * PG + u) * 32); } }
#pragma unroll
              for (int u = 0; u < PG; ++u) { const int kb = (kh * 1024 + (g * PG + u) * 32 + 8 * k4) * 2;
                  const bf16x8 ah = *(const LAS bf16x8*)(h0 + (kb ^ (i16 << 4))), al = *(const LAS bf16x8*)(l0 + (kb ^ (i16 << 4)));
                  acc0 = __builtin_amdgcn_mfma_f32_16x16x32_bf16(al, bh[u], acc0, 0, 0, 0);
                  acc0 = __builtin_amdgcn_mfma_f32_16x16x32_bf16(ah, bl[u], acc0, 0, 0, 0);
                  acc0 = __builtin_amdgcn_mfma_f32_16x16x32_bf16(ah, bh[u], acc0, 0, 0, 0);
                  if (two) { const bf16x8 ch = *(const LAS bf16x8*)(h1 + kb), cl = *(const LAS bf16x8*)(l1 + kb);
                      acc1 = __builtin_amdgcn_mfma_f32_16x16x32_bf16(cl, bh[u], acc1, 0, 0, 0);
                      acc1 = __builtin_amdgcn_mfma_f32_16x16x32_bf16(ch, bl[u], acc1, 0, 0, 0);
                      acc1 = __builtin_amdgcn_mfma_f32_16x16x32_bf16(ch, bh[u], acc1, 0, 0, 0); } }
              if (g + 1 < 32 / PG) {
#pragma unroll
                  for (int u = 0; u < PG; ++u) { bh[u] = nh[u]; bl[u] = nl[u]; } } }
#pragma unroll
          for (int r = 0; r < 4; ++r) part[(kh * BT + 4 * k4 + r) * 64 + nt * 16 + i16] = acc0[r];
          if (two && k4 == 0) part[(kh * BT + 16) * 64 + nt * 16 + i16] = acc1[0]; }
        __syncthreads();
#pragma unroll 1
        for (int q = 0; q < 3; ++q) { const int jl = F.wave + 8 * q, j = b * BT + jl; if (jl >= BT || j >= nmine) break;
            const float lg = part[jl * 64 + lane] + part[(BT + jl) * 64 + lane];
            const float s = sigmoid_f(lg); float sv = s + rb[lane]; float ssum = 0.f, mys = 0.f; int myk = -1;
#pragma unroll
            for (int k = 0; k < TOPK; ++k) { const float mx = wave_max(sv); const unsigned long long bal = __ballot(sv == mx); const int win = __ffsll((long long)bal) - 1;
                const float ws_ = __shfl(s, win, 64); ssum += ws_; if (lane == win) { sv = -3.0e38f; myk = k; mys = s; } }
            if (myk >= 0) { const int rank = atomicAdd((int*)&hist[lane], 1); selE[j * 8 + myk] = lane; selW[j * 8 + myk] = mys / ssum * 2.5f; selR[j * 8 + myk] = rank; } }
    }
#undef RT_LOADX
#undef RT_HI
#undef RT_LO
    __syncthreads();
    if (F.tid < 64) base[F.tid] = hist[F.tid] > 0 ? (int)atomicAdd(&cnt[F.tid], (unsigned)hist[F.tid]) : 0;
    __syncthreads();
    for (int i = F.tid; i < nmine * 8; i += NTHREADS) { const int j = i >> 3, k = i & 7; const int tglob = tok0 + t0 + j; const int e = selE[i], pos = base[e] + selR[i];
        list[(size_t)e * NTOK + pos] = tglob; toke[(size_t)tglob * 8 + k] = e; tokp[(size_t)tglob * 8 + k] = pos; tokw[(size_t)tglob * 8 + k] = selW[i]; }
}

__device__ __forceinline__ void phase_combine(const Frame& F_, const Args& a, int l, int tok0, int ntok, int dummy) {
    LOCAL_FRAME(F, F_);
    unsigned char* wso = F.ws + (dummy ? WS_DUMMY : 0);
    const bf16_t* X = (const bf16_t*)(F.ws + WS_X); bf16_t* Xo = (bf16_t*)(wso + WS_X); bf16_t* A = (bf16_t*)(wso + WS_A); const unsigned char* Y = F.ws + WS_Y;
    const float* mod = (const float*)(F.ws + WS_MOD) + (size_t)l * 2 * 6 * DM;
    const int* toke = (const int*)(F.ws + WS_TOKE); const int* tokp = (const int*)(F.ws + WS_TOKP); const float* tokw = (const float*)(F.ws + WS_TOKW);
    const LAS int* rbS = (const LAS int*)(F.lds + LDS_STAGE + MS_RB);
    const int lane = F.lane;
    for (int tl = F.bid * 8 + F.wave; tl < ntok; tl += F.G * 8) { const int t = tok0 + tl;
        int rowv = 0; float wv = 0.f;
        if (lane < 8) { const int e = toke[(size_t)t * 8 + lane]; rowv = rbS[e] + tokp[(size_t)t * 8 + lane]; wv = tokw[(size_t)t * 8 + lane]; }
        int rows[9]; float wts[9];
#pragma unroll
        for (int s = 0; s < 8; ++s) { rows[s] = __builtin_amdgcn_readlane(rowv, s); wts[s] = __uint_as_float(__builtin_amdgcn_readlane(__float_as_uint(wv), s)); }
        rows[8] = rbS[NEXP] + tl; wts[8] = 1.f;
        f32x4 acc[8];
#pragma unroll
        for (int k = 0; k < 8; ++k) acc[k] = (f32x4){0.f, 0.f, 0.f, 0.f};
        { unsigned w[9][8];
#pragma unroll
          for (int r = 0; r < 9; ++r) { const unsigned char* yr = Y + (size_t)rows[r] * DM + lane * 4;
#pragma unroll
              for (int k = 0; k < 8; ++k) w[r][k] = *(const unsigned*)(yr + k * 256); }
#pragma unroll
          for (int r = 0; r < 9; ++r) { const float wg = wts[r];
#pragma unroll
              for (int k = 0; k < 8; ++k) { const auto lo = __builtin_amdgcn_cvt_pk_f32_fp8((int)w[r][k], false), hi = __builtin_amdgcn_cvt_pk_f32_fp8((int)w[r][k], true);
                  acc[k] += wg * (f32x4){lo[0], lo[1], hi[0], hi[1]}; } } }
        const float* m = mod + (size_t)(t < NCTX ? 0 : 1) * 6 * DM; const bf16_t* xr = X + (size_t)t * DM; bf16_t* xo = Xo + (size_t)t * DM; float ss = 0.f;
#pragma unroll
        for (int k = 0; k < 8; ++k) { const int i = k * 256 + lane * 4; const f32x4 g2 = *(const f32x4*)(m + 5 * DM + i); const u32x2 xw = *(const u32x2*)(xr + i); const f32x4 xv = {bflo(xw.x), bfhi(xw.x), bflo(xw.y), bfhi(xw.y)};
            acc[k] = xv + g2 * acc[k]; ss += acc[k][0] * acc[k][0] + acc[k][1] * acc[k][1] + acc[k][2] * acc[k][2] + acc[k][3] * acc[k][3]; }
        ss = wave_sum(ss); const float rs = rsqrtf(ss * (1.f / DM) + NORM_EPS);
        if (l + 1 < DEPTH) {
            const float* mn = (const float*)(F.ws + WS_MOD) + ((size_t)(l + 1) * 2 + (t < NCTX ? 0 : 1)) * 6 * DM; const float* g = a.in[I_N1G] + (size_t)(l + 1) * DM;
#pragma unroll
            for (int k = 0; k < 8; ++k) { const int i = k * 256 + lane * 4; { u32x2 xo2; xo2.x = cvt_pk_bf16(acc[k][0], acc[k][1]); xo2.y = cvt_pk_bf16(acc[k][2], acc[k][3]); *(u32x2*)(xo + i) = xo2; }
                const f32x4 gg = *(const f32x4*)(g + i), s0 = *(const f32x4*)(mn + i), s1 = *(const f32x4*)(mn + DM + i);
                const f32x4 y = acc[k] * rs * gg * (s1 + 1.f) + s0; u32x2 w; w.x = cvt_pk_bf16(y[0], y[1]); w.y = cvt_pk_bf16(y[2], y[3]); *(u32x2*)(A + (size_t)t * DM + i) = w; }
        } else {
            float* orow = (dummy ? (float*)(F.ws + WS_DUMMY + WS_X) : a.out) + (size_t)(t - NCTX) * DM; const float* g = a.in[I_FG];
#pragma unroll
            for (int k = 0; k < 8; ++k) { const int i = k * 256 + lane * 4; const f32x4 gg = *(const f32x4*)(g + i); *(f32x4*)(orow + i) = acc[k] * rs * gg; }
        }
    }
}

__device__ __forceinline__ float diff_lambda(const Args& a, int l) {
    float s1 = 0.f, s2 = 0.f;
    for (int i = 0; i < 64; ++i) { s1 += a.in[I_LQ1][l * 64 + i] * a.in[I_LK1][l * 64 + i]; s2 += a.in[I_LQ2][l * 64 + i] * a.in[I_LK2][l * 64 + i]; }
    const float lam = expf(s1) - expf(s2) + (l == 0 ? 0.2f : 0.35550907f);
    return __uint_as_float(__builtin_amdgcn_readfirstlane(__float_as_uint(lam)));
}
template <int BGL>
__device__ __forceinline__ void attn_gqa_unit(const Frame& F, int hq, int row0, int seq, const attn::BgArgs bg) {
    const bf16_t* Z = (const bf16_t*)(F.ws + WS_Z); unsigned char* MIX = F.ws + WS_MIX; const int kv = hq >> 2;
    attn::OutArgs oa; oa.mix = MIX + (size_t)row0 * DM + 512 + hq * 128; oa.scr = nullptr; oa.lam = 0.f; oa.osc = 0.f; oa.ng = nullptr;
    attn::body<128, 0, BGL>(Z + (size_t)row0 * ZW + ZC_AQ + hq * 128, Z + ZC_AK + kv * 128, Z + ZC_AV + kv * 128, seq, (char*)F.lds, oa, bg);
}
template <int BGL>
__device__ __forceinline__ void attn_diff_unit(const Frame& F, const Args& a, int l, int hd, int row0, int seq, float lam, const attn::BgArgs bg) {
    const bf16_t* Z = (const bf16_t*)(F.ws + WS_Z); unsigned char* MIX = F.ws + WS_MIX;
    attn::OutArgs oa; oa.mix = MIX + (size_t)row0 * DM + 1536 + hd * 128; oa.scr = (float*)(F.ws + WS_DSCR) + (size_t)F.bid * 256 * 128;
    oa.lam = lam; oa.osc = (l == 0 ? 0.8f : 0.64449093f); oa.ng = a.in[I_DNG] + l * 128;
    attn::body<64, 1, BGL>(Z + (size_t)row0 * ZW + ZC_DQ + hd * 128, Z + ZC_DK + hd * 128, Z + ZC_DV + hd * 128, seq, (char*)F.lds, oa, bg);
    attn::body<64, 2, BGL>(Z + (size_t)row0 * ZW + ZC_DQ + hd * 128 + 64, Z + ZC_DK + hd * 128 + 64, Z + ZC_DV + hd * 128, seq, (char*)F.lds, oa, bg);
}
struct AUnit { int type, p0, row0, seq; };
template <int l>
__device__ __forceinline__ bool attn_unit_of(int G, int bid, int vcu, int k, AUnit& u) {
    constexpr int nsmall = (l == 0 ? 12 : 0) + (l == 0 ? NCHUNK : NCHUNK - 4) * 4;
    int li;
    if (G == 256) { const int x = vcu >> 5, j = vcu & 31;
#if AT_PLAN == 1
        if (x < 4) { if (k == 0) li = x * 32 + j; else li = 384 + x * 32 + j + 128 * (k - 1); }
        else { if (k > 1) return false; li = 128 + (2 * (x - 4) + k) * 32 + j; }
#else
        if (j < 16) { if (k == 0) li = x * 16 + j; else { const int sm = x * 16 + j + 128 * (k - 1); if (sm >= SM_NA) return false; li = 384 + sm; } }
        else { if (k < 2) li = 128 + x * 32 + (j - 16) + 16 * k; else li = 384 + SM_NA + x * 16 + (j - 16) + 128 * (k - 2); }
#endif
    } else li = bid + k * G;
    if (li >= 384 + nsmall) return false;
    if (li < 128) { u.type = 1; u.p0 = li >> 5; u.row0 = NCTX + (li & 31) * 256; u.seq = NTOK; return true; }
    if (li < 384) { const int g = li - 128; u.type = 0; u.p0 = g >> 5; u.row0 = NCTX + (g & 31) * 256; u.seq = NTOK; return true; }
    int v = li - 384;
    if (l == 0) { if (v < 8) { u.type = 0; u.p0 = v; u.row0 = 0; u.seq = NCTX; return true; }
                  if (v < 12) { u.type = 1; u.p0 = v - 8; u.row0 = 0; u.seq = NCTX; return true; } v -= 12; }
    u.type = 2; u.p0 = v & 3; u.row0 = (l == 0) ? (v >> 2) : 4 + (v >> 2); u.seq = 0; return true;
}
template <int l>
__device__ __forceinline__ void phase_attention(const Frame& F, const Args& a) {
    const float lam = diff_lambda(a, l);
    const attn::BgArgs bg{nullptr, &a, F.ws, F.lds};
    for (int k = 0;; ++k) {
        AUnit u; if (!attn_unit_of<l>(F.G, F.bid, F.vcu, k, u)) break;
        const int nrep = ((REP_PH == 13 && u.type == 0) || (REP_PH == 14 && u.type == 1) || (REP_PH == 15 && u.type == 2)) ? 2 : 1;
        for (int rep = 0; rep < nrep; ++rep) {
        if (u.type == 0) attn_gqa_unit<-1>(F, u.p0, u.row0, u.seq, bg);
        else if (u.type == 1) attn_diff_unit<-1>(F, a, l, u.p0, u.row0, u.seq, lam, bg);
        else gla_out_unit(F, a, l, rep ? (u.row0 + 66) % NCHUNK : u.row0, u.p0, rep); }
    }
#if WC_ATT
    { unsigned* done = (unsigned*)(F.ws + WS_CTL) + CW_DONE + 32 * (8 + l);
      __syncthreads();
      if (F.tid == 0) __hip_atomic_fetch_add(done, 1u, __ATOMIC_RELAXED, __HIP_MEMORY_SCOPE_AGENT);
      wc_work(a, F.ws, F.lds, (unsigned*)(F.ws + WS_CTL), WC_CH_TOTAL, done, (unsigned)F.G); }
#endif
}

constexpr int PH_PRO = 0, PH_N1 = 1, PH_L0 = 2, PH_PER_LAYER = 9, N_PHASES = PH_L0 + DEPTH * PH_PER_LAYER;
#ifndef REP_PH
#define REP_PH -1
#endif
#if !MK_PER_PHASE
#define SEAM(k) do { if ((k) + 1 < hi) { xcd_barrier(bar); if (REP_PH == 12) xcd_barrier(bar); } } while (0)
#define LP_BAR , bar
#else
#define SEAM(k) do { } while (0)
#define LP_BAR
#endif
#ifdef ONLY_PH
#define PHSEL(k) (((k) < PH_L0 ? (k) : PH_L0 + ((k) - PH_L0) % PH_PER_LAYER) == ONLY_PH)
#else
#define PHSEL(k) true
#endif
#define IN(k) (PHSEL(k) && lo <= (k) && (k) < hi)
#define PHCLASS(k) ((k) < PH_L0 ? (k) : PH_L0 + ((k) - PH_L0) % PH_PER_LAYER)
#define NREP(k) ((PHCLASS(k) == REP_PH) ? 2 : 1)
template <int l>
__device__ __forceinline__ void layer_phases(const Frame& F, const Args& args, unsigned* ctl, const int lo, const int hi
#if !MK_PER_PHASE
    , const XcdBarrier& bar
#endif
    ) {
        const int pb = PH_L0 + l * PH_PER_LAYER;
        const int tok0 = (l == 0) ? 0 : NCTX, ntok = NTOK - tok0;
#define GEMM_DONE(k) (ctl + CW_DONE + 32 * (l * 4 + (k)))
#define SIGNAL_DONE(k) do { if (F.tid == 0) __hip_atomic_fetch_add(GEMM_DONE(k), 1u, __ATOMIC_RELAXED, __HIP_MEMORY_SCOPE_AGENT); } while (0)
        bf16_t* A = (bf16_t*)(F.ws + WS_A); bf16_t* Zb = (bf16_t*)(F.ws + WS_Z); bf16_t* X = (bf16_t*)(F.ws + WS_X);
        const float* mod = (const float*)(F.ws + WS_MOD) + (size_t)l * 2 * 6 * DM;
        if (IN(pb + 0)) {
            const int ge = (WC_TAIL & 1) ? F.G : wc_geff((NTOK / 256) * (ZW / 256), F.G);
            if (F.bid < ge) {
                DenseSched S; S.init(NTOK, ZW, DM * 2, ge, F.bid, 0, (const bf16_t*)(F.ws + WS_BTIN) + (size_t)l * ZW * DM);
                EpiZ E{Zb, ZW};
                for (int rep = 0; rep < NREP(pb + 0); ++rep) pg8::gemm_phase<EpiZ, DenseSched, false>(F.lds, A, DM * 2, S, E);
                SIGNAL_DONE(0);
                if (WC_TAIL & 1) wc_work(args, F.ws, F.lds, ctl, WC_CH_TOTAL, GEMM_DONE(0), (unsigned)ge);
            } else if (WC_MASK & 1) wc_work(args, F.ws, F.lds, ctl, WC_CH_TOTAL, GEMM_DONE(0), (unsigned)ge);
            SEAM(pb + 0);
        }
        if (IN(pb + 1)) {
            for (int rep = ((REP_PH == 16) ? 1 : 0); rep >= 0; --rep) qk_prep(F, args, l, rep);
            for (int rep = 0; rep < NREP(pb + 1); ++rep) for (int u = F.bid; u < NCHUNK * 4; u += F.G) gla_prep_unit(F, args, l, u >> 2, u & 3);
            SEAM(pb + 1);
        }
        if (IN(pb + 2)) { for (int rep = 0; rep < NREP(pb + 2); ++rep) gla_scan(F); SEAM(pb + 2); }
        if (IN(pb + 3)) { for (int rep = 0; rep < NREP(pb + 3); ++rep) phase_attention<l>(F, args); SEAM(pb + 3); }
        if (IN(pb + 4)) {
            const int ge = (F.G % 8 == 0 && F.G > WC_NOUT) ? WC_NOUT : F.G;
            if (F.bid < ge) {
                DenseSched S; S.init(ntok, DM, DM, ge, F.bid, tok0, F.ws + WS_BTOUT + (size_t)l * DM * DM);
                for (int rep = NREP(pb + 4) - 1; rep >= 0; --rep) { EpiOut E{X, mod + 2 * DM, mod + 6 * DM + 2 * DM, rep ? (bf16_t*)(F.ws + WS_DUMMY + WS_X) : X};
                    pg8::gemm_phase<EpiOut, DenseSched, true>(F.lds, F.ws + WS_MIX, DM, S, E); }
            }
            wc_work(args, F.ws, F.lds, ctl, l * WC_CH_LAYER + WC_CH_GU, nullptr, 0u);
            SEAM(pb + 4);
        }
        if (IN(pb + 5)) { wc_work(args, F.ws, F.lds, ctl, l * WC_CH_LAYER + WC_CH_GU, nullptr, 0u); __syncthreads();
            for (int rep = NREP(pb + 5) - 1; rep >= 0; --rep) phase_router(F, args, l, tok0, ntok, rep); SEAM(pb + 5); }
        if (IN(pb + 6)) {
            moe_tables(F, ctl + CW_CNT + l * NEXP, ntok);
            const int ge = wc_geff(*(const LAS int*)(F.lds + LDS_STAGE + MS_NT) * 4, F.G), ge8 = ge >> 3;
            const bool gemm_wg = (ge == F.G) || (F.bid >> 3) < ge8;
            MoeSched<4, true> S; S.misc = F.lds + LDS_STAGE; S.G = ge; S.c = (ge == F.G) ? F.vcu : (F.bid & 7) * ge8 + (F.bid >> 3); S.RB = DM; S.tok0 = tok0;
            S.Bt = F.ws + WS_BTGU + (size_t)l * 65 * 1024 * DM; S.bstride = (size_t)1024 * DM; S.list = (const int*)(F.ws + WS_LIST);
            if (gemm_wg) {
                for (int rep = ((REP_PH == 18 || REP_PH == 8) ? 1 : 0); rep >= 0; --rep) { EpiUp E{F.ws + WS_H, (REP_PH == 18 && rep) ? 1 : 0};
                    pg8::gemm_phase<EpiUp, MoeSched<4, true>, true>(F.lds, F.ws + WS_A8, DM, S, E); }
                SIGNAL_DONE(2);
            } else if (WC_MASK & 4) wc_work(args, F.ws, F.lds, ctl, WC_CH_TOTAL, GEMM_DONE(2), (unsigned)ge);
            wc_work(args, F.ws, F.lds, ctl, (l + 1) * WC_CH_LAYER, nullptr, 0u);
            SEAM(pb + 6);
        }
        if (IN(pb + 7)) {
            moe_tables(F, ctl + CW_CNT + l * NEXP, ntok);
            const int ge = wc_geff(*(const LAS int*)(F.lds + LDS_STAGE + MS_NT) * 8, F.G), ge8 = ge >> 3;
            const bool gemm_wg = (ge == F.G) || (F.bid >> 3) < ge8;
            MoeSched<8, false> S; S.misc = F.lds + LDS_STAGE; S.G = ge; S.c = (ge == F.G) ? F.vcu : (F.bid & 7) * ge8 + (F.bid >> 3); S.RB = EH; S.tok0 = tok0;
            S.Bt = F.ws + WS_BTD + (size_t)l * 65 * DM * EH; S.bstride = (size_t)DM * EH; S.list = nullptr;
            if (gemm_wg) {
                for (int rep = ((REP_PH == 17 || REP_PH == 9) ? 1 : 0); rep >= 0; --rep) { EpiDown E{F.ws + WS_Y, (REP_PH == 17 && rep) ? 1 : 0};
                    pg8::gemm_phase<EpiDown, MoeSched<8, false>, true>(F.lds, F.ws + WS_H, EH, S, E); }
                SIGNAL_DONE(3);
            } else if (WC_MASK & 8) wc_work(args, F.ws, F.lds, ctl, WC_CH_TOTAL, GEMM_DONE(3), (unsigned)ge);
            SEAM(pb + 7);
        }
        if (IN(pb + 8)) {
            moe_tables(F, ctl + CW_CNT + l * NEXP, ntok);
            for (int rep = NREP(pb + 8) - 1; rep >= 0; --rep) phase_combine(F, args, l, tok0, ntok, rep);
            SEAM(pb + 8);
        }
    }
__global__ void __launch_bounds__(NTHREADS, 2) fwd(Args args) {
    extern __shared__ __attribute__((aligned(16))) unsigned char lds_raw[];
    Frame F; F.lds = (LAS unsigned char*)lds_raw; F.ws = args.ws;
    F.tid = threadIdx.x; F.lane = F.tid & 63; F.wave = __builtin_amdgcn_readfirstlane(F.tid >> 6); F.G = gridDim.x; F.bid = blockIdx.x;
    F.vcu = (F.G % 8 == 0) ? (F.bid % 8) * (F.G / 8) + F.bid / 8 : F.bid;
    unsigned* ctl = (unsigned*)(F.ws + WS_CTL);
    const int lo = args.ph_lo, hi = args.ph_hi;
#if !MK_PER_PHASE
    if (F.tid < 4) ((LAS unsigned*)(F.lds + LDS_STAGE))[F.tid] = 0u;
    __syncthreads();
    XcdBarrier bar = xcd_barrier_post(ctl + CW_BAR, (volatile LAS unsigned*)(F.lds + LDS_STAGE));
#endif
    if (IN(PH_PRO)) {
        for (int rep = 0; rep < ((REP_PH == 11) ? 2 : 1); ++rep) mod_gemv(F, args.in[I_C], args.in[I_CCTX], args.in[I_WMOD], args.in[I_BMOD], (float*)(F.ws + WS_MOD));
        small_tables(F, (float*)(F.ws + WS_ROPE), args.in[I_RW], (float*)(F.ws + WS_RWT));
        for (int rep = 0; rep < NREP(PH_PRO); ++rep) { convert_weights(F, args);
            }
        SEAM(PH_PRO);
    }
    if (IN(PH_N1)) { for (int rep = 0; rep < NREP(PH_N1); ++rep) phase_norm1(F, args); SEAM(PH_N1); }
    layer_phases<0>(F, args, ctl, lo, hi LP_BAR);
    layer_phases<1>(F, args, ctl, lo, hi LP_BAR);
#undef IN
#undef SEAM
}

extern "C" void kernel_launch(void* const* d_in, const int* in_sizes, int n_in, void* d_out, int out_size, void* d_ws, size_t ws_size, hipStream_t stream) {
    static int grid = 0;
    if (grid == 0) {
        if (n_in != 31 || out_size != SEQ * DM || ws_size < WS_END + (REP_PH >= 0 ? WS_DUMMY_BYTES : 0)) { fprintf(stderr, "kernel_launch: expected 31 inputs, out %d, ws >= %zu; got n_in %d out %d ws %zu\n", SEQ * DM, (size_t)WS_END, n_in, out_size, ws_size); grid = -1; return; }
        int dev = 0, cus = 0, per_cu = 0;
        if (hipGetDevice(&dev) != hipSuccess || hipDeviceGetAttribute(&cus, hipDeviceAttributeMultiprocessorCount, dev) != hipSuccess) { grid = -1; return; }
        if (hipFuncSetAttribute((const void*)fwd, hipFuncAttributeMaxDynamicSharedMemorySize, LDS_BYTES) != hipSuccess) { fprintf(stderr, "kernel_launch: hipFuncSetAttribute failed\n"); grid = -1; return; }
        if (hipOccupancyMaxActiveBlocksPerMultiprocessor(&per_cu, (const void*)fwd, NTHREADS, LDS_BYTES) != hipSuccess || per_cu < 1) fprintf(stderr, "kernel_launch: occupancy query says %d\n", per_cu);
        (void)hipGetLastError();
        grid = cus;
    }
    if (grid < 0) return;
    (void)hipMemsetAsync((char*)d_ws + WS_CTL, 0, CTL_BYTES, stream);
    Args a{};
    for (int i = 0; i < 31; ++i) a.in[i] = (const float*)d_in[i];
    a.out = (float*)d_out; a.ws = (unsigned char*)d_ws;
#if MK_PER_PHASE
    for (int p = 0; p < N_PHASES; ++p) { a.ph_lo = p; a.ph_hi = p + 1; hipLaunchKernelGGL(fwd, dim3(grid), dim3(NTHREADS), LDS_BYTES, stream, a); }
#else
    a.ph_lo = 0; a.ph_hi = N_PHASES;
    hipLaunchKernelGGL(fwd, dim3(grid), dim3(NTHREADS), LDS_BYTES, stream, a);
#endif
    const hipError_t le = hipPeekAtLastError();
    if (le != hipSuccess) fprintf(stderr, "kernel_launch: launch failed: %s\n", hipGetErrorName(le));
}
```

```cpp
#include <hip/hip_runtime.h>
#include <stdint.h>
#include <stdio.h>

#ifndef WC_MASK
#define WC_MASK 0
#endif
#ifndef WC_TAIL
#define WC_TAIL 0
#endif
#ifndef SM_NA
#define SM_NA 4096
#endif
#ifndef WC_ATT
#define WC_ATT 1
#endif
#ifndef AT_PLAN
#define AT_PLAN 1
#endif
#ifndef WC_NOUT1
#define WC_NOUT1 128
#endif
#ifndef WC_NOUT
#define WC_NOUT 176
#endif
#ifndef REP_PH
#define REP_PH -1
#endif
#ifndef MK_PER_PHASE
#define MK_PER_PHASE 0
#endif

typedef unsigned short bf16_t;
typedef short bf16x8 __attribute__((ext_vector_type(8)));
typedef short s16x4 __attribute__((ext_vector_type(4)));
typedef float f32x4 __attribute__((ext_vector_type(4)));
typedef float f32x16 __attribute__((ext_vector_type(16)));
typedef unsigned u32x4 __attribute__((ext_vector_type(4)));
typedef unsigned u32x2 __attribute__((ext_vector_type(2)));
typedef int i32x4 __attribute__((ext_vector_type(4)));
typedef int i32x8 __attribute__((ext_vector_type(8)));
#define LAS __attribute__((address_space(3)))

constexpr int DM = 2048, SEQ = 8192, NCTX = 256, NTOK = SEQ + NCTX, DEPTH = 2;
constexpr int GRIDW = 64;
constexpr int IN_W = 4640, ZW = 4864;
constexpr int ZC_GQ = 0, ZC_GK = 256, ZC_GV = 512, ZC_GG = 1024, ZC_AQ = 1536, ZC_AK = 2560, ZC_AV = 2816, ZC_DQ = 3072, ZC_DK = 3584, ZC_DV = 4096, ZC_DEC = 4608;
constexpr int NEXP = 64, TOPK = 8, EH = 512;
constexpr int NCHUNK = NTOK / 64;
constexpr float NORM_EPS = 1e-6f;
constexpr int HROWS = 92416;
constexpr int NTHREADS = 512;

constexpr size_t al256(size_t x) { return (x + 255) / 256 * 256; }
constexpr size_t WS_CTL   = 0;
constexpr size_t CTL_BYTES = 65536;
constexpr size_t WS_MOD   = WS_CTL + CTL_BYTES;
constexpr size_t WS_ROPE  = WS_MOD + al256((size_t)2 * 2 * 6 * DM * 4);
constexpr size_t WS_RWT   = WS_ROPE + al256((size_t)(128 * 32 * 2 + 128 * 16 * 2) * 4);
constexpr size_t WS_BTIN  = WS_RWT + al256((size_t)2 * NEXP * DM * 4);
constexpr size_t WS_BTOUT = WS_BTIN + al256((size_t)2 * ZW * DM * 2);
constexpr size_t WS_BTGU  = WS_BTOUT + al256((size_t)2 * DM * DM * 2);
constexpr size_t WS_BTD   = WS_BTGU + al256((size_t)2 * 65 * 1024 * DM * 2);
constexpr size_t WS_X     = WS_BTD + al256((size_t)2 * 65 * DM * EH * 2);
constexpr size_t WS_A     = WS_X + al256((size_t)NTOK * DM * 4);
constexpr size_t WS_Z     = WS_A + al256((size_t)NTOK * DM * 2);
constexpr size_t WS_GQK   = WS_Z + al256((size_t)NTOK * ZW * 2);
constexpr size_t WS_GVT   = WS_GQK + al256((size_t)NTOK * 4 * 256 * 2);
constexpr size_t WS_GU    = WS_GVT + al256((size_t)NCHUNK * 4 * 128 * 64 * 2);
constexpr size_t WS_GG    = WS_GU + al256((size_t)NCHUNK * 4 * 2 * 128 * 64 * 4);
constexpr size_t WS_GS    = WS_GG + al256((size_t)NCHUNK * 4 * 2 * 64 * 4);
constexpr size_t WS_MIX   = WS_GS + al256((size_t)NCHUNK * 4 * 2 * 128 * 64 * 2);
constexpr size_t WS_DSCR  = WS_MIX + al256((size_t)NTOK * DM * 2);
constexpr size_t WS_LIST  = WS_DSCR + al256((size_t)256 * 256 * 128 * 4);
constexpr size_t WS_TOKE  = WS_LIST + al256((size_t)NEXP * NTOK * 4);
constexpr size_t WS_TOKP  = WS_TOKE + al256((size_t)NTOK * 8 * 4);
constexpr size_t WS_TOKW  = WS_TOKP + al256((size_t)NTOK * 8 * 4);
constexpr size_t WS_H     = WS_TOKW + al256((size_t)NTOK * 8 * 4);
constexpr size_t WS_Y     = WS_H + al256((size_t)HROWS * EH * 2);
constexpr size_t WS_AF    = WS_Y + al256((size_t)HROWS * DM * 2);
constexpr size_t WS_A8    = WS_AF + al256((size_t)NTOK * DM * 4);
constexpr size_t WS_END   = WS_A8 + al256((size_t)NTOK * DM);
constexpr size_t WS_DUMMY = WS_END - WS_X;
constexpr size_t WS_DUMMY_BYTES = WS_H - WS_X;

constexpr int CW_BAR = 0;
constexpr int CW_CNT = 4096;
constexpr int CW_Q   = 4352;
constexpr int CW_DONE = 4800;
constexpr int CW_CNTD = 4608;

constexpr int LDS_STAGE = 131072;
constexpr int LDS_MISC  = 8192;
constexpr int LDS_BYTES = 163840;
constexpr int MS_CNT = 64;
constexpr int MS_RB  = 64 + 68 * 4;
constexpr int MS_TE  = MS_RB + 68 * 4;
constexpr int MS_TM  = MS_TE + 1024;
constexpr int MS_NT  = MS_TM + 1024;
constexpr int MS_F   = MS_NT + 16;

__device__ __forceinline__ unsigned cvt_pk_bf16(float lo, float hi) { unsigned r; asm volatile("v_cvt_pk_bf16_f32 %0, %1, %2" : "=v"(r) : "v"(lo), "v"(hi)); return r; }
__device__ __forceinline__ bf16_t f2bf(float x) { return (bf16_t)(cvt_pk_bf16(x, 0.f) & 0xffffu); }
__device__ __forceinline__ float clamp448(float x) { return __builtin_fminf(__builtin_fmaxf(x, -448.f), 448.f); }
__device__ __forceinline__ unsigned cvt4_fp8(float a, float b, float c, float d) { a = clamp448(a); b = clamp448(b); c = clamp448(c); d = clamp448(d); int w = __builtin_amdgcn_cvt_pk_fp8_f32(a, b, 0, false); w = __builtin_amdgcn_cvt_pk_fp8_f32(c, d, w, true); return (unsigned)w; }
__device__ __forceinline__ unsigned char f2fp8_x16(float x) { return (unsigned char)(__builtin_amdgcn_cvt_pk_fp8_f32(clamp448(x * 16.f), 0.f, 0, false) & 0xff); }
__device__ __forceinline__ float bf2f(bf16_t b) { return __uint_as_float(((unsigned)b) << 16); }
__device__ __forceinline__ float bflo(unsigned w) { return __uint_as_float(w << 16); }
__device__ __forceinline__ float bfhi(unsigned w) { return __uint_as_float(w & 0xffff0000u); }
__device__ __forceinline__ float wave_sum(float v) {
#pragma unroll
    for (int o = 32; o >= 1; o >>= 1) v += __shfl_xor(v, o, 64);
    return v;
}
__device__ __forceinline__ float wave_max(float v) {
#pragma unroll
    for (int o = 32; o >= 1; o >>= 1) v = fmaxf(v, __shfl_xor(v, o, 64));
    return v;
}
__device__ __forceinline__ float silu_f(float x) { return x / (1.f + __expf(-x)); }
__device__ __forceinline__ float sigmoid_f(float x) { return 1.f / (1.f + expf(-x)); }
__device__ __forceinline__ float logsigmoid_f(float x) { return fminf(x, 0.f) - __logf(1.f + __expf(-fabsf(x))); }
#define VM_WAIT() asm volatile("s_waitcnt vmcnt(0)" ::: "memory")

#define XB_TMO      128
#define XB_XCNT(j)  (256  + 64 * (j))
#define XB_XSUB(j)  (1280 + 64 * (j))
#define XB_XGEN(j)  (2304 + 64 * (j))
#define XB_TOP      3328
#define XB_TOPGEN   3392
#define XCD_BAR_WORDS 3456
#define XB_SPIN_CAP (1u << 22)
__device__ __forceinline__ unsigned xb_ld(unsigned* p)              { return __hip_atomic_load(p, __ATOMIC_RELAXED, __HIP_MEMORY_SCOPE_AGENT); }
__device__ __forceinline__ unsigned xb_add(unsigned* p, unsigned v) { return __hip_atomic_fetch_add(p, v, __ATOMIC_RELAXED, __HIP_MEMORY_SCOPE_AGENT); }
__device__ __forceinline__ unsigned xb_xcc_id() { return (unsigned)__builtin_amdgcn_s_getreg((3 << 11) | 20) & 0xFu; }
#define XB_SPIN(cond, bar) do { unsigned _sp = 0; while (cond) { __builtin_amdgcn_s_sleep(1); \
    if ((++_sp & 255u) == 0u) { if (xb_ld(&(bar)[XB_TMO])) break; if (_sp > XB_SPIN_CAP) { atomicAdd(&(bar)[XB_TMO], 1u); break; } } } } while (0)
struct XcdBarrier { unsigned* bar; unsigned x; volatile LAS unsigned* st; };
__device__ __forceinline__ XcdBarrier xcd_barrier_post(unsigned* bar, volatile LAS unsigned* st) {
    XcdBarrier b; b.bar = bar; b.x = xb_xcc_id(); b.st = st;
    if (threadIdx.x == 0) (void)xb_add(&bar[XB_XCNT(b.x)], 1u);
    return b;
}
__device__ __forceinline__ void xcd_barrier_complete(unsigned* bar, unsigned x, unsigned& nloc, unsigned& nx) {
    const unsigned G = gridDim.x * gridDim.y * gridDim.z;
    unsigned sum, cnt, mine, sp = 0u;
    for (;;) {
        sum = 0u; cnt = 0u; mine = 0u;
#pragma unroll
        for (unsigned j = 0; j < 16; ++j) { const unsigned c = xb_ld(&bar[XB_XCNT(j)]); sum += c; cnt += (c > 0u) ? 1u : 0u; mine = (j == x) ? c : mine; }
        if (sum == G) break;
        __builtin_amdgcn_s_sleep(1);
        if ((++sp & 255u) == 0u) { if (xb_ld(&bar[XB_TMO])) break; if (sp > XB_SPIN_CAP) { atomicAdd(&bar[XB_TMO], 1u); break; } }
    }
    nloc = mine > 0u ? mine : 1u; nx = cnt > 0u ? cnt : 1u;
}
__device__ __forceinline__ void xcd_barrier(const XcdBarrier& b) {
    asm volatile("s_waitcnt vmcnt(0)" ::: "memory");
    __syncthreads();
    if (threadIdx.x == 0) {
        unsigned* bar = b.bar;
        __builtin_amdgcn_s_waitcnt(0);
        unsigned nloc = b.st[0], nx = b.st[1];
        if (nloc == 0u) { xcd_barrier_complete(bar, b.x, nloc, nx); b.st[0] = nloc; b.st[1] = nx; }
        const unsigned old = xb_add(&bar[XB_XSUB(b.x)], 1u);
        const unsigned gen = old / nloc;
        if (old + 1u == (gen + 1u) * nloc) {
            __builtin_amdgcn_fence(__ATOMIC_RELEASE, "agent");
            asm volatile("s_waitcnt vmcnt(0)" ::: "memory");
            const unsigned og = xb_add(&bar[XB_TOP], 1u);
            const unsigned tg = og / nx;
            if (og + 1u == (tg + 1u) * nx) xb_add(&bar[XB_TOPGEN], 1u);
            else XB_SPIN(xb_ld(&bar[XB_TOPGEN]) == tg, bar);
            __builtin_amdgcn_fence(__ATOMIC_ACQUIRE, "agent");
            xb_add(&bar[XB_XGEN(b.x)], 1u);
            asm volatile("s_waitcnt vmcnt(0)" ::: "memory");
        } else {
            XB_SPIN(xb_ld(&bar[XB_XGEN(b.x)]) == gen, bar);
            __builtin_amdgcn_fence(__ATOMIC_ACQUIRE, "agent");
            asm volatile("s_waitcnt vmcnt(0)" ::: "memory");
        }
    }
    __syncthreads();
}

struct Args {
    const float* in[31];
    float* out;
    unsigned char* ws;
    int ph_lo, ph_hi;
};
struct Frame {
    LAS unsigned char* lds;
    unsigned char* ws;
    int tid, lane, wave, G, bid, vcu;
};
#define LOCAL_FRAME(F, F_) Frame F = F_; { int tz_ = threadIdx.x; asm volatile("" : "+v"(tz_)); F.tid = tz_; F.lane = tz_ & 63; }
enum { I_X = 0, I_C, I_CTX, I_CCTX, I_N1G, I_N2G, I_WMOD, I_BMOD, I_WIN, I_WAF, I_BAF, I_WAB, I_BAB, I_GLAG, I_QNG, I_KNG,
       I_LQ1, I_LK1, I_LQ2, I_LK2, I_DNG, I_WOUT, I_RW, I_RB, I_EWG, I_EWU, I_EWD, I_SWG, I_SWU, I_SWD, I_FG };
constexpr int WC_CH_E = 128;
constexpr int WC_CH_GU = 2 * 65 * WC_CH_E, WC_CH_D = 65 * WC_CH_E, WC_CH_LAYER = WC_CH_GU + WC_CH_D, WC_CH_TOTAL = DEPTH * WC_CH_LAYER;
constexpr int WC_TROW = 80, WC_TILE = 128 * WC_TROW;
struct WConv {};
__device__ __forceinline__ void wc_chunk(const Args& a, unsigned char* ws, LAS unsigned char* T, int c, int lane) {
    const int l = c / WC_CH_LAYER, r = c % WC_CH_LAYER;
    int kind, e, cb, kb, ld;
    if (r < WC_CH_GU) { kind = r / WC_CH_D; const int rr = r % WC_CH_D; e = rr / WC_CH_E; const int q = rr % WC_CH_E; cb = q >> 5; kb = q & 31; ld = EH; }
    else { kind = 2; const int rr = r - WC_CH_GU; e = rr / WC_CH_E; const int q = rr % WC_CH_E; cb = q >> 3; kb = q & 7; ld = DM; }
    const float* src = (kind == 0) ? ((e < NEXP) ? a.in[I_EWG] + ((size_t)l * NEXP + e) * DM * EH : a.in[I_SWG] + (size_t)l * DM * EH)
                     : (kind == 1) ? ((e < NEXP) ? a.in[I_EWU] + ((size_t)l * NEXP + e) * DM * EH : a.in[I_SWU] + (size_t)l * DM * EH)
                                   : ((e < NEXP) ? a.in[I_EWD] + ((size_t)l * NEXP + e) * EH * DM : a.in[I_SWD] + (size_t)l * EH * DM);
    const uintptr_t pb = (uintptr_t)src; const unsigned pl = __builtin_amdgcn_readfirstlane((unsigned)pb), ph = __builtin_amdgcn_readfirstlane((unsigned)(pb >> 32));
    const __amdgpu_buffer_rsrc_t rs = __builtin_amdgcn_make_buffer_rsrc((void*)(((uintptr_t)ph << 32) | pl), 0, 0x7fffffff, 0x00020000);
    const int h = lane >> 5, c4 = (lane & 31) * 4, ld4 = ld * 4;
    const int soff = __builtin_amdgcn_readfirstlane((kb * 64 * ld + cb * 128) * 4), vofs = (h * 32 * ld + c4) * 4;
    f32x4 v[32];
#pragma unroll
    for (int j = 0; j < 32; ++j) { const u32x4 t = __builtin_amdgcn_raw_buffer_load_b128(rs, vofs, soff + j * ld4, 2); v[j] = *reinterpret_cast<const f32x4*>(&t); }
    const float scale = (kind < 2) ? 64.f : 32.f;
#pragma unroll
    for (int jc = 0; jc < 4; ++jc) {
#pragma unroll
        for (int hh = 0; hh < 2; ++hh) { u32x4 w;
#pragma unroll
            for (int d = 0; d < 4; ++d) { const int j = hh * 16 + d * 4; w[d] = cvt4_fp8(v[j][jc] * scale, v[j + 1][jc] * scale, v[j + 2][jc] * scale, v[j + 3][jc] * scale); }
            *(LAS u32x4*)(T + (c4 + jc) * WC_TROW + h * 32 + hh * 16) = w; } }
    unsigned char* d0 = (kind < 2) ? ws + WS_BTGU + (((size_t)l * 65 + e) * 1024 + 8 * (cb * 32) + 4 * kind) * DM + kb * 64
                                   : ws + WS_BTD + (((size_t)l * 65 + e) * DM + cb * 128) * EH + kb * 64;
#pragma unroll
    for (int half = 0; half < 2; ++half) { const int n = lane + half * 64;
        unsigned char* dp = d0 + ((kind < 2) ? (size_t)(8 * (n >> 2) + (n & 3)) * DM : (size_t)n * EH);
        u32x4 w[4];
#pragma unroll
        for (int i = 0; i < 4; ++i) w[i] = *(const LAS u32x4*)(T + n * WC_TROW + i * 16);
#pragma unroll
        for (int i = 0; i < 4; ++i) *(u32x4*)(dp + i * 16) = w[i]; }
}
__device__ __forceinline__ void wc_work(const Args& a, unsigned char* ws, LAS unsigned char* lds, unsigned* ctl, int limit, unsigned* done, unsigned need) {
    int tz = threadIdx.x; asm volatile("" : "+v"(tz));
    const int tid = tz, lane = tz & 63, wave = __builtin_amdgcn_readfirstlane(tz >> 6); LAS unsigned char* T = lds + wave * WC_TILE;
    LAS int* slot = (LAS int*)(lds + 8 * WC_TILE);
    unsigned* q = ctl + CW_Q;
    unsigned tk = 0, dn = 0; bool have = false;
    if (tid == 0) { const unsigned hd = __hip_atomic_load(q, __ATOMIC_RELAXED, __HIP_MEMORY_SCOPE_AGENT);
        if ((int)(hd * 8u) < limit) { tk = __hip_atomic_fetch_add(q, 1u, __ATOMIC_RELAXED, __HIP_MEMORY_SCOPE_AGENT); have = true; } }
    for (int it = 0;; ++it) {
        if (tid == 0) {
            int c0 = -1, more = 0;
            if (have) { c0 = (int)(tk * 8u); if (c0 >= WC_CH_TOTAL) c0 = -1; }
            if (c0 >= 0) { more = (c0 < limit) ? 1 : 0; if (done && dn >= need) more = 0;
                if (more) { tk = __hip_atomic_fetch_add(q, 1u, __ATOMIC_RELAXED, __HIP_MEMORY_SCOPE_AGENT); if (done) dn = __hip_atomic_load(done, __ATOMIC_RELAXED, __HIP_MEMORY_SCOPE_AGENT); } }
            slot[(it & 1) * 2] = c0; slot[(it & 1) * 2 + 1] = more;
        }
        __syncthreads();
        const int c0 = __builtin_amdgcn_readfirstlane(slot[(it & 1) * 2]), more = __builtin_amdgcn_readfirstlane(slot[(it & 1) * 2 + 1]);
        if (c0 < 0) break;
        wc_chunk(a, ws, T, c0 + wave, lane);
        if (!more) break;
    }
    __syncthreads();
}
__device__ __forceinline__ int wc_geff(int units, int G) {
    if (G % 8 != 0 || units <= 0) return G;
    const int k = (units + G - 1) / G; int ge = (((units + k - 1) / k) + 7) & ~7;
    return ge < G ? ge : G;
}
namespace pg8 {
constexpr int BM = 256, BK = 64, HALF = 128, HTB = HALF * BK * 2, STAGE_BYTES = 8 * HTB;
__device__ __forceinline__ int lds_byte(int r, int c) { const int st = (r >> 4) * 2 + (c >> 5), rr = r & 15, cc = c & 31, ob = rr * 64 + cc * 2; return st * 1024 + (ob ^ (((ob >> 9) & 1) << 5)); }
__device__ __forceinline__ void stage_rc(int b, int& R, int& C) { const int st = b / 1024, sb = b % 1024, swz = sb ^ (((sb >> 9) & 1) << 5); R = (st >> 1) * 16 + swz / 64; C = (st & 1) * 32 + (swz % 64) / 2; }
__device__ __forceinline__ int perm32(int rho) { const int n = rho >> 4, i = rho & 15; return 8 * (i >> 2) + 4 * n + (i & 3); }

template <class Epi, class Sched, bool F8>
__device__ __forceinline__ void gemm_phase(LAS unsigned char* lds, const void* Aptr, const int RB, const Sched& S, const Epi& E) {
    typedef typename Sched::Unit Unit;
    int tz0 = threadIdx.x; asm volatile("" : "+v"(tz0));
    const int tid = tz0, wid = __builtin_amdgcn_readfirstlane(tid >> 6), lane = tid & 63, wr = wid >> 2, wc = wid & 3, fr = lane & 15, fq = lane >> 4;
    const int nt = RB / 128;
    int sR[2], sC[2]; unsigned voffB[2][2];
#pragma unroll
    for (int i = 0; i < 2; ++i) { int R, C; stage_rc(tid * 16 + i * 8192, R, C); sR[i] = R; sC[i] = C;
        if (Epi::PERM == 2) {
#pragma unroll
            for (int h = 0; h < 2; ++h) voffB[h][i] = (unsigned)((64 * (R >> 5) + 16 * ((R >> 2) & 3) + 8 * h + 4 * ((R >> 4) & 1) + (R & 3)) * RB + C * 2); }
        else { const int Rb = Epi::PERM ? ((R & ~31) + perm32(R & 31)) : R; voffB[0][i] = (unsigned)(Rb * RB + C * 2); voffB[1][i] = voffB[0][i] + (unsigned)HALF * (unsigned)RB; } }
    const unsigned kstep = 128u;
    __amdgpu_buffer_rsrc_t rsA, rsB;
    { const uintptr_t pa = (uintptr_t)Aptr, pb = (uintptr_t)S.Bbase();
      const unsigned al = __builtin_amdgcn_readfirstlane((unsigned)pa), ah = __builtin_amdgcn_readfirstlane((unsigned)(pa >> 32));
      const unsigned bl = __builtin_amdgcn_readfirstlane((unsigned)pb), bh = __builtin_amdgcn_readfirstlane((unsigned)(pb >> 32));
      rsA = __builtin_amdgcn_make_buffer_rsrc((void*)(((uintptr_t)ah << 32) | al), 0, 0x7fffffff, 0x00020000);
      rsB = __builtin_amdgcn_make_buffer_rsrc((void*)(((uintptr_t)bh << 32) | bl), 0, 0x7fffffff, 0x00020000); }
    const unsigned ldsw = (unsigned)wid * 1024u;
    const int aoff = lds_byte(wr * 64 + fr, fq * 8), boff = lds_byte(wc * 32 + fr, fq * 8);
#define PG8_SA(b, h) (((b) * 2 + (h)) * HTB)
#define PG8_SB(b, h) ((4 + (b) * 2 + (h)) * HTB)
#define PG8_STAGEB(bufoff, soff, h) do { _Pragma("unroll") for (int _i = 0; _i < 2; ++_i) \
        __builtin_amdgcn_raw_ptr_buffer_load_lds(rsB, (LAS void*)(lds + (bufoff) + ldsw + _i * 8192), 16, voffB[h][_i], (int)(soff), 0, 0); } while (0)
#define PG8_STAGEA(bufoff, soff, v0, v1) do { \
        __builtin_amdgcn_raw_ptr_buffer_load_lds(rsA, (LAS void*)(lds + (bufoff) + ldsw), 16, (v0), (int)(soff), 0, 0); \
        __builtin_amdgcn_raw_ptr_buffer_load_lds(rsA, (LAS void*)(lds + (bufoff) + ldsw + 8192), 16, (v1), (int)(soff), 0, 0); } while (0)
#define PG8_LDA(dst, b, h) do { _Pragma("unroll") for (int m = 0; m < 4; ++m) dst[m] = __builtin_shufflevector(*(const LAS i32x4*)(lds + PG8_SA(b, h) + aoff + m * 2048), *(const LAS i32x4*)(lds + PG8_SA(b, h) + aoff + m * 2048 + 1024), 0, 1, 2, 3, 4, 5, 6, 7); } while (0)
#define PG8_LDB(dst, b, h) do { _Pragma("unroll") for (int n = 0; n < 2; ++n) dst[n] = __builtin_shufflevector(*(const LAS i32x4*)(lds + PG8_SB(b, h) + boff + n * 2048), *(const LAS i32x4*)(lds + PG8_SB(b, h) + boff + n * 2048 + 1024), 0, 1, 2, 3, 4, 5, 6, 7); } while (0)
#define PG8_H0(x) ({ i32x4 t_ = __builtin_shufflevector(x, x, 0, 1, 2, 3); *reinterpret_cast<bf16x8*>(&t_); })
#define PG8_H1(x) ({ i32x4 t_ = __builtin_shufflevector(x, x, 4, 5, 6, 7); *reinterpret_cast<bf16x8*>(&t_); })
#define PG8_MMA(ai, bj, At, Bt) do { __builtin_amdgcn_s_setprio(1); \
        if (F8) { _Pragma("unroll") for (int m = 0; m < 4; ++m) _Pragma("unroll") for (int n = 0; n < 2; ++n) \
            asm volatile("v_mfma_scale_f32_16x16x128_f8f6f4 %0, %1, %2, %0, %3, %4 op_sel_hi:[0,0,0]" : "+v"(acc[ai][bj][m][n]) : "v"(Bt[n]), "v"(At[m]), "v"(sclW), "v"(sclA)); } \
        else { _Pragma("unroll") for (int m = 0; m < 4; ++m) _Pragma("unroll") for (int n = 0; n < 2; ++n) { \
            acc[ai][bj][m][n] = __builtin_amdgcn_mfma_f32_16x16x32_bf16(PG8_H0(Bt[n]), PG8_H0(At[m]), acc[ai][bj][m][n], 0, 0, 0); \
            acc[ai][bj][m][n] = __builtin_amdgcn_mfma_f32_16x16x32_bf16(PG8_H1(Bt[n]), PG8_H1(At[m]), acc[ai][bj][m][n], 0, 0, 0); } } \
        __builtin_amdgcn_s_setprio(0); } while (0)
#define PG8_WAIT_V(n) asm volatile("s_waitcnt vmcnt(" #n ")" ::: "memory")
#define PG8_WAIT_L(n) asm volatile("s_waitcnt lgkmcnt(" #n ")" ::: "memory")
#define PG8_BAR __builtin_amdgcn_s_barrier()
#define PG8_SCHED __builtin_amdgcn_sched_barrier(0)
#define PG8_AOFFS(u, o00, o01, o10, o11) do { o00 = (unsigned)(S.row(u, sR[0]) * RB + sC[0] * 2); o01 = (unsigned)(S.row(u, sR[1]) * RB + sC[1] * 2); \
        o10 = (unsigned)(S.row(u, sR[0] + HALF) * RB + sC[0] * 2); o11 = (unsigned)(S.row(u, sR[1] + HALF) * RB + sC[1] * 2); } while (0)
    int sclW = E.wscale, sclA = E.ascale; if (F8) { asm volatile("" : "+v"(sclW), "+v"(sclA)); }
    Unit cur, nxt; int ui = 0;
    if (!S.next(0, cur)) return;
    f32x4 acc[2][2][4][2];
#pragma unroll
    for (int a = 0; a < 2; ++a)
#pragma unroll
        for (int b = 0; b < 2; ++b)
#pragma unroll
            for (int m = 0; m < 4; ++m)
#pragma unroll
                for (int n = 0; n < 2; ++n) acc[a][b][m][n] = (f32x4){0.f, 0.f, 0.f, 0.f};
    i32x8 At[4], B0[2], B1[2];
    unsigned cB = (unsigned)__builtin_amdgcn_readfirstlane((int)cur.boff);
    unsigned c00, c01, c10, c11, n00, n01, n10, n11;
    PG8_AOFFS(cur, c00, c01, c10, c11);
    n00 = c00; n01 = c01; n10 = c10; n11 = c11;
    PG8_STAGEB(PG8_SB(0, 0), cB, 0); PG8_STAGEA(PG8_SA(0, 0), 0u, c00, c01); PG8_STAGEB(PG8_SB(0, 1), cB, 1); PG8_STAGEA(PG8_SA(0, 1), 0u, c10, c11);
    if (wr == 1) PG8_BAR;
    PG8_WAIT_V(4); PG8_BAR;
    PG8_STAGEB(PG8_SB(1, 0), cB + kstep, 0); PG8_STAGEA(PG8_SA(1, 0), kstep, c00, c01); PG8_STAGEB(PG8_SB(1, 1), cB + kstep, 1);
    PG8_WAIT_V(6); PG8_BAR;
    for (;;) {
        const bool has_next = S.next(ui + 1, nxt);
        const unsigned nB = (unsigned)__builtin_amdgcn_readfirstlane((int)(has_next ? nxt.boff : cB));
        if (has_next) { PG8_AOFFS(nxt, n00, n01, n10, n11); } else { n00 = c00; n01 = c01; n10 = c10; n11 = c11; }
#pragma clang loop unroll(disable)
        for (int t = 0; t < nt; t += 2) {
            const bool last = (t == nt - 2);
            const unsigned a1 = (unsigned)__builtin_amdgcn_readfirstlane((int)((unsigned)(t + 1) * kstep));
            const unsigned a2 = (unsigned)__builtin_amdgcn_readfirstlane((int)(last ? 0u : (unsigned)(t + 2) * kstep)), b2 = (unsigned)__builtin_amdgcn_readfirstlane((int)(last ? nB : cB + (unsigned)(t + 2) * kstep));
            const unsigned a3 = a2 + kstep, b3 = b2 + kstep;
            const unsigned x00 = last ? n00 : c00, x01 = last ? n01 : c01, x10 = last ? n10 : c10, x11 = last ? n11 : c11;
            PG8_LDB(B0, 0, 0); PG8_SCHED; PG8_LDA(At, 0, 0); PG8_STAGEA(PG8_SA(1, 1), a1, c10, c11);
            PG8_WAIT_L(8); PG8_BAR; PG8_WAIT_L(0); PG8_MMA(0, 0, At, B0); PG8_BAR; PG8_SCHED;
            PG8_LDB(B1, 0, 1); PG8_STAGEB(PG8_SB(0, 0), b2, 0);
            PG8_BAR; PG8_WAIT_L(0); PG8_MMA(0, 1, At, B1); PG8_BAR;
            PG8_LDA(At, 0, 1); PG8_STAGEA(PG8_SA(0, 0), a2, x00, x01);
            PG8_BAR; PG8_WAIT_L(0); PG8_MMA(1, 0, At, B0); PG8_BAR; PG8_SCHED;
            PG8_STAGEB(PG8_SB(0, 1), b2, 1);
            PG8_WAIT_V(6); PG8_BAR; PG8_MMA(1, 1, At, B1); PG8_BAR;
            PG8_LDB(B0, 1, 0); PG8_SCHED; PG8_LDA(At, 1, 0); PG8_STAGEA(PG8_SA(0, 1), a2, x10, x11);
            PG8_WAIT_L(8); PG8_BAR; PG8_WAIT_L(0); PG8_MMA(0, 0, At, B0); PG8_BAR; PG8_SCHED;
            PG8_LDB(B1, 1, 1); PG8_STAGEB(PG8_SB(1, 0), b3, 0);
            PG8_BAR; PG8_WAIT_L(0); PG8_MMA(0, 1, At, B1); PG8_BAR;
            PG8_LDA(At, 1, 1); PG8_STAGEA(PG8_SA(1, 0), a3, x00, x01);
            PG8_BAR; PG8_WAIT_L(0); PG8_MMA(1, 0, At, B0); PG8_BAR; PG8_SCHED;
            PG8_STAGEB(PG8_SB(1, 1), b3, 1);
            PG8_WAIT_V(6); PG8_BAR; PG8_MMA(1, 1, At, B1); PG8_BAR;
        }
        if (F8) asm volatile("s_nop 15\n\ts_nop 15" ::: "memory");
        { int tz1 = threadIdx.x; asm volatile("" : "+v"(tz1));
          const int wid1 = __builtin_amdgcn_readfirstlane(tz1 >> 6), lane1 = tz1 & 63;
          E(acc, cur, wid1 >> 2, wid1 & 3, lane1 & 15, lane1 >> 4); }
        if (!has_next) break;
#pragma unroll
        for (int a = 0; a < 2; ++a)
#pragma unroll
            for (int b = 0; b < 2; ++b)
#pragma unroll
                for (int m = 0; m < 4; ++m)
#pragma unroll
                    for (int n = 0; n < 2; ++n) acc[a][b][m][n] = (f32x4){0.f, 0.f, 0.f, 0.f};
        cur = nxt; cB = nB; c00 = n00; c01 = n01; c10 = n10; c11 = n11; ++ui;
    }
    PG8_WAIT_V(0);
    if (wr == 0) PG8_BAR;
    PG8_BAR;
#undef PG8_SA
#undef PG8_SB
#undef PG8_STAGEA
#undef PG8_STAGEB
#undef PG8_LDA
#undef PG8_LDB
#undef PG8_MMA
#undef PG8_H0
#undef PG8_H1
#undef PG8_WAIT_V
#undef PG8_WAIT_L
#undef PG8_BAR
#undef PG8_SCHED
#undef PG8_AOFFS
}
}

struct DenseSched {
    struct Unit { unsigned boff; int pm, pn, m0; };
    int nM, nN, nwg, G, c, row0, RB  ; const void* Bt;
    __device__ void init(int M, int N, int RB_, int G_, int c_, int row0_, const void* Bt_) { nM = M / 256; nN = N / 256; nwg = nM * nN; G = G_; c = c_; row0 = row0_; RB = RB_; Bt = Bt_; }
    __device__ __forceinline__ bool next(int i, Unit& u) const {
        const long L = (long)i * G + c; if (L >= nwg) return false;
        int wgid = (int)L; { const int q = nwg / 8, r = nwg % 8, xcd = wgid % 8, off = wgid / 8; wgid = (xcd < r ? xcd * (q + 1) : r * (q + 1) + (xcd - r) * q) + off; }
        const int nig = 8 * nN, gid = wgid / nig, fm = gid * 8, gsz = (nM - fm) < 8 ? (nM - fm) : 8;
        u.pm = fm + ((wgid % nig) % gsz); u.pn = (wgid % nig) / gsz; u.m0 = row0 + u.pm * 256;
        u.boff = (unsigned)u.pn * 256u * (unsigned)RB; return true;
    }
    __device__ __forceinline__ int row(const Unit& u, int r) const { return u.m0 + r; }
    __device__ __forceinline__ int nrows(const Unit&) const { return 256; }
    __device__ __forceinline__ const void* Bbase() const { return Bt; }
};
template <int NTS, bool GATHER>
struct MoeSched {
    struct Unit { unsigned boff; int e, mt, pn, rows, hrow0; };
    LAS unsigned char* misc; int G, c, RB  , tok0; const unsigned char* Bt; size_t bstride  ; const int* list;
    __device__ __forceinline__ bool next(int i, Unit& u) const {
        const int ntiles = *(const LAS int*)(misc + MS_NT);
        const long L = (long)i * G + c; if (L >= (long)ntiles * NTS) return false;
        const int t = (int)(L / NTS); u.pn = (int)(L % NTS);
        u.e = ((const LAS short*)(misc + MS_TE))[t]; u.mt = ((const LAS short*)(misc + MS_TM))[t];
        const int cnt = ((const LAS int*)(misc + MS_CNT))[u.e]; const int rem = cnt - u.mt * 256; u.rows = rem < 256 ? rem : 256;
        u.hrow0 = ((const LAS int*)(misc + MS_RB))[u.e] + u.mt * 256;
        u.boff = (unsigned)u.e * (unsigned)bstride + (unsigned)u.pn * 256u * (unsigned)RB; return true;
    }
    __device__ __forceinline__ int row(const Unit& u, int r) const {
        if (GATHER) {
            const int rr = r < u.rows ? r : u.rows - 1;
            if (u.e == NEXP) return tok0 + u.mt * 256 + rr;
            return list[(size_t)u.e * NTOK + u.mt * 256 + rr];
        } else return u.hrow0 + r;
    }
    __device__ __forceinline__ int nrows(const Unit& u) const { return u.rows; }
    __device__ __forceinline__ const void* Bbase() const { return Bt; }
};

struct EpiZ {
    static constexpr int PERM = 1; static constexpr int wscale = 127, ascale = 127;
    bf16_t* O; int ldc;
    template <class U> __device__ __forceinline__ void operator()(const f32x4 (&acc)[2][2][4][2], const U& u, int wr, int wc, int fr, int fq) const {
        const int row0 = u.m0 + wr * 64 + fr, col0 = u.pn * 256 + wc * 32 + 8 * fq;
#pragma unroll
        for (int ai = 0; ai < 2; ++ai)
#pragma unroll
            for (int m = 0; m < 4; ++m) { bf16_t* rowp = O + (size_t)(row0 + ai * 128 + m * 16) * ldc + col0;
#pragma unroll
                for (int bj = 0; bj < 2; ++bj) { const f32x4 v0 = acc[ai][bj][m][0], v1 = acc[ai][bj][m][1];
                    u32x4 w; w.x = cvt_pk_bf16(v0[0], v0[1]); w.y = cvt_pk_bf16(v0[2], v0[3]); w.z = cvt_pk_bf16(v1[0], v1[1]); w.w = cvt_pk_bf16(v1[2], v1[3]);
                    *(u32x4*)(rowp + bj * 128) = w; } }
    }
};
struct EpiOut {
    static constexpr int PERM = 1; static constexpr int wscale = 121, ascale = 123;
    bf16_t* X; const float* gctx; const float* gx; bf16_t* Xo;
    template <class U> __device__ __forceinline__ void operator()(const f32x4 (&acc)[2][2][4][2], const U& u, int wr, int wc, int fr, int fq) const {
        const int row0 = u.m0 + wr * 64 + fr, col0 = u.pn * 256 + wc * 32 + 8 * fq;
        const float* g = (u.m0 < NCTX) ? gctx : gx;
        f32x4 gv[2][2];
#pragma unroll
        for (int bj = 0; bj < 2; ++bj)
#pragma unroll
            for (int n = 0; n < 2; ++n) gv[bj][n] = *(const f32x4*)(g + col0 + bj * 128 + n * 4);
#pragma unroll
        for (int ai = 0; ai < 2; ++ai)
#pragma unroll
            for (int m = 0; m < 4; ++m) { const size_t ro = (size_t)(row0 + ai * 128 + m * 16) * DM + col0; const bf16_t* rowp = X + ro; bf16_t* rowo = Xo + ro;
#pragma unroll
                for (int bj = 0; bj < 2; ++bj) { const u32x4 b = *(const u32x4*)(rowp + bj * 128);
                    const f32x4 v0 = (f32x4){bflo(b.x), bfhi(b.x), bflo(b.y), bfhi(b.y)} + gv[bj][0] * acc[ai][bj][m][0], v1 = (f32x4){bflo(b.z), bfhi(b.z), bflo(b.w), bfhi(b.w)} + gv[bj][1] * acc[ai][bj][m][1];
                    u32x4 w; w.x = cvt_pk_bf16(v0[0], v0[1]); w.y = cvt_pk_bf16(v0[2], v0[3]); w.z = cvt_pk_bf16(v1[0], v1[1]); w.w = cvt_pk_bf16(v1[2], v1[3]);
                    *(u32x4*)(rowo + bj * 128) = w; } }
    }
};
struct EpiUp {
    static constexpr int PERM = 2; static constexpr int wscale = 121, ascale = 127;
    unsigned char* H; int nostore;
    template <class U> __device__ __forceinline__ void operator()(const f32x4 (&acc)[2][2][4][2], const U& u, int wr, int wc, int fr, int fq) const {
        if (nostore) return;
        const int r0 = wr * 64 + fr, col0 = u.pn * 128 + wc * 32 + 8 * fq;
#pragma unroll
        for (int ai = 0; ai < 2; ++ai)
#pragma unroll
            for (int m = 0; m < 4; ++m) { const int r = r0 + ai * 128 + m * 16;
                if (r < u.rows) { u32x2 w;
                    { const f32x4 g = acc[ai][0][m][0], up = acc[ai][0][m][1]; w.x = cvt4_fp8(silu_f(g[0]) * up[0], silu_f(g[1]) * up[1], silu_f(g[2]) * up[2], silu_f(g[3]) * up[3]); }
                    { const f32x4 g = acc[ai][1][m][0], up = acc[ai][1][m][1]; w.y = cvt4_fp8(silu_f(g[0]) * up[0], silu_f(g[1]) * up[1], silu_f(g[2]) * up[2], silu_f(g[3]) * up[3]); }
                    *(u32x2*)(H + (size_t)(u.hrow0 + r) * EH + col0) = w; } }
    }
};
struct EpiDown {
    static constexpr int PERM = 2; static constexpr int wscale = 122, ascale = 127;
    unsigned char* Y; int nostore;
    template <class U> __device__ __forceinline__ void operator()(const f32x4 (&acc)[2][2][4][2], const U& u, int wr, int wc, int fr, int fq) const {
        const int r0 = wr * 64 + fr, col0 = u.pn * 256 + wc * 64 + 16 * fq;
#pragma unroll
        for (int ai = 0; ai < 2; ++ai)
#pragma unroll
            for (int m = 0; m < 4; ++m) { const int r = r0 + ai * 128 + m * 16;
                if (r < u.rows && !nostore) { u32x4 w;
                    w.x = cvt4_fp8(acc[ai][0][m][0][0], acc[ai][0][m][0][1], acc[ai][0][m][0][2], acc[ai][0][m][0][3]); w.y = cvt4_fp8(acc[ai][0][m][1][0], acc[ai][0][m][1][1], acc[ai][0][m][1][2], acc[ai][0][m][1][3]);
                    w.z = cvt4_fp8(acc[ai][1][m][0][0], acc[ai][1][m][0][1], acc[ai][1][m][0][2], acc[ai][1][m][0][3]); w.w = cvt4_fp8(acc[ai][1][m][1][0], acc[ai][1][m][1][1], acc[ai][1][m][1][2], acc[ai][1][m][1][3]);
                    *(u32x4*)(Y + (size_t)(u.hrow0 + r) * DM + col0) = w; } }
    }
};

__device__ __forceinline__ void moe_tables(const Frame& F_, const unsigned* cnt_g, int ntok) {
    LOCAL_FRAME(F, F_);
    LAS unsigned char* misc = F.lds + LDS_STAGE;
    LAS int* cntS = (LAS int*)(misc + MS_CNT); LAS int* rbS = (LAS int*)(misc + MS_RB);
    LAS short* te = (LAS short*)(misc + MS_TE); LAS short* tm = (LAS short*)(misc + MS_TM);
    __syncthreads();
    if (F.tid < 64) {
        const int c = (int)cnt_g[F.tid]; const int nt = (c + 255) >> 8;
        int inc = nt;
#pragma unroll
        for (int o = 1; o < 64; o <<= 1) { const int v = __shfl_up(inc, o, 64); if (F.lane >= o) inc += v; }
        const int first = inc - nt;
        cntS[F.tid] = c; rbS[F.tid] = first * 256;
        for (int m = 0; m < nt; ++m) { te[first + m] = (short)F.tid; tm[first + m] = (short)m; }
        if (F.tid == 63) { const int nts = (ntok + 255) >> 8; cntS[NEXP] = ntok; rbS[NEXP] = inc * 256; rbS[NEXP + 1] = (inc + nts) * 256; *(LAS int*)(misc + MS_NT) = inc + nts;
            for (int m = 0; m < nts; ++m) { te[inc + m] = (short)NEXP; tm[inc + m] = (short)m; } }
    }
    __syncthreads();
}
namespace attn {
constexpr int NW = 8, QBLK = 32, KVBLK = 64;
constexpr float THR = 8.f;
constexpr int SHM_V = KVBLK * 128 * 2, SHM_K = KVBLK * 128 * 2;
constexpr int OFF_K = 2 * SHM_V, OFF_WS = 2 * SHM_V + 2 * SHM_K, LDS_ATTN = OFF_WS + NW * 64 * 4;
#define KSWZ128(row, colB) ((row) * 256 + ((colB) ^ (((row) & 7) << 4)))
#define KSWZ64(row, colB)  ((row) * 128 + ((colB) ^ ((((row) >> 1) & 7) << 4)))
#define SBAR() __builtin_amdgcn_sched_barrier(0)
__device__ __forceinline__ int crow(int r, int hi) { return (r & 3) + 8 * (r >> 2) + 4 * hi; }

template <int DQK>
__device__ __forceinline__ void partialSM(f32x16& p0, f32x16& p1, float& m_reg, float& mn, float& alpha) {
    constexpr float SCALE = (DQK == 128) ? 0.088388347648318440f : 0.125f;
    constexpr float C = SCALE * 1.4426950408889634f;
    float pmax = p0[0];
#pragma unroll
    for (int r = 1; r < 16; ++r) pmax = fmaxf(pmax, p0[r]);
#pragma unroll
    for (int r = 0; r < 16; ++r) pmax = fmaxf(pmax, p1[r]);
    { auto rr = __builtin_amdgcn_permlane32_swap(__float_as_uint(pmax), __float_as_uint(pmax), false, false);
      pmax = fmaxf(__uint_as_float(rr[0]), __uint_as_float(rr[1])); }
    if (__builtin_expect(__all(pmax - m_reg <= THR / SCALE), 1)) { mn = m_reg; alpha = 1.f; }
    else { mn = fmaxf(m_reg, pmax); alpha = __builtin_amdgcn_exp2f((m_reg - mn) * C); m_reg = mn; }
    const float mnC = -mn * C;
#pragma unroll
    for (int r = 0; r < 16; ++r) p0[r] = fmaf(p0[r], C, mnC);
#pragma unroll
    for (int r = 0; r < 16; ++r) p1[r] = fmaf(p1[r], C, mnC);
#pragma unroll
    for (int r = 0; r < 16; ++r) p0[r] = __builtin_amdgcn_exp2f(p0[r]);
}
__device__ __forceinline__ void finishSM(f32x16& p0, f32x16& p1, float alpha, float& l_reg, bf16x8& pa0, bf16x8& pa1, bf16x8& pa2, bf16x8& pa3) {
#pragma unroll
    for (int r = 0; r < 16; ++r) p1[r] = __builtin_amdgcn_exp2f(p1[r]);
    float ps = 0;
#pragma unroll
    for (int r = 0; r < 16; ++r) ps += p0[r];
#pragma unroll
    for (int r = 0; r < 16; ++r) ps += p1[r];
    { auto rr = __builtin_amdgcn_permlane32_swap(__float_as_uint(ps), __float_as_uint(ps), false, false);
      ps = __uint_as_float(rr[0]) + __uint_as_float(rr[1]); }
    l_reg = l_reg * alpha + ps;
#define PK4(P, BASE, OUT) do { unsigned a0 = cvt_pk_bf16(P[BASE + 0], P[BASE + 1]), a1 = cvt_pk_bf16(P[BASE + 2], P[BASE + 3]);   \
    unsigned b0 = cvt_pk_bf16(P[BASE + 4], P[BASE + 5]), b1 = cvt_pk_bf16(P[BASE + 6], P[BASE + 7]);                              \
    auto r0 = __builtin_amdgcn_permlane32_swap(a0, b0, false, false); auto r1 = __builtin_amdgcn_permlane32_swap(a1, b1, false, false); \
    u32x4 w = {r0[0], r1[0], r0[1], r1[1]}; OUT = *reinterpret_cast<bf16x8*>(&w); } while (0)
    PK4(p0, 0, pa0); PK4(p0, 8, pa1); PK4(p1, 0, pa2); PK4(p1, 8, pa3);
#undef PK4
}
template <int DQK>
__device__ __forceinline__ void qkt(f32x16& p0, f32x16& p1, const char* Ks, const bf16x8* qr, int r32, int hi) {
    p0 = f32x16{}; p1 = f32x16{};
#pragma unroll
    for (int d0 = 0; d0 < DQK / 16; ++d0) { const int cb = (d0 * 16 + hi * 8) * 2;
        bf16x8 b0, b1;
        if (DQK == 128) { b0 = *reinterpret_cast<const bf16x8*>(Ks + KSWZ128(r32, cb)); b1 = *reinterpret_cast<const bf16x8*>(Ks + KSWZ128(32 + r32, cb)); }
        else            { b0 = *reinterpret_cast<const bf16x8*>(Ks + KSWZ64(r32, cb));  b1 = *reinterpret_cast<const bf16x8*>(Ks + KSWZ64(32 + r32, cb)); }
        p0 = __builtin_amdgcn_mfma_f32_32x32x16_bf16(b0, qr[d0], p0, 0, 0, 0);
        p1 = __builtin_amdgcn_mfma_f32_32x32x16_bf16(b1, qr[d0], p1, 0, 0, 0); }
}
__device__ __forceinline__ int v_st(int k, int c) { const int kk = (k & ~0xC) | ((k & 4) << 1) | ((k & 8) >> 1); return ((kk >> 3) * 4 + (c >> 5)) * 512 + ((kk & 7) * 32 + (c & 31)) * 2; }
__device__ __forceinline__ int v_rd_base(int lane) { return ((lane & 3) << 3) | (((lane >> 2) & 3) << 6) | (((lane >> 4) & 1) << 5) | (((lane >> 5) & 1) << 8); }
constexpr int v_rd_off(int d0, int ks, int half) { return d0 * 512 + ks * 4096 + half * 2048; }
template <int OFF> __device__ __forceinline__ s16x4 tr_read(int vb) {
    s16x4 r; asm volatile("ds_read_b64_tr_b16 %0, %1 offset:%2" : "=&v"(r) : "v"(vb), "i"(OFF) : "memory"); return r;
}
template <int D0> __device__ __forceinline__ void pv_one(f32x16& od, int vb, bf16x8 pa0, bf16x8 pa1, bf16x8 pa2, bf16x8 pa3) {
    const s16x4 l0 = tr_read<v_rd_off(D0, 0, 0)>(vb), h0 = tr_read<v_rd_off(D0, 0, 1)>(vb), l1 = tr_read<v_rd_off(D0, 1, 0)>(vb), h1 = tr_read<v_rd_off(D0, 1, 1)>(vb);
    const s16x4 l2 = tr_read<v_rd_off(D0, 2, 0)>(vb), h2 = tr_read<v_rd_off(D0, 2, 1)>(vb), l3 = tr_read<v_rd_off(D0, 3, 0)>(vb), h3 = tr_read<v_rd_off(D0, 3, 1)>(vb);
    asm volatile("s_waitcnt lgkmcnt(0)" ::: "memory"); SBAR();
#define PK(L, H) (bf16x8){L[0], L[1], L[2], L[3], H[0], H[1], H[2], H[3]}
    od = __builtin_amdgcn_mfma_f32_32x32x16_bf16(pa0, PK(l0, h0), od, 0, 0, 0);
    od = __builtin_amdgcn_mfma_f32_32x32x16_bf16(pa1, PK(l1, h1), od, 0, 0, 0);
    od = __builtin_amdgcn_mfma_f32_32x32x16_bf16(pa2, PK(l2, h2), od, 0, 0, 0);
    od = __builtin_amdgcn_mfma_f32_32x32x16_bf16(pa3, PK(l3, h3), od, 0, 0, 0);
#undef PK
}
__device__ __forceinline__ void pv_d0(f32x16* o, int vb, bf16x8 pa0, bf16x8 pa1, bf16x8 pa2, bf16x8 pa3) {
    pv_one<0>(o[0], vb, pa0, pa1, pa2, pa3); pv_one<1>(o[1], vb, pa0, pa1, pa2, pa3); pv_one<2>(o[2], vb, pa0, pa1, pa2, pa3); pv_one<3>(o[3], vb, pa0, pa1, pa2, pa3);
}

struct OutArgs { unsigned char* mix; float* scr; float lam; float osc; const float* ng; };

struct BgArgs { WConv* c; const Args* a; unsigned char* ws; LAS unsigned char* ldsl; };
template <int DQK, int MODE, int BGL>
__device__ __forceinline__ void body(const bf16_t* __restrict__ Qb, const bf16_t* __restrict__ Kh, const bf16_t* __restrict__ Vh, int seq, char* lds, const OutArgs oa, const BgArgs bg) {
    constexpr int ND = DQK / 16;
    int tz0 = threadIdx.x; asm volatile("" : "+v"(tz0));
    const int tid = tz0, wid = tid >> 6, lane = tid & 63, r32 = lane & 31, hi = lane >> 5;
    __syncthreads();
    char* V_lds = lds; char* K_lds = lds + OFF_K;
    float* ws = (float*)(lds + OFF_WS) + wid * 64; float* li_l = ws; float* al_l = ws + 32;
    float m_reg = -1e30f, l_reg = 0; f32x16 o[4] = {}; bf16x8 qr[ND];
    const bf16_t* Qw = Qb + (size_t)(wid * QBLK + r32) * ZW + hi * 8;
#pragma unroll
    for (int d0 = 0; d0 < ND; ++d0) qr[d0] = *reinterpret_cast<const bf16x8*>(Qw + d0 * 16);
    const int sr = tid >> 4, sc = (tid & 15) * 8, vst0 = v_st(sr, sc), vst1 = v_st(32 + sr, sc);
    const int kr64 = tid >> 3, kc64 = (tid & 7) * 8;
    const int vb0 = (int)(uintptr_t)V_lds + v_rd_base(lane);
#ifndef WC_MODE
#define WC_MODE 0
#endif
    constexpr int SD = (BGL >= 0 && WC_MODE != 1) ? 1 : 2;
    struct { bf16x8 vs0, vs1, ks0, ks1; } sr_[SD];
    const unsigned voffS = (unsigned)(sr * ZW + sc) * 2u, voffK64 = (unsigned)(kr64 * ZW + kc64) * 2u;
    __amdgpu_buffer_rsrc_t rsK, rsV;
    { const uintptr_t pk = (uintptr_t)Kh, pv = (uintptr_t)Vh;
      const unsigned kl = __builtin_amdgcn_readfirstlane((unsigned)pk), kh = __builtin_amdgcn_readfirstlane((unsigned)(pk >> 32));
      const unsigned vl = __builtin_amdgcn_readfirstlane((unsigned)pv), vh = __builtin_amdgcn_readfirstlane((unsigned)(pv >> 32));
      rsK = __builtin_amdgcn_make_buffer_rsrc((void*)(((uintptr_t)kh << 32) | kl), 0, NTOK * ZW * 2, 0x00020000);
      rsV = __builtin_amdgcn_make_buffer_rsrc((void*)(((uintptr_t)vh << 32) | vl), 0, NTOK * ZW * 2, 0x00020000); }
#define BLD(rs, vo, so) ({ u32x4 t_ = __builtin_amdgcn_raw_buffer_load_b128(rs, vo, so, 0); *reinterpret_cast<bf16x8*>(&t_); })
#define SLOAD(i, k0) do { const int so_ = (k0) * (ZW * 2); \
    sr_[i].vs0 = BLD(rsV, voffS, so_); sr_[i].vs1 = BLD(rsV, voffS, so_ + 32 * ZW * 2); \
    if (DQK == 128) { sr_[i].ks0 = BLD(rsK, voffS, so_); sr_[i].ks1 = BLD(rsK, voffS, so_ + 32 * ZW * 2); } \
    else { sr_[i].ks0 = BLD(rsK, voffK64, so_); } } while (0)
#define SWRITE(b, i) do { *(bf16x8*)(V_lds + (b) * SHM_V + vst0) = sr_[i].vs0; *(bf16x8*)(V_lds + (b) * SHM_V + vst1) = sr_[i].vs1; \
    if (DQK == 128) { const int kc = sc * 2; *(bf16x8*)(K_lds + (b) * SHM_K + KSWZ128(sr, kc)) = sr_[i].ks0; *(bf16x8*)(K_lds + (b) * SHM_K + KSWZ128(32 + sr, kc)) = sr_[i].ks1; } \
    else { *(bf16x8*)(K_lds + (b) * SHM_K + KSWZ64(kr64, kc64 * 2)) = sr_[i].ks0; } } while (0)
#define SWAIT() do { if (SD == 2) { if (DQK == 128) asm volatile("s_waitcnt vmcnt(4)" ::: "memory"); else asm volatile("s_waitcnt vmcnt(3)" ::: "memory"); } \
    else if (BGL >= 0 && WC_MODE == 0) asm volatile("s_waitcnt vmcnt(2)" ::: "memory"); else asm volatile("s_waitcnt vmcnt(0)" ::: "memory"); } while (0)
#define BGSTEP(X) do { } while (0)
#define RESC(a) do { if (__any((a) < 1.f)) { if (hi == 0) al_l[r32] = (a); asm volatile("s_waitcnt lgkmcnt(0)" ::: "memory"); \
    _Pragma("unroll") for (int d = 0; d < 4; ++d) _Pragma("unroll") for (int r = 0; r < 16; ++r) o[d][r] *= al_l[crow(r, hi)]; } } while (0)
    f32x16 pA0, pA1, pB0, pB1; float mnA, mnB, alA, alB; bf16x8 pa0, pa1, pa2, pa3; const int NT = seq / KVBLK;
    constexpr int SE = 0, SO = SD - 1;
    SLOAD(SE, 0); asm volatile("s_waitcnt vmcnt(0)" ::: "memory"); SWRITE(0, SE); __syncthreads();
    qkt<DQK>(pA0, pA1, K_lds, qr, r32, hi); partialSM<DQK>(pA0, pA1, m_reg, mnA, alA);
    SLOAD(SO, KVBLK); if (SD == 2) { if (2 < NT) SLOAD(SE, 2 * KVBLK); }
    SWAIT(); SWRITE(1, SO); __syncthreads();
    for (int j = 1; j + 1 < NT; j += 2) {
        SBAR(); qkt<DQK>(pB0, pB1, K_lds + SHM_K, qr, r32, hi);
        finishSM(pA0, pA1, alA, l_reg, pa0, pa1, pa2, pa3); SBAR();
        SLOAD(SO, (j + SD) * KVBLK); BGSTEP(0); SBAR();
        pv_d0(o, vb0, pa0, pa1, pa2, pa3); partialSM<DQK>(pB0, pB1, m_reg, mnB, alB);
        __syncthreads(); SWAIT(); SWRITE(0, SE);
        RESC(alB); __syncthreads();
        SBAR(); qkt<DQK>(pA0, pA1, K_lds, qr, r32, hi);
        finishSM(pB0, pB1, alB, l_reg, pa0, pa1, pa2, pa3); SBAR();
        if (SD == 1 || j + 3 < NT) SLOAD(SE, (j + 1 + SD) * KVBLK); BGSTEP(1); SBAR();
        pv_d0(o, vb0 + SHM_V, pa0, pa1, pa2, pa3); partialSM<DQK>(pA0, pA1, m_reg, mnA, alA);
        __syncthreads(); SWAIT(); SWRITE(1, SO);
        RESC(alA); __syncthreads();
    }
    SBAR(); qkt<DQK>(pB0, pB1, K_lds + SHM_K, qr, r32, hi);
    finishSM(pA0, pA1, alA, l_reg, pa0, pa1, pa2, pa3); SBAR();
    pv_d0(o, vb0, pa0, pa1, pa2, pa3); partialSM<DQK>(pB0, pB1, m_reg, mnB, alB);
    __syncthreads(); RESC(alB);
    finishSM(pB0, pB1, alB, l_reg, pa0, pa1, pa2, pa3); SBAR();
    pv_d0(o, vb0 + SHM_V, pa0, pa1, pa2, pa3);
    if (hi == 0) li_l[r32] = l_reg; asm volatile("s_waitcnt lgkmcnt(0)" ::: "memory");
    float rli[16];
#pragma unroll
    for (int r = 0; r < 16; ++r) rli[r] = __builtin_amdgcn_rcpf(li_l[crow(r, hi)]);
    int tz = threadIdx.x; asm volatile("" : "+v"(tz));
    const int tid_e = tz, wid_e = tz >> 6, r32_e = tz & 31, hi_e = (tz >> 5) & 1;
#define tid tid_e
#define wid wid_e
#define r32 r32_e
#define hi hi_e
    if (MODE == 0) {
        unsigned char* Ow = oa.mix + (size_t)(wid * QBLK) * DM;
#pragma unroll
        for (int r = 0; r < 16; ++r) { const int orow = crow(r, hi);
#pragma unroll
            for (int d0 = 0; d0 < 4; ++d0) Ow[(size_t)orow * DM + d0 * 32 + r32] = f2fp8_x16(o[d0][r] * rli[r]); }
    } else if (MODE == 1) {
#pragma unroll
        for (int r = 0; r < 16; ++r)
#pragma unroll
            for (int d0 = 0; d0 < 4; ++d0) oa.scr[(r * 4 + d0) * 512 + tid] = o[d0][r] * rli[r];
    } else {
        unsigned char* Ow = oa.mix + (size_t)(wid * QBLK) * DM;
        float gn[4];
#pragma unroll
        for (int d0 = 0; d0 < 4; ++d0) gn[d0] = oa.ng[d0 * 32 + r32] * oa.osc;
#pragma unroll
        for (int r = 0; r < 16; ++r) { const int orow = crow(r, hi); float v[4]; float ss = 0.f;
#pragma unroll
            for (int d0 = 0; d0 < 4; ++d0) { v[d0] = oa.scr[(r * 4 + d0) * 512 + tid] - oa.lam * (o[d0][r] * rli[r]); ss += v[d0] * v[d0]; }
#pragma unroll
            for (int s = 16; s >= 1; s >>= 1) ss += __shfl_xor(ss, s, 64);
            const float rs = rsqrtf(ss * (1.f / 128.f) + NORM_EPS);
#pragma unroll
            for (int d0 = 0; d0 < 4; ++d0) Ow[(size_t)orow * DM + d0 * 32 + r32] = f2fp8_x16(v[d0] * rs * gn[d0]); }
    }
#undef tid
#undef wid
#undef r32
#undef hi
    asm volatile("s_waitcnt vmcnt(0) lgkmcnt(0)" ::: "memory");
    __syncthreads();
#undef SLOAD
#undef BGSTEP
#undef BLD
#undef SWRITE
#undef SWAIT
#undef RESC
}
}
__device__ __forceinline__ void mod_gemv(const Frame& F_, const float* c, const float* cctx, const float* wmod, const float* bmod, float* mod) {
    LOCAL_FRAME(F, F_);
    LAS float* sx = (LAS float*)F.lds;
    LAS float* sc = sx + DM;
    LAS float* red = sc + DM;
    __syncthreads();
    for (int i = F.tid; i < DM; i += NTHREADS) { const float a = c[i], b = cctx[i]; sx[i] = a / (1.f + expf(-a)); sc[i] = b / (1.f + expf(-b)); }
    __syncthreads();
    for (int item = F.bid; item < 256; item += F.G) {
        const int l = item >> 7, col0 = (item & 127) * 96;
        const float* W = wmod + (size_t)l * DM * (6 * DM) + col0;
        const int c4 = F.tid % 24, rg = F.tid / 24;
        if (rg < 21) {
            f32x4 ax = {0.f, 0.f, 0.f, 0.f}, ac = {0.f, 0.f, 0.f, 0.f};
            for (int d0 = rg; d0 < DM; d0 += 21 * 7) {
                f32x4 w[7];
#pragma unroll
                for (int u = 0; u < 7; ++u) { const int d = d0 + 21 * u; w[u] = (d < DM) ? *(const f32x4*)(W + (size_t)d * (6 * DM) + c4 * 4) : (f32x4){0.f, 0.f, 0.f, 0.f}; }
#pragma unroll
                for (int u = 0; u < 7; ++u) { const int d = d0 + 21 * u; if (d < DM) { ax += sx[d] * w[u]; ac += sc[d] * w[u]; } }
            }
#pragma unroll
            for (int j = 0; j < 4; ++j) { red[(rg * 2 + 0) * 96 + c4 * 4 + j] = ac[j]; red[(rg * 2 + 1) * 96 + c4 * 4 + j] = ax[j]; }
        }
        __syncthreads();
        if (F.tid < 192) { const int w = F.tid / 96, col = F.tid % 96; float s = 0.f;
            for (int r = 0; r < 21; ++r) s += red[(r * 2 + w) * 96 + col];
            mod[((size_t)l * 2 + w) * (6 * DM) + col0 + col] = s + bmod[(size_t)l * 6 * DM + col0 + col]; }
        __syncthreads();
    }
}
__device__ __forceinline__ void small_tables(const Frame& F_, float* rope, const float* rw, float* rwT) {
    LOCAL_FRAME(F, F_);
    for (int i = F.bid * NTHREADS + F.tid; i < 128 * 32 + 128 * 16; i += F.G * NTHREADS) {
        if (i < 128 * 32) { const int pos = i >> 5, j = i & 31; const float inv = powf(10000.f, -(float)j / 32.f); const float a = (float)pos * inv; rope[i] = cosf(a); rope[128 * 32 + i] = sinf(a); }
        else { const int k = i - 128 * 32, pos = k >> 4, j = k & 15; const float inv = powf(10000.f, -(float)j / 16.f); const float a = (float)pos * inv; rope[2 * 128 * 32 + k] = cosf(a); rope[2 * 128 * 32 + 128 * 16 + k] = sinf(a); }
    }
    bf16_t* rh = (bf16_t*)rwT;
    for (int i = F.bid * NTHREADS + F.tid; i < 2 * DM * NEXP; i += F.G * NTHREADS) { const int l = i / (DM * NEXP), r = i % (DM * NEXP), d = r / NEXP, e = r % NEXP;
        const float w = rw[i]; const bf16_t hi = f2bf(w); rh[((size_t)(l * 2 + 0) * NEXP + e) * DM + d] = hi; rh[((size_t)(l * 2 + 1) * NEXP + e) * DM + d] = f2bf(w - bf2f(hi)); }
}
struct CvtTile { const float* src0; const float* src1; unsigned char* dst; int ld, dstrb  ; float scale; int ilv, f8; };
__device__ __forceinline__ void cvt_decode(int idx, const Args& a, unsigned char* ws, CvtTile& t) {
    constexpr int N_IN = 76 * 16, N_OUT = 32 * 16, N_GU = 65 * 16 * 16, N_DN = 65 * 32 * 4, PER_L = N_IN + N_OUT;
    const int l = idx / PER_L; int r = idx % PER_L;
    t.scale = 1.f; t.ilv = 0; t.f8 = 0;
    if (r < N_IN) { const int nt = r / 16, kt = r % 16; const float* W = a.in[I_WIN] + (size_t)l * DM * IN_W + (size_t)kt * 128 * IN_W;
        t.ld = IN_W; t.dstrb = DM * 2; t.dst = ws + WS_BTIN + (((size_t)l * ZW + nt * 64) * DM + kt * 128) * 2;
        if (nt < 24) { t.src0 = W + nt * 64; t.src1 = t.src0 + 32; if (nt < 4) t.scale = 0.125f; }
        else if (nt < 72) { t.src0 = W + nt * 64 + 32; t.src1 = t.src0 + 32; }
        else if (nt == 72) { t.src0 = W + 1536; t.src1 = nullptr; }
        else { t.src0 = nullptr; t.src1 = nullptr; }
        return; }
    r -= N_IN;
    if (r < N_OUT) { const int nt = r / 16, kt = r % 16; const float* W = a.in[I_WOUT] + (size_t)l * DM * DM + (size_t)kt * 128 * DM;
        t.ld = DM; t.dstrb = DM; t.f8 = 1; t.scale = 64.f; t.dst = ws + WS_BTOUT + ((size_t)l * DM + nt * 64) * DM + kt * 128; t.src0 = W + nt * 64; t.src1 = t.src0 + 32; return; }
    r -= N_OUT;
    if (r < N_GU) { const int e = r / 256, q = r % 256, nt = q / 16, kt = q % 16;
        const float* Wg = (e < NEXP) ? a.in[I_EWG] + ((size_t)l * NEXP + e) * DM * EH : a.in[I_SWG] + (size_t)l * DM * EH;
        const float* Wu = (e < NEXP) ? a.in[I_EWU] + ((size_t)l * NEXP + e) * DM * EH : a.in[I_SWU] + (size_t)l * DM * EH;
        t.ld = EH; t.dstrb = DM; t.ilv = 1; t.f8 = 1; t.scale = 64.f; t.dst = ws + WS_BTGU + (((size_t)l * 65 + e) * 1024 + nt * 64) * DM + kt * 128;
        t.src0 = Wg + (size_t)kt * 128 * EH + nt * 32; t.src1 = Wu + (size_t)kt * 128 * EH + nt * 32; return; }
    r -= N_GU;
    { const int e = r / 128, q = r % 128, nt = q / 4, kt = q % 4;
        const float* Wd = (e < NEXP) ? a.in[I_EWD] + ((size_t)l * NEXP + e) * EH * DM : a.in[I_SWD] + (size_t)l * EH * DM;
        t.ld = DM; t.dstrb = EH; t.f8 = 1; t.scale = 32.f; t.dst = ws + WS_BTD + (((size_t)l * 65 + e) * DM + nt * 64) * EH + kt * 128;
        t.src0 = Wd + (size_t)kt * 128 * DM + nt * 64; t.src1 = t.src0 + 32; }
}
constexpr int CVT_ITEMS = 2 * (76 * 16 + 32 * 16);
__device__ __forceinline__ void convert_weights(const Frame& F_, const Args& a) {
    LOCAL_FRAME(F, F_);
    constexpr int TSB = 272;
    LAS unsigned char* tile = F.lds;
    const int kq = F.tid >> 4, s4 = (F.tid & 15) * 4;
    const int rs = F.tid >> 3, rk = (F.tid & 7) * 16;
    f32x4 v[2][4]; CvtTile t[2];
    __syncthreads();
    int it = F.bid, par = 0;
#define CV_LOAD(p, T) do { const float* s_ = (s4 < 32) ? (T).src0 : (T).src1; const int so_ = (s4 < 32) ? s4 : s4 - 32; \
        _Pragma("unroll") for (int i = 0; i < 4; ++i) v[p][i] = s_ ? __builtin_nontemporal_load((const f32x4*)(s_ + (size_t)(4 * kq + i) * (T).ld + so_)) : (f32x4){0.f, 0.f, 0.f, 0.f}; } while (0)
    if (it < CVT_ITEMS) { cvt_decode(it, a, F.ws, t[0]); CV_LOAD(0, t[0]); }
    while (it < CVT_ITEMS) {
        const int nx = it + F.G;
        if (par == 0) { if (nx < CVT_ITEMS) { cvt_decode(nx, a, F.ws, t[1]); CV_LOAD(1, t[1]); } }
        else          { if (nx < CVT_ITEMS) { cvt_decode(nx, a, F.ws, t[0]); CV_LOAD(0, t[0]); } }
        LAS unsigned char* tb = tile + par * 64 * TSB;
#define CV_PROC(p) do { const float sc_ = t[p].scale; \
        const int drow_ = t[p].ilv ? ((rs < 32) ? (8 * (rs >> 2) + (rs & 3)) : (8 * ((rs - 32) >> 2) + 4 + (rs & 3))) : rs; \
        if (t[p].f8) { _Pragma("unroll") for (int j = 0; j < 4; ++j) *(LAS unsigned*)(tb + (s4 + j) * TSB + 4 * kq) = cvt4_fp8(v[p][0][j] * sc_, v[p][1][j] * sc_, v[p][2][j] * sc_, v[p][3][j] * sc_); \
            __syncthreads(); \
            *(u32x4*)(t[p].dst + (size_t)drow_ * t[p].dstrb + rk) = *(const LAS u32x4*)(tb + rs * TSB + rk); } \
        else { _Pragma("unroll") for (int j = 0; j < 4; ++j) { u32x2 w_; w_.x = cvt_pk_bf16(v[p][0][j] * sc_, v[p][1][j] * sc_); w_.y = cvt_pk_bf16(v[p][2][j] * sc_, v[p][3][j] * sc_); *(LAS u32x2*)(tb + (s4 + j) * TSB + 8 * kq) = w_; } \
            __syncthreads(); \
            const u32x4 w0_ = *(const LAS u32x4*)(tb + rs * TSB + rk * 2), w1_ = *(const LAS u32x4*)(tb + rs * TSB + rk * 2 + 16); \
            u32x4* dp_ = (u32x4*)(t[p].dst + (size_t)drow_ * t[p].dstrb + rk * 2); dp_[0] = w0_; dp_[1] = w1_; } } while (0)
        if (par == 0) CV_PROC(0); else CV_PROC(1);
        it = nx; par ^= 1;
    }
    __syncthreads();
#undef CV_LOAD
#undef CV_PROC
}

__device__ __forceinline__ void norm_mod_row(const float* xr, bf16_t* xcopy, const float* g, const float* sh, const float* sc, bf16_t* out, int lane) {
    f32x4 v[8]; float ss = 0.f;
#pragma unroll
    for (int k = 0; k < 8; ++k) { v[k] = *(const f32x4*)(xr + k * 256 + lane * 4); ss += v[k][0] * v[k][0] + v[k][1] * v[k][1] + v[k][2] * v[k][2] + v[k][3] * v[k][3]; }
    ss = wave_sum(ss);
    const float rs = rsqrtf(ss * (1.f / DM) + NORM_EPS);
#pragma unroll
    for (int k = 0; k < 8; ++k) { const int i = k * 256 + lane * 4;
        const f32x4 gg = *(const f32x4*)(g + i), s0 = *(const f32x4*)(sh + i), s1 = *(const f32x4*)(sc + i);
        const f32x4 y = v[k] * rs * gg * (s1 + 1.f) + s0;
        u32x2 w; w.x = cvt_pk_bf16(y[0], y[1]); w.y = cvt_pk_bf16(y[2], y[3]);
        *(u32x2*)(out + i) = w;
        if (xcopy) { u32x2 xw; xw.x = cvt_pk_bf16(v[k][0], v[k][1]); xw.y = cvt_pk_bf16(v[k][2], v[k][3]); *(u32x2*)(xcopy + i) = xw; } }
}
__device__ __forceinline__ void phase_norm1(const Frame& F_, const Args& a) {
    LOCAL_FRAME(F, F_);
    bf16_t* X = (bf16_t*)(F.ws + WS_X); bf16_t* A = (bf16_t*)(F.ws + WS_A); const float* mod = (const float*)(F.ws + WS_MOD);
    for (int r = F.bid * 8 + F.wave; r < NTOK; r += F.G * 8) {
        const bool isctx = r < NCTX;
        const float* src = isctx ? a.in[I_CTX] + (size_t)r * DM : a.in[I_X] + (size_t)(r - NCTX) * DM;
        const float* m = mod + (size_t)(isctx ? 0 : 1) * 6 * DM;
        norm_mod_row(src, X + (size_t)r * DM, a.in[I_N1G], m, m + DM, A + (size_t)r * DM, F.lane);
    }
}

__device__ __forceinline__ void qk_prep(const Frame& F_, const Args& a, int l, int dummy, int qb, int qG) {
    LOCAL_FRAME(F, F_);
    const bf16_t* Z = (const bf16_t*)(F.ws + WS_Z); bf16_t* Zo = (bf16_t*)(F.ws + (dummy ? WS_DUMMY : 0) + WS_Z);
    const float* rope = (const float*)(F.ws + WS_ROPE);
    const float* cg = rope; const float* sg = rope + 128 * 32; const float* cd = rope + 2 * 128 * 32; const float* sd = cd + 128 * 16;
    const float* qng = a.in[I_QNG] + l * 128; const float* kng = a.in[I_KNG] + l * 128;
#define QK_UNPACK(W_, X_) do { X_[0] = bflo(W_[0]); X_[1] = bfhi(W_[0]); X_[2] = bflo(W_[1]); X_[3] = bfhi(W_[1]); X_[4] = bflo(W_[2]); X_[5] = bfhi(W_[2]); X_[6] = bflo(W_[3]); X_[7] = bfhi(W_[3]); } while (0)
    { const int sub = F.tid & 7, half = sub >> 2, j0 = (sub & 3) * 8;
      for (int g0 = qb * 64; g0 < NTOK * 10; g0 += qG * 64) {
        const int g = g0 + (F.tid >> 3);
        if (g < NTOK * 10) {
            const int t = g / 10, hv = g - t * 10; const int col = ((hv < 8) ? ZC_AQ + hv * 128 : ZC_AK + (hv - 8) * 128) + half * 64 + j0;
            const float* gn = ((hv < 8) ? qng : kng) + half * 64 + j0;
            const u32x4 w1 = *(const u32x4*)(Z + (size_t)t * ZW + col), w2 = *(const u32x4*)(Z + (size_t)t * ZW + col + 32);
            const f32x4 ga = *(const f32x4*)gn, gb = *(const f32x4*)(gn + 4), gc = *(const f32x4*)(gn + 32), gd = *(const f32x4*)(gn + 36);
            const bool lat = t >= NCTX; const int p = t - NCTX, pos = lat ? (half == 0 ? (p >> 6) : (p & 63)) : 0;
            const f32x4 ca = *(const f32x4*)(cg + pos * 32 + j0), cb = *(const f32x4*)(cg + pos * 32 + j0 + 4), sa = *(const f32x4*)(sg + pos * 32 + j0), sb = *(const f32x4*)(sg + pos * 32 + j0 + 4);
            float x1[8], x2[8]; QK_UNPACK(w1, x1); QK_UNPACK(w2, x2);
            float ss = 0.f;
#pragma unroll
            for (int i = 0; i < 8; ++i) ss += x1[i] * x1[i] + x2[i] * x2[i];
            ss += __shfl_xor(ss, 1, 64); ss += __shfl_xor(ss, 2, 64); ss += __shfl_xor(ss, 4, 64);
            const float rs = rsqrtf(ss * (1.f / 128.f) + NORM_EPS);
            float o1[8], o2[8];
#pragma unroll
            for (int i = 0; i < 8; ++i) { const float g1 = (i < 4) ? ga[i & 3] : gb[i & 3], g2 = (i < 4) ? gc[i & 3] : gd[i & 3];
                const float cs = lat ? ((i < 4) ? ca[i & 3] : cb[i & 3]) : 1.f, sn = lat ? ((i < 4) ? sa[i & 3] : sb[i & 3]) : 0.f;
                const float y1 = x1[i] * rs * g1, y2 = x2[i] * rs * g2; o1[i] = y1 * cs - y2 * sn; o2[i] = y2 * cs + y1 * sn; }
            u32x4 r1, r2; r1.x = cvt_pk_bf16(o1[0], o1[1]); r1.y = cvt_pk_bf16(o1[2], o1[3]); r1.z = cvt_pk_bf16(o1[4], o1[5]); r1.w = cvt_pk_bf16(o1[6], o1[7]);
            r2.x = cvt_pk_bf16(o2[0], o2[1]); r2.y = cvt_pk_bf16(o2[2], o2[3]); r2.z = cvt_pk_bf16(o2[4], o2[5]); r2.w = cvt_pk_bf16(o2[6], o2[7]);
            *(u32x4*)(Zo + (size_t)t * ZW + col) = r1; *(u32x4*)(Zo + (size_t)t * ZW + col + 32) = r2;
        } } }
    { const int sub = F.tid & 3, half = sub >> 1, j0 = (sub & 1) * 8;
      for (int g0 = qb * 128; g0 < (NTOK - NCTX) * 16; g0 += qG * 128) {
        const int g = g0 + (F.tid >> 2);
        if (g < (NTOK - NCTX) * 16) {
            const int p = g >> 4, vi = g & 15, t = p + NCTX; const int col = ((vi < 8) ? ZC_DQ + vi * 64 : ZC_DK + (vi - 8) * 64) + half * 32 + j0;
            const u32x4 w1 = *(const u32x4*)(Z + (size_t)t * ZW + col), w2 = *(const u32x4*)(Z + (size_t)t * ZW + col + 16);
            const int pos = half == 0 ? (p >> 6) : (p & 63);
            const f32x4 ca = *(const f32x4*)(cd + pos * 16 + j0), cb = *(const f32x4*)(cd + pos * 16 + j0 + 4), sa = *(const f32x4*)(sd + pos * 16 + j0), sb = *(const f32x4*)(sd + pos * 16 + j0 + 4);
            float x1[8], x2[8]; QK_UNPACK(w1, x1); QK_UNPACK(w2, x2);
            float o1[8], o2[8];
#pragma unroll
            for (int i = 0; i < 8; ++i) { const float cs = (i < 4) ? ca[i & 3] : cb[i & 3], sn = (i < 4) ? sa[i & 3] : sb[i & 3]; o1[i] = x1[i] * cs - x2[i] * sn; o2[i] = x2[i] * cs + x1[i] * sn; }
            u32x4 r1, r2; r1.x = cvt_pk_bf16(o1[0], o1[1]); r1.y = cvt_pk_bf16(o1[2], o1[3]); r1.z = cvt_pk_bf16(o1[4], o1[5]); r1.w = cvt_pk_bf16(o1[6], o1[7]);
            r2.x = cvt_pk_bf16(o2[0], o2[1]); r2.y = cvt_pk_bf16(o2[2], o2[3]); r2.z = cvt_pk_bf16(o2[4], o2[5]); r2.w = cvt_pk_bf16(o2[6], o2[7]);
            *(u32x4*)(Zo + (size_t)t * ZW + col) = r1; *(u32x4*)(Zo + (size_t)t * ZW + col + 16) = r2;
        } } }
#undef QK_UNPACK
}

__device__ __forceinline__ void gla_prep_unit(const Frame& F, const Args& a, int l, int n, int h) {
    const bf16_t* Z = (const bf16_t*)(F.ws + WS_Z); bf16_t* GQK = (bf16_t*)(F.ws + WS_GQK); bf16_t* GVT = (bf16_t*)(F.ws + WS_GVT);
    float* GU = (float*)(F.ws + WS_GU); float* GG = (float*)(F.ws + WS_GG);
    LAS unsigned char* L = F.lds;
    LAS float* zz = (LAS float*)L;
    LAS float* waf = (LAS float*)(L + 8192);
    LAS float* wab = (LAS float*)(L + 12288);
    LAS float* baf = (LAS float*)(L + 16384);
    LAS float* bab = (LAS float*)(L + 16640);
    LAS float* LF = (LAS float*)(L + 17408);
    LAS float* LB = (LAS float*)(L + 34304);
    LAS float* segF = (LAS float*)(L + 51200);
    LAS float* segB = (LAS float*)(L + 53248);
    LAS bf16_t* keTf = (LAS bf16_t*)(L + 55296);
    LAS bf16_t* keTb = (LAS bf16_t*)(L + 64512);
    LAS bf16_t* vT = (LAS bf16_t*)(L + 73728);
    int tz0 = threadIdx.x; asm volatile("" : "+v"(tz0));
    const int tid = tz0, tok0 = n * 64;
    __syncthreads();
    if (tid < 256) { const int c = tid >> 2, p8 = (tid & 3) * 8; const u32x4 w = *(const u32x4*)(Z + (size_t)(tok0 + c) * ZW + ZC_DEC + p8);
        LAS float* d = zz + c * 32 + p8; d[0] = bflo(w.x); d[1] = bfhi(w.x); d[2] = bflo(w.y); d[3] = bfhi(w.y); d[4] = bflo(w.z); d[5] = bfhi(w.z); d[6] = bflo(w.w); d[7] = bfhi(w.w); }
    for (int i = tid; i < 1024; i += NTHREADS) { const int r = i >> 6, d = i & 63; waf[i] = a.in[I_WAF][((size_t)l * 16 + r) * 256 + h * 64 + d]; wab[i] = a.in[I_WAB][((size_t)l * 16 + r) * 256 + h * 64 + d]; }
    if (tid < 64) { baf[tid] = a.in[I_BAF][l * 256 + h * 64 + tid]; bab[tid] = a.in[I_BAB][l * 256 + h * 64 + tid]; }
    __syncthreads();
    const int c = tid >> 3, d8 = (tid & 7) * 8;
    { float af[8], ab[8];
#pragma unroll
      for (int e = 0; e < 8; ++e) { af[e] = baf[d8 + e]; ab[e] = bab[d8 + e]; }
#pragma unroll
      for (int r = 0; r < 16; ++r) { const float zf = zz[c * 32 + r], zb = zz[c * 32 + 16 + r];
#pragma unroll
          for (int e = 0; e < 8; ++e) { af[e] += zf * waf[r * 64 + d8 + e]; ab[e] += zb * wab[r * 64 + d8 + e]; } }
#pragma unroll
      for (int e = 0; e < 8; ++e) { LF[c * 65 + d8 + e] = logsigmoid_f(af[e]) * (1.f / 16.f); LB[c * 65 + d8 + e] = logsigmoid_f(ab[e]) * (1.f / 16.f); } }
    __syncthreads();
    { const int d = tid & 63, seg = tid >> 6; float run = 0.f;
#pragma unroll
      for (int i = 0; i < 8; ++i) { run += LF[(8 * seg + i) * 65 + d]; LF[(8 * seg + i) * 65 + d] = run; }
      segF[seg * 64 + d] = run; run = 0.f;
#pragma unroll
      for (int i = 7; i >= 0; --i) { run += LB[(8 * seg + i) * 65 + d]; LB[(8 * seg + i) * 65 + d] = run; }
      segB[seg * 64 + d] = run; }
    __syncthreads();
    { const int d = tid & 63, seg = tid >> 6; float of = 0.f, ob = 0.f;
      for (int s = 0; s < 8; ++s) { if (s < seg) of += segF[s * 64 + d]; if (s > seg) ob += segB[s * 64 + d]; }
#pragma unroll
      for (int i = 0; i < 8; ++i) { LF[(8 * seg + i) * 65 + d] += of; LB[(8 * seg + i) * 65 + d] += ob; } }
    __syncthreads();
    { const size_t zrow = (size_t)(tok0 + c) * ZW;
      const u32x4 qw = *(const u32x4*)(Z + zrow + ZC_GQ + h * 64 + d8), kw = *(const u32x4*)(Z + zrow + ZC_GK + h * 64 + d8);
      float q[8] = {bflo(qw.x), bfhi(qw.x), bflo(qw.y), bfhi(qw.y), bflo(qw.z), bfhi(qw.z), bflo(qw.w), bfhi(qw.w)};
      float k[8] = {bflo(kw.x), bfhi(kw.x), bflo(kw.y), bfhi(kw.y), bflo(kw.z), bfhi(kw.z), bflo(kw.w), bfhi(kw.w)};
      float qdf[8], kif[8], qdb[8], kib[8];
#pragma unroll
      for (int e = 0; e < 8; ++e) { const float cf = LF[c * 65 + d8 + e], cb = LB[c * 65 + d8 + e];
          qdf[e] = q[e] * __expf(cf); kif[e] = k[e] * __expf(-cf); qdb[e] = q[e] * __expf(cb); kib[e] = k[e] * __expf(-cb);
          keTf[(d8 + e) * 72 + c] = f2bf(k[e] * __expf(LF[63 * 65 + d8 + e] - cf)); keTb[(d8 + e) * 72 + c] = f2bf(k[e] * __expf(LB[d8 + e] - cb)); }
      bf16_t* go = GQK + (size_t)(tok0 + c) * 1024 + h * 64 + d8;
#define PK8(x) (u32x4){cvt_pk_bf16(x[0], x[1]), cvt_pk_bf16(x[2], x[3]), cvt_pk_bf16(x[4], x[5]), cvt_pk_bf16(x[6], x[7])}
      *(u32x4*)(go) = PK8(qdf); *(u32x4*)(go + 256) = PK8(kif); *(u32x4*)(go + 512) = PK8(qdb); *(u32x4*)(go + 768) = PK8(kib);
#undef PK8
#pragma unroll
      for (int i = 0; i < 2; ++i) { const int p = tid + NTHREADS * i, cc = p >> 4, v8 = (p & 15) * 8; const u32x4 w = *(const u32x4*)(Z + (size_t)(tok0 + cc) * ZW + ZC_GV + h * 128 + v8);
          vT[(v8 + 0) * 72 + cc] = (bf16_t)(w.x & 0xffff); vT[(v8 + 1) * 72 + cc] = (bf16_t)(w.x >> 16); vT[(v8 + 2) * 72 + cc] = (bf16_t)(w.y & 0xffff); vT[(v8 + 3) * 72 + cc] = (bf16_t)(w.y >> 16);
          vT[(v8 + 4) * 72 + cc] = (bf16_t)(w.z & 0xffff); vT[(v8 + 5) * 72 + cc] = (bf16_t)(w.z >> 16); vT[(v8 + 6) * 72 + cc] = (bf16_t)(w.w & 0xffff); vT[(v8 + 7) * 72 + cc] = (bf16_t)(w.w >> 16); }
      if (tid < 64) GG[((size_t)(n * 4 + h) * 2 + 0) * 64 + tid] = __expf(LF[63 * 65 + tid]);
      else if (tid < 128) GG[((size_t)(n * 4 + h) * 2 + 1) * 64 + tid - 64] = __expf(LB[tid - 64]); }
    __syncthreads();
    { const int v = tid >> 2, c16 = (tid & 3) * 16; const u32x4 w0 = *(const LAS u32x4*)(vT + v * 72 + c16), w1 = *(const LAS u32x4*)(vT + v * 72 + c16 + 8);
      u32x4* dp = (u32x4*)(GVT + ((size_t)(n * 4 + h) * 128 + v) * 64 + c16); dp[0] = w0; dp[1] = w1; }
    { const int w = tid >> 6, vb = w >> 1, db = w & 1, r32 = tid & 31, hi = (tid >> 5) & 1;
#pragma unroll
      for (int dir = 0; dir < 2; ++dir) { LAS bf16_t* keT = dir ? keTb : keTf; f32x16 acc = {};
#pragma unroll
          for (int ks = 0; ks < 4; ++ks) { const bf16x8 A = *(const LAS bf16x8*)(vT + (vb * 32 + r32) * 72 + 16 * ks + 8 * hi), B = *(const LAS bf16x8*)(keT + (db * 32 + r32) * 72 + 16 * ks + 8 * hi);
              acc = __builtin_amdgcn_mfma_f32_32x32x16_bf16(A, B, acc, 0, 0, 0); }
          float* up = GU + ((size_t)(n * 4 + h) * 2 + dir) * 8192;
#pragma unroll
          for (int r = 0; r < 16; ++r) up[(vb * 32 + attn::crow(r, hi)) * 64 + db * 32 + r32] = acc[r]; } }
}
__device__ __forceinline__ void gla_scan(const Frame& F_) {
    LOCAL_FRAME(F, F_);
    const float* GU = (const float*)(F.ws + WS_GU); const float* GG = (const float*)(F.ws + WS_GG); bf16_t* GS = (bf16_t*)(F.ws + WS_GS);
    constexpr int NS = 4, HS = NCHUNK / NS; static_assert(NCHUNK % NS == 0, "equal segments");
    LAS float* cs = (LAS float*)F.lds;
    LAS float* cp = cs + NS * 128;
    const int per = (4 * 2 * 8192 + F.G - 1) / F.G;
    __syncthreads();
    for (int base = 0; base < per; base += 128) {
        const int cl = F.tid & 127, ci = base + cl, seg = F.tid >> 7, g = F.bid * per + ci; const bool ok = ci < per && g < 4 * 2 * 8192;
        const int d = g & 63, vd = g & 8191, dir = (g >> 13) & 1, h = g >> 14;
        float uu[HS], gg[HS];
#define GS_OFF(i) ({ const int step_ = seg * HS + (i); const int nn_ = dir == 0 ? step_ : (step_ < 4 ? 3 - step_ : NCHUNK + 3 - step_); (nn_ * 4 + h) * 2 + dir; })
#pragma unroll
        for (int i = 0; i < HS; ++i) { const int ob = ok ? GS_OFF(i) : 0; uu[i] = GU[(size_t)ob * 8192 + vd]; gg[i] = GG[ob * 64 + d]; }
        float s = 0.f, P = 1.f;
#pragma unroll
        for (int i = 0; i < HS; ++i) { const float u = uu[i], gd = gg[i]; uu[i] = s; gg[i] = P; s = gd * s + u; P *= gd; }
        cs[seg * 128 + cl] = s; cp[seg * 128 + cl] = P;
        __syncthreads();
        float s_in = 0.f;
        for (int k = 0; k < seg; ++k) s_in = cp[k * 128 + cl] * s_in + cs[k * 128 + cl];
        if (ok) {
#pragma unroll
            for (int i = 0; i < HS; ++i) GS[(size_t)GS_OFF(i) * 8192 + vd] = f2bf(uu[i] + gg[i] * s_in); }
        __syncthreads();
#undef GS_OFF
    }
}
__device__ __forceinline__ void gla_out_unit(const Frame& F, const Args& a, int l, int n, int h, int dummy = 0) {
    const bf16_t* Z = (const bf16_t*)(F.ws + WS_Z); const bf16_t* GQK = (const bf16_t*)(F.ws + WS_GQK); const bf16_t* GVT = (const bf16_t*)(F.ws + WS_GVT);
    const bf16_t* GS = (const bf16_t*)(F.ws + WS_GS); unsigned char* MIX = F.ws + (dummy ? WS_DUMMY : 0) + WS_MIX;
    LAS bf16_t* T = (LAS bf16_t*)F.lds;
    LAS float* ssq = (LAS float*)(F.lds + 92160);
    int tz0 = threadIdx.x; asm volatile("" : "+v"(tz0));
    const int tid = tz0, tok0 = n * 64;
    __syncthreads();
    { const int c = tid >> 3, d8 = (tid & 7) * 8; const bf16_t* gp = GQK + (size_t)(tok0 + c) * 1024 + h * 64 + d8;
#pragma unroll
      for (int kd = 0; kd < 4; ++kd) *(LAS u32x4*)(T + kd * 4608 + c * 72 + d8) = *(const u32x4*)(gp + kd * 256);
#pragma unroll
      for (int i = 0; i < 2; ++i) { const int p = tid + NTHREADS * i, v = p >> 3, c8 = (p & 7) * 8;
          *(LAS u32x4*)(T + 18432 + v * 72 + c8) = *(const u32x4*)(GVT + ((size_t)(n * 4 + h) * 128 + v) * 64 + c8);
          *(LAS u32x4*)(T + 27648 + v * 72 + c8) = *(const u32x4*)(GS + ((size_t)(n * 4 + h) * 2 + 0) * 8192 + v * 64 + c8);
          *(LAS u32x4*)(T + 36864 + v * 72 + c8) = *(const u32x4*)(GS + ((size_t)(n * 4 + h) * 2 + 1) * 8192 + v * 64 + c8); } }
    __syncthreads();
    const int w = tid >> 6, cb = w & 1, vb = w >> 1, r32 = tid & 31, hi = (tid >> 5) & 1;
    f32x16 O = {};
#pragma unroll
    for (int dir = 0; dir < 2; ++dir) {
        LAS bf16_t* Q = T + (dir ? 9216 : 0); LAS bf16_t* Kt = T + (dir ? 13824 : 4608); LAS bf16_t* ST = T + (dir ? 36864 : 27648); LAS bf16_t* vT = T + 18432;
        bf16x8 qf[4];
#pragma unroll
        for (int ks = 0; ks < 4; ++ks) qf[ks] = *(const LAS bf16x8*)(Q + (cb * 32 + r32) * 72 + 16 * ks + 8 * hi);
#pragma unroll
        for (int ks = 0; ks < 4; ++ks) { const bf16x8 B = *(const LAS bf16x8*)(ST + (vb * 32 + r32) * 72 + 16 * ks + 8 * hi); O = __builtin_amdgcn_mfma_f32_32x32x16_bf16(qf[ks], B, O, 0, 0, 0); }
#pragma unroll
        for (int sb = 0; sb < 2; ++sb) {
            if ((dir == 0 && sb > cb) || (dir == 1 && sb < cb)) continue;
            f32x16 X = {};
#pragma unroll
            for (int ks = 0; ks < 4; ++ks) { const bf16x8 A = *(const LAS bf16x8*)(Kt + (sb * 32 + r32) * 72 + 16 * ks + 8 * hi); X = __builtin_amdgcn_mfma_f32_32x32x16_bf16(A, qf[ks], X, 0, 0, 0); }
            if (sb == cb) {
#pragma unroll
                for (int r = 0; r < 16; ++r) { const int s = attn::crow(r, hi); const bool keep = dir == 0 ? (s <= r32) : (s >= r32); X[r] = keep ? X[r] : 0.f; } }
#pragma unroll
            for (int kk = 0; kk < 2; ++kk) {
                u32x4 pw = {cvt_pk_bf16(X[8 * kk + 0], X[8 * kk + 1]), cvt_pk_bf16(X[8 * kk + 2], X[8 * kk + 3]), cvt_pk_bf16(X[8 * kk + 4], X[8 * kk + 5]), cvt_pk_bf16(X[8 * kk + 6], X[8 * kk + 7])};
                const bf16x8 pa = *reinterpret_cast<bf16x8*>(&pw);
                const u32x2 lo = *(const LAS u32x2*)(vT + (vb * 32 + r32) * 72 + sb * 32 + 16 * kk + 4 * hi), hh = *(const LAS u32x2*)(vT + (vb * 32 + r32) * 72 + sb * 32 + 16 * kk + 8 + 4 * hi);
                u32x4 bw = {lo.x, lo.y, hh.x, hh.y};
                O = __builtin_amdgcn_mfma_f32_32x32x16_bf16(pa, *reinterpret_cast<bf16x8*>(&bw), O, 0, 0, 0); }
        }
    }
#pragma unroll
    for (int r = 0; r < 16; ++r) { float ss = O[r] * O[r];
#pragma unroll
        for (int s = 16; s >= 1; s >>= 1) ss += __shfl_xor(ss, s, 64);
        if (r32 == 0) ssq[(cb * 32 + attn::crow(r, hi)) * 4 + vb] = ss; }
    __syncthreads();
    const float gn = a.in[I_GLAG][l * 128 + vb * 32 + r32];
#pragma unroll
    for (int r = 0; r < 16; ++r) { const int c = cb * 32 + attn::crow(r, hi); const f32x4 q4 = *(const LAS f32x4*)(ssq + c * 4);
        const float rs = rsqrtf((q4[0] + q4[1] + q4[2] + q4[3]) * (1.f / 128.f) + NORM_EPS);
        const float gate = bf2f(Z[(size_t)(tok0 + c) * ZW + ZC_GG + h * 128 + vb * 32 + r32]);
        const float on = O[r] * rs * gn;
        MIX[(size_t)(tok0 + c) * DM + h * 128 + vb * 32 + r32] = f2fp8_x16(on * silu_f(gate)); }
}
__device__ __forceinline__ void phase_router(const Frame& F_, const Args& a, int l, int tok0, int ntok, int dummy) {
    LOCAL_FRAME(F, F_);
    unsigned char* wso = F.ws + (dummy ? WS_DUMMY : 0);
    const bf16_t* X = (const bf16_t*)(F.ws + WS_X); unsigned char* A8 = F.ws + WS_A8;
    const float* mod = (const float*)(F.ws + WS_MOD) + (size_t)l * 2 * 6 * DM;
    const bf16_t* RH = (const bf16_t*)(F.ws + WS_RWT) + (size_t)l * 2 * NEXP * DM; const bf16_t* RL = RH + (size_t)NEXP * DM;
    const float* rb = a.in[I_RB] + l * NEXP; const float* n2g = a.in[I_N2G] + (size_t)l * DM;
    unsigned* cnt = (unsigned*)(F.ws + WS_CTL) + (dummy ? CW_CNTD : CW_CNT) + l * NEXP;
    int* list = (int*)(wso + WS_LIST); int* toke = (int*)(wso + WS_TOKE); int* tokp = (int*)(wso + WS_TOKP); float* tokw = (float*)(wso + WS_TOKW);
    constexpr int BT = 17;
    LAS unsigned char* up = F.lds + LDS_STAGE + LDS_MISC;
#define RT_HI(r) (F.lds + (r) * 4096)
#define RT_LO(r) (((r) < 15) ? F.lds + 69632 + (r) * 4096 : up + ((r) - 15) * 4096)
    LAS float* part = (LAS float*)(up + 8192);
    LAS int* selE = (LAS int*)(up + 8192 + 8704);
    LAS float* selW = (LAS float*)(up + 8192 + 8704 + 1536);
    LAS int* selR = (LAS int*)(up + 8192 + 8704 + 3072);
    LAS int* hist = (LAS int*)(up + 8192 + 8704 + 4608);
    LAS int* base = (LAS int*)(up + 8192 + 8704 + 4864);
    const int lane = F.lane;
    const int per = (ntok + F.G - 1) / F.G;
    const int t0 = F.bid * per, t1 = (t0 + per < ntok) ? t0 + per : ntok, nmine = t1 > t0 ? t1 - t0 : 0;
    __syncthreads();
    if (F.tid < 64) hist[F.tid] = 0;
    u32x2 xw[3][8];
#define RT_LOADX(b) do { _Pragma("unroll") for (int q = 0; q < 3; ++q) { const int jl_ = F.wave + 8 * q, j_ = (b) * BT + jl_; if (jl_ < BT) { \
        const bf16_t* xr_ = X + (size_t)(tok0 + t0 + (j_ < nmine ? j_ : 0)) * DM; \
        _Pragma("unroll") for (int k = 0; k < 8; ++k) xw[q][k] = *(const u32x2*)(xr_ + k * 256 + lane * 4); } } } while (0)
    if (nmine > 0) RT_LOADX(0);
    for (int b = 0; b * BT < nmine; ++b) {
#pragma unroll
        for (int q = 0; q < 3; ++q) { const int jl = F.wave + 8 * q, j = b * BT + jl;
            if (jl < BT && j < nmine) { const int t = tok0 + t0 + j; const float* m = mod + (size_t)(t < NCTX ? 0 : 1) * 6 * DM;
                LAS unsigned char* hr = RT_HI(jl); LAS unsigned char* lr = RT_LO(jl);
                f32x4 v[8]; float ss = 0.f;
#pragma unroll
                for (int k = 0; k < 8; ++k) { v[k] = (f32x4){bflo(xw[q][k].x), bfhi(xw[q][k].x), bflo(xw[q][k].y), bfhi(xw[q][k].y)}; ss += v[k][0] * v[k][0] + v[k][1] * v[k][1] + v[k][2] * v[k][2] + v[k][3] * v[k][3]; }
                ss = wave_sum(ss); const float rs = rsqrtf(ss * (1.f / DM) + NORM_EPS);
#pragma unroll
                for (int k = 0; k < 8; ++k) { const int i = k * 256 + lane * 4;
                    const f32x4 gg = *(const f32x4*)(n2g + i), s0 = *(const f32x4*)(m + 3 * DM + i), s1 = *(const f32x4*)(m + 4 * DM + i);
                    const f32x4 y = v[k] * rs * gg * (s1 + 1.f) + s0;
                    u32x2 wh; wh.x = cvt_pk_bf16(y[0], y[1]); wh.y = cvt_pk_bf16(y[2], y[3]);
                    u32x2 wl; wl.x = cvt_pk_bf16(y[0] - bflo(wh.x), y[1] - bfhi(wh.x)); wl.y = cvt_pk_bf16(y[2] - bflo(wh.y), y[3] - bfhi(wh.y));
                    const int sb = (i * 2) ^ ((jl & 15) << 4);
                    *(LAS u32x2*)(hr + sb) = wh; *(LAS u32x2*)(lr + sb) = wl;
                    *(unsigned*)(A8 + (size_t)t * DM + i) = cvt4_fp8(y[0], y[1], y[2], y[3]); } } }
        if ((b + 1) * BT < nmine) RT_LOADX(b + 1);
        __syncthreads();
        { const int i16 = lane & 15, k4 = lane >> 4, nt = F.wave & 3, kh = F.wave >> 2;
          const bool two = (b * BT + 16) < nmine;
          f32x4 acc0 = {0.f, 0.f, 0.f, 0.f}, acc1 = acc0;
          const bf16_t* bhp = RH + (size_t)(nt * 16 + i16) * DM + kh * 1024 + 8 * k4; const bf16_t* blp = RL + (size_t)(nt * 16 + i16) * DM + kh * 1024 + 8 * k4;
          LAS unsigned char* h0 = RT_HI(i16); LAS unsigned char* l0 = RT_LO(i16); LAS unsigned char* h1 = RT_HI(16); LAS unsigned char* l1 = RT_LO(16);
          constexpr int PG = 4;
          bf16x8 bh[PG], bl[PG];
#pragma unroll
          for (int u = 0; u < PG; ++u) { bh[u] = *(const bf16x8*)(bhp + u * 32); bl[u] = *(const bf16x8*)(blp + u * 32); }
#pragma unroll
          for (int g = 0; g < 32 / PG; ++g) { bf16x8 nh[PG], nl[PG];
              if (g + 1 < 32 / PG) {
#pragma unroll
                  for (int u = 0; u < PG; ++u) { nh[u] = *(const bf16x8*)(bhp + ((g + 1) * PG + u) * 32); nl[u] = *(const bf16x8*)(blp + ((g + 1) * PG + u) * 32); } }
#pragma unroll
              for (int u = 0; u < PG; ++u) { const int kb = (kh * 1024 + (g * PG + u) * 32 + 8 * k4) * 2;
                  const bf16x8 ah = *(const LAS bf16x8*)(h0 + (kb ^ (i16 << 4))), al = *(const LAS bf16x8*)(l0 + (kb ^ (i16 << 4)));
                  acc0 = __builtin_amdgcn_mfma_f32_16x16x32_bf16(al, bh[u], acc0, 0, 0, 0);
                  acc0 = __builtin_amdgcn_mfma_f32_16x16x32_bf16(ah, bl[u], acc0, 0, 0, 0);
                  acc0 = __builtin_amdgcn_mfma_f32_16x16x32_bf16(ah, bh[u], acc0, 0, 0, 0);
                  if (two) { const bf16x8 ch = *(const LAS bf16x8*)(h1 + kb), cl = *(const LAS bf16x8*)(l1 + kb);
                      acc1 = __builtin_amdgcn_mfma_f32_16x16x32_bf16(cl, bh[u], acc1, 0, 0, 0);
                      acc1 = __builtin_amdgcn_mfma_f32_16x16x32_bf16(ch, bl[u], acc1, 0, 0, 0);
                      acc1 = __builtin_amdgcn_mfma_f32_16x16x32_bf16(ch, bh[u], acc1, 0, 0, 0); } }
              if (g + 1 < 32 / PG) {
#pragma unroll
                  for (int u = 0; u < PG; ++u) { bh[u] = nh[u]; bl[u] = nl[u]; } } }
#pragma unroll
          for (int r = 0; r < 4; ++r) part[(kh * BT + 4 * k4 + r) * 64 + nt * 16 + i16] = acc0[r];
          if (two && k4 == 0) part[(kh * BT + 16) * 64 + nt * 16 + i16] = acc1[0]; }
        __syncthreads();
#pragma unroll 1
        for (int q = 0; q < 3; ++q) { const int jl = F.wave + 8 * q, j = b * BT + jl; if (jl >= BT || j >= nmine) break;
            const float lg = part[jl * 64 + lane] + part[(BT + jl) * 64 + lane];
            const float s = sigmoid_f(lg); float sv = s + rb[lane]; float ssum = 0.f, mys = 0.f; int myk = -1;
#pragma unroll
            for (int k = 0; k < TOPK; ++k) { const float mx = wave_max(sv); const unsigned long long bal = __ballot(sv == mx); const int win = __ffsll((long long)bal) - 1;
                const float ws_ = __shfl(s, win, 64); ssum += ws_; if (lane == win) { sv = -3.0e38f; myk = k; mys = s; } }
            if (myk >= 0) { const int rank = atomicAdd((int*)&hist[lane], 1); selE[j * 8 + myk] = lane; selW[j * 8 + myk] = mys / ssum * 2.5f; selR[j * 8 + myk] = rank; } }
    }
#undef RT_LOADX
#undef RT_HI
#undef RT_LO
    __syncthreads();
    if (F.tid < 64) base[F.tid] = hist[F.tid] > 0 ? (int)atomicAdd(&cnt[F.tid], (unsigned)hist[F.tid]) : 0;
    __syncthreads();
    for (int i = F.tid; i < nmine * 8; i += NTHREADS) { const int j = i >> 3, k = i & 7; const int tglob = tok0 + t0 + j; const int e = selE[i], pos = base[e] + selR[i];
        list[(size_t)e * NTOK + pos] = tglob; toke[(size_t)tglob * 8 + k] = e; tokp[(size_t)tglob * 8 + k] = pos; tokw[(size_t)tglob * 8 + k] = selW[i]; }
}

__device__ __forceinline__ void phase_combine(const Frame& F_, const Args& a, int l, int tok0, int ntok, int dummy) {
    LOCAL_FRAME(F, F_);
    unsigned char* wso = F.ws + (dummy ? WS_DUMMY : 0);
    const bf16_t* X = (const bf16_t*)(F.ws + WS_X); bf16_t* Xo = (bf16_t*)(wso + WS_X); bf16_t* A = (bf16_t*)(wso + WS_A); const unsigned char* Y = F.ws + WS_Y;
    const float* mod = (const float*)(F.ws + WS_MOD) + (size_t)l * 2 * 6 * DM;
    const int* toke = (const int*)(F.ws + WS_TOKE); const int* tokp = (const int*)(F.ws + WS_TOKP); const float* tokw = (const float*)(F.ws + WS_TOKW);
    const LAS int* rbS = (const LAS int*)(F.lds + LDS_STAGE + MS_RB);
    const int lane = F.lane;
    for (int tl = F.bid * 8 + F.wave; tl < ntok; tl += F.G * 8) { const int t = tok0 + tl;
        int rowv = 0; float wv = 0.f;
        if (lane < 8) { const int e = toke[(size_t)t * 8 + lane]; rowv = rbS[e] + tokp[(size_t)t * 8 + lane]; wv = tokw[(size_t)t * 8 + lane]; }
        int rows[9]; float wts[9];
#pragma unroll
        for (int s = 0; s < 8; ++s) { rows[s] = __builtin_amdgcn_readlane(rowv, s); wts[s] = __uint_as_float(__builtin_amdgcn_readlane(__float_as_uint(wv), s)); }
        rows[8] = rbS[NEXP] + tl; wts[8] = 1.f;
        f32x4 acc[8];
#pragma unroll
        for (int k = 0; k < 8; ++k) acc[k] = (f32x4){0.f, 0.f, 0.f, 0.f};
        { unsigned w[9][8];
#pragma unroll
          for (int r = 0; r < 9; ++r) { const unsigned char* yr = Y + (size_t)rows[r] * DM + lane * 4;
#pragma unroll
              for (int k = 0; k < 8; ++k) w[r][k] = *(const unsigned*)(yr + k * 256); }
#pragma unroll
          for (int r = 0; r < 9; ++r) { const float wg = wts[r];
#pragma unroll
              for (int k = 0; k < 8; ++k) { const auto lo = __builtin_amdgcn_cvt_pk_f32_fp8((int)w[r][k], false), hi = __builtin_amdgcn_cvt_pk_f32_fp8((int)w[r][k], true);
                  acc[k] += wg * (f32x4){lo[0], lo[1], hi[0], hi[1]}; } } }
        const float* m = mod + (size_t)(t < NCTX ? 0 : 1) * 6 * DM; const bf16_t* xr = X + (size_t)t * DM; bf16_t* xo = Xo + (size_t)t * DM; float ss = 0.f;
#pragma unroll
        for (int k = 0; k < 8; ++k) { const int i = k * 256 + lane * 4; const f32x4 g2 = *(const f32x4*)(m + 5 * DM + i); const u32x2 xw = *(const u32x2*)(xr + i); const f32x4 xv = {bflo(xw.x), bfhi(xw.x), bflo(xw.y), bfhi(xw.y)};
            acc[k] = xv + g2 * acc[k]; ss += acc[k][0] * acc[k][0] + acc[k][1] * acc[k][1] + acc[k][2] * acc[k][2] + acc[k][3] * acc[k][3]; }
        ss = wave_sum(ss); const float rs = rsqrtf(ss * (1.f / DM) + NORM_EPS);
        if (l + 1 < DEPTH) {
            const float* mn = (const float*)(F.ws + WS_MOD) + ((size_t)(l + 1) * 2 + (t < NCTX ? 0 : 1)) * 6 * DM; const float* g = a.in[I_N1G] + (size_t)(l + 1) * DM;
#pragma unroll
            for (int k = 0; k < 8; ++k) { const int i = k * 256 + lane * 4; { u32x2 xo2; xo2.x = cvt_pk_bf16(acc[k][0], acc[k][1]); xo2.y = cvt_pk_bf16(acc[k][2], acc[k][3]); *(u32x2*)(xo + i) = xo2; }
                const f32x4 gg = *(const f32x4*)(g + i), s0 = *(const f32x4*)(mn + i), s1 = *(const f32x4*)(mn + DM + i);
                const f32x4 y = acc[k] * rs * gg * (s1 + 1.f) + s0; u32x2 w; w.x = cvt_pk_bf16(y[0], y[1]); w.y = cvt_pk_bf16(y[2], y[3]); *(u32x2*)(A + (size_t)t * DM + i) = w; }
        } else {
            float* orow = (dummy ? (float*)(F.ws + WS_DUMMY + WS_X) : a.out) + (size_t)(t - NCTX) * DM; const float* g = a.in[I_FG];
#pragma unroll
            for (int k = 0; k < 8; ++k) { const int i = k * 256 + lane * 4; const f32x4 gg = *(const f32x4*)(g + i); *(f32x4*)(orow + i) = acc[k] * rs * gg; }
        }
    }
}

__device__ __forceinline__ float diff_lambda(const Args& a, int l) {
    float s1 = 0.f, s2 = 0.f;
    for (int i = 0; i < 64; ++i) { s1 += a.in[I_LQ1][l * 64 + i] * a.in[I_LK1][l * 64 + i]; s2 += a.in[I_LQ2][l * 64 + i] * a.in[I_LK2][l * 64 + i]; }
    const float lam = expf(s1) - expf(s2) + (l == 0 ? 0.2f : 0.35550907f);
    return __uint_as_float(__builtin_amdgcn_readfirstlane(__float_as_uint(lam)));
}
template <int BGL>
__device__ __forceinline__ void attn_gqa_unit(const Frame& F, int hq, int row0, int seq, const attn::BgArgs bg) {
    const bf16_t* Z = (const bf16_t*)(F.ws + WS_Z); unsigned char* MIX = F.ws + WS_MIX; const int kv = hq >> 2;
    attn::OutArgs oa; oa.mix = MIX + (size_t)row0 * DM + 512 + hq * 128; oa.scr = nullptr; oa.lam = 0.f; oa.osc = 0.f; oa.ng = nullptr;
    attn::body<128, 0, BGL>(Z + (size_t)row0 * ZW + ZC_AQ + hq * 128, Z + ZC_AK + kv * 128, Z + ZC_AV + kv * 128, seq, (char*)F.lds, oa, bg);
}
template <int BGL>
__device__ __forceinline__ void attn_diff_unit(const Frame& F, const Args& a, int l, int hd, int row0, int seq, float lam, const attn::BgArgs bg) {
    const bf16_t* Z = (const bf16_t*)(F.ws + WS_Z); unsigned char* MIX = F.ws + WS_MIX;
    attn::OutArgs oa; oa.mix = MIX + (size_t)row0 * DM + 1536 + hd * 128; oa.scr = (float*)(F.ws + WS_DSCR) + (size_t)F.bid * 256 * 128;
    oa.lam = lam; oa.osc = (l == 0 ? 0.8f : 0.64449093f); oa.ng = a.in[I_DNG] + l * 128;
    attn::body<64, 1, BGL>(Z + (size_t)row0 * ZW + ZC_DQ + hd * 128, Z + ZC_DK + hd * 128, Z + ZC_DV + hd * 128, seq, (char*)F.lds, oa, bg);
    attn::body<64, 2, BGL>(Z + (size_t)row0 * ZW + ZC_DQ + hd * 128 + 64, Z + ZC_DK + hd * 128 + 64, Z + ZC_DV + hd * 128, seq, (char*)F.lds, oa, bg);
}
struct AUnit { int type, p0, row0, seq; };
template <int l>
__device__ __forceinline__ bool attn_unit_of(int G, int bid, int vcu, int k, AUnit& u) {
    constexpr int nsmall = (l == 0 ? 12 : 0) + (l == 0 ? NCHUNK : NCHUNK - 4) * 4;
    int li;
    if (G == 256) { const int x = vcu >> 5, j = vcu & 31;
#if AT_PLAN == 1
        if (x < 4) { if (k == 0) li = x * 32 + j; else li = 384 + x * 32 + j + 128 * (k - 1); }
        else { if (k > 1) return false; li = 128 + (2 * (x - 4) + k) * 32 + j; }
#else
        if (j < 16) { if (k == 0) li = x * 16 + j; else { const int sm = x * 16 + j + 128 * (k - 1); if (sm >= SM_NA) return false; li = 384 + sm; } }
        else { if (k < 2) li = 128 + x * 32 + (j - 16) + 16 * k; else li = 384 + SM_NA + x * 16 + (j - 16) + 128 * (k - 2); }
#endif
    } else li = bid + k * G;
    if (li >= 384 + nsmall) return false;
    if (li < 128) { u.type = 1; u.p0 = li >> 5; u.row0 = NCTX + (li & 31) * 256; u.seq = NTOK; return true; }
    if (li < 384) { const int g = li - 128; u.type = 0; u.p0 = g >> 5; u.row0 = NCTX + (g & 31) * 256; u.seq = NTOK; return true; }
    int v = li - 384;
    if (l == 0) { if (v < 8) { u.type = 0; u.p0 = v; u.row0 = 0; u.seq = NCTX; return true; }
                  if (v < 12) { u.type = 1; u.p0 = v - 8; u.row0 = 0; u.seq = NCTX; return true; } v -= 12; }
    u.type = 2; u.p0 = v & 3; u.row0 = (l == 0) ? (v >> 2) : 4 + (v >> 2); u.seq = 0; return true;
}
template <int l>
__device__ __forceinline__ void phase_attention(const Frame& F, const Args& a) {
    const float lam = diff_lambda(a, l);
    const attn::BgArgs bg{nullptr, &a, F.ws, F.lds};
    for (int k = 0;; ++k) {
        AUnit u; if (!attn_unit_of<l>(F.G, F.bid, F.vcu, k, u)) break;
        const int nrep = ((REP_PH == 13 && u.type == 0) || (REP_PH == 14 && u.type == 1) || (REP_PH == 15 && u.type == 2)) ? 2 : 1;
        for (int rep = 0; rep < nrep; ++rep) {
        if (u.type == 0) attn_gqa_unit<-1>(F, u.p0, u.row0, u.seq, bg);
        else if (u.type == 1) attn_diff_unit<-1>(F, a, l, u.p0, u.row0, u.seq, lam, bg);
        else gla_out_unit(F, a, l, rep ? (u.row0 + 66) % NCHUNK : u.row0, u.p0, rep); }
    }
#if WC_ATT
    { unsigned* done = (unsigned*)(F.ws + WS_CTL) + CW_DONE + 32 * (8 + l);
      __syncthreads();
      if (F.tid == 0) __hip_atomic_fetch_add(done, 1u, __ATOMIC_RELAXED, __HIP_MEMORY_SCOPE_AGENT);
      wc_work(a, F.ws, F.lds, (unsigned*)(F.ws + WS_CTL), WC_CH_TOTAL, done, (unsigned)F.G); }
#endif
}

constexpr int PH_PRO = 0, PH_N1 = 1, PH_L0 = 2, PH_PER_LAYER = 9, N_PHASES = PH_L0 + DEPTH * PH_PER_LAYER;
#ifndef REP_PH
#define REP_PH -1
#endif
#if !MK_PER_PHASE
#define SEAM(k) do { if ((k) + 1 < hi) { xcd_barrier(bar); if (REP_PH == 12) xcd_barrier(bar); } } while (0)
#define LP_BAR , bar
#else
#define SEAM(k) do { } while (0)
#define LP_BAR
#endif
#ifdef ONLY_PH
#define PHSEL(k) (((k) < PH_L0 ? (k) : PH_L0 + ((k) - PH_L0) % PH_PER_LAYER) == ONLY_PH)
#else
#define PHSEL(k) true
#endif
#define IN(k) (PHSEL(k) && lo <= (k) && (k) < hi)
#define PHCLASS(k) ((k) < PH_L0 ? (k) : PH_L0 + ((k) - PH_L0) % PH_PER_LAYER)
#define NREP(k) ((PHCLASS(k) == REP_PH) ? 2 : 1)
template <int l>
__device__ __forceinline__ void layer_phases(const Frame& F, const Args& args, unsigned* ctl, const int lo, const int hi
#if !MK_PER_PHASE
    , const XcdBarrier& bar
#endif
    ) {
        const int pb = PH_L0 + l * PH_PER_LAYER;
        const int tok0 = (l == 0) ? 0 : NCTX, ntok = NTOK - tok0;
#define GEMM_DONE(k) (ctl + CW_DONE + 32 * (l * 4 + (k)))
#define SIGNAL_DONE(k) do { if (F.tid == 0) __hip_atomic_fetch_add(GEMM_DONE(k), 1u, __ATOMIC_RELAXED, __HIP_MEMORY_SCOPE_AGENT); } while (0)
        bf16_t* A = (bf16_t*)(F.ws + WS_A); bf16_t* Zb = (bf16_t*)(F.ws + WS_Z); bf16_t* X = (bf16_t*)(F.ws + WS_X);
        const float* mod = (const float*)(F.ws + WS_MOD) + (size_t)l * 2 * 6 * DM;
        if (IN(pb + 0)) {
            const int ge = (WC_TAIL & 1) ? F.G : wc_geff((NTOK / 256) * (ZW / 256), F.G);
            if (F.bid < ge) {
                DenseSched S; S.init(NTOK, ZW, DM * 2, ge, F.bid, 0, (const bf16_t*)(F.ws + WS_BTIN) + (size_t)l * ZW * DM);
                EpiZ E{Zb, ZW};
                for (int rep = 0; rep < NREP(pb + 0); ++rep) pg8::gemm_phase<EpiZ, DenseSched, false>(F.lds, A, DM * 2, S, E);
                SIGNAL_DONE(0);
                if (WC_TAIL & 1) wc_work(args, F.ws, F.lds, ctl, WC_CH_TOTAL, GEMM_DONE(0), (unsigned)ge);
            } else if (WC_MASK & 1) wc_work(args, F.ws, F.lds, ctl, WC_CH_TOTAL, GEMM_DONE(0), (unsigned)ge);
            SEAM(pb + 0);
        }
        if (IN(pb + 1)) {
            for (int rep = 0; rep < NREP(pb + 1); ++rep) for (int u = F.bid; u < NCHUNK * 4; u += F.G) gla_prep_unit(F, args, l, u >> 2, u & 3);
            { const int n3 = NCHUNK * 4 - 2 * F.G; const bool split = n3 > 0 && n3 < F.G;
              if (!split) { for (int rep = ((REP_PH == 16) ? 1 : 0); rep >= 0; --rep) qk_prep(F, args, l, rep, F.bid, F.G); }
              else if (F.bid >= n3) { for (int rep = ((REP_PH == 16) ? 1 : 0); rep >= 0; --rep) qk_prep(F, args, l, rep, F.bid - n3, F.G - n3); } }
            SEAM(pb + 1);
        }
        if (IN(pb + 2)) { for (int rep = 0; rep < NREP(pb + 2); ++rep) gla_scan(F); SEAM(pb + 2); }
        if (IN(pb + 3)) { for (int rep = 0; rep < NREP(pb + 3); ++rep) phase_attention<l>(F, args); SEAM(pb + 3); }
        if (IN(pb + 4)) {
            constexpr int NOUT = (l == 0) ? WC_NOUT : WC_NOUT1;
            const int ge = (F.G % 8 == 0 && F.G > NOUT) ? NOUT : F.G;
            if (F.bid < ge) {
                DenseSched S; S.init(ntok, DM, DM, ge, F.bid, tok0, F.ws + WS_BTOUT + (size_t)l * DM * DM);
                for (int rep = NREP(pb + 4) - 1; rep >= 0; --rep) { EpiOut E{X, mod + 2 * DM, mod + 6 * DM + 2 * DM, rep ? (bf16_t*)(F.ws + WS_DUMMY + WS_X) : X};
                    pg8::gemm_phase<EpiOut, DenseSched, true>(F.lds, F.ws + WS_MIX, DM, S, E); }
            }
            wc_work(args, F.ws, F.lds, ctl, l * WC_CH_LAYER + WC_CH_GU, nullptr, 0u);
            SEAM(pb + 4);
        }
        if (IN(pb + 5)) { wc_work(args, F.ws, F.lds, ctl, l * WC_CH_LAYER + WC_CH_GU, nullptr, 0u); __syncthreads();
            for (int rep = NREP(pb + 5) - 1; rep >= 0; --rep) phase_router(F, args, l, tok0, ntok, rep); SEAM(pb + 5); }
        if (IN(pb + 6)) {
            moe_tables(F, ctl + CW_CNT + l * NEXP, ntok);
            const int ge = wc_geff(*(const LAS int*)(F.lds + LDS_STAGE + MS_NT) * 4, F.G), ge8 = ge >> 3;
            const bool gemm_wg = (ge == F.G) || (F.bid >> 3) < ge8;
            MoeSched<4, true> S; S.misc = F.lds + LDS_STAGE; S.G = ge; S.c = (ge == F.G) ? F.vcu : (F.bid & 7) * ge8 + (F.bid >> 3); S.RB = DM; S.tok0 = tok0;
            S.Bt = F.ws + WS_BTGU + (size_t)l * 65 * 1024 * DM; S.bstride = (size_t)1024 * DM; S.list = (const int*)(F.ws + WS_LIST);
            if (gemm_wg) {
                for (int rep = ((REP_PH == 18 || REP_PH == 8) ? 1 : 0); rep >= 0; --rep) { EpiUp E{F.ws + WS_H, (REP_PH == 18 && rep) ? 1 : 0};
                    pg8::gemm_phase<EpiUp, MoeSched<4, true>, true>(F.lds, F.ws + WS_A8, DM, S, E); }
                SIGNAL_DONE(2);
            } else if (WC_MASK & 4) wc_work(args, F.ws, F.lds, ctl, WC_CH_TOTAL, GEMM_DONE(2), (unsigned)ge);
            wc_work(args, F.ws, F.lds, ctl, (l + 1) * WC_CH_LAYER, nullptr, 0u);
            SEAM(pb + 6);
        }
        if (IN(pb + 7)) {
            moe_tables(F, ctl + CW_CNT + l * NEXP, ntok);
            const int ge = wc_geff(*(const LAS int*)(F.lds + LDS_STAGE + MS_NT) * 8, F.G), ge8 = ge >> 3;
            const bool gemm_wg = (ge == F.G) || (F.bid >> 3) < ge8;
            MoeSched<8, false> S; S.misc = F.lds + LDS_STAGE; S.G = ge; S.c = (ge == F.G) ? F.vcu : (F.bid & 7) * ge8 + (F.bid >> 3); S.RB = EH; S.tok0 = tok0;
            S.Bt = F.ws + WS_BTD + (size_t)l * 65 * DM * EH; S.bstride = (size_t)DM * EH; S.list = nullptr;
            if (gemm_wg) {
                for (int rep = ((REP_PH == 17 || REP_PH == 9) ? 1 : 0); rep >= 0; --rep) { EpiDown E{F.ws + WS_Y, (REP_PH == 17 && rep) ? 1 : 0};
                    pg8::gemm_phase<EpiDown, MoeSched<8, false>, true>(F.lds, F.ws + WS_H, EH, S, E); }
                SIGNAL_DONE(3);
            } else if (WC_MASK & 8) wc_work(args, F.ws, F.lds, ctl, WC_CH_TOTAL, GEMM_DONE(3), (unsigned)ge);
            SEAM(pb + 7);
        }
        if (IN(pb + 8)) {
            moe_tables(F, ctl + CW_CNT + l * NEXP, ntok);
            for (int rep = NREP(pb + 8) - 1; rep >= 0; --rep) phase_combine(F, args, l, tok0, ntok, rep);
            SEAM(pb + 8);
        }
    }
__global__ void __launch_bounds__(NTHREADS, 2) fwd(Args args) {
    extern __shared__ __attribute__((aligned(16))) unsigned char lds_raw[];
    Frame F; F.lds = (LAS unsigned char*)lds_raw; F.ws = args.ws;
    F.tid = threadIdx.x; F.lane = F.tid & 63; F.wave = __builtin_amdgcn_readfirstlane(F.tid >> 6); F.G = gridDim.x; F.bid = blockIdx.x;
    F.vcu = (F.G % 8 == 0) ? (F.bid % 8) * (F.G / 8) + F.bid / 8 : F.bid;
    unsigned* ctl = (unsigned*)(F.ws + WS_CTL);
    const int lo = args.ph_lo, hi = args.ph_hi;
#if !MK_PER_PHASE
    if (F.tid < 4) ((LAS unsigned*)(F.lds + LDS_STAGE))[F.tid] = 0u;
    __syncthreads();
    XcdBarrier bar = xcd_barrier_post(ctl + CW_BAR, (volatile LAS unsigned*)(F.lds + LDS_STAGE));
#endif
    if (IN(PH_PRO)) {
        for (int rep = 0; rep < ((REP_PH == 11) ? 2 : 1); ++rep) mod_gemv(F, args.in[I_C], args.in[I_CCTX], args.in[I_WMOD], args.in[I_BMOD], (float*)(F.ws + WS_MOD));
        small_tables(F, (float*)(F.ws + WS_ROPE), args.in[I_RW], (float*)(F.ws + WS_RWT));
        for (int rep = 0; rep < NREP(PH_PRO); ++rep) { convert_weights(F, args);
            }
        SEAM(PH_PRO);
    }
    if (IN(PH_N1)) { for (int rep = 0; rep < NREP(PH_N1); ++rep) phase_norm1(F, args); SEAM(PH_N1); }
    layer_phases<0>(F, args, ctl, lo, hi LP_BAR);
    layer_phases<1>(F, args, ctl, lo, hi LP_BAR);
#undef IN
#undef SEAM
}

extern "C" void kernel_launch(void* const* d_in, const int* in_sizes, int n_in, void* d_out, int out_size, void* d_ws, size_t ws_size, hipStream_t stream) {
    static int grid = 0;
    if (grid == 0) {
        if (n_in != 31 || out_size != SEQ * DM || ws_size < WS_END + (REP_PH >= 0 ? WS_DUMMY_BYTES : 0)) { fprintf(stderr, "kernel_launch: expected 31 inputs, out %d, ws >= %zu; got n_in %d out %d ws %zu\n", SEQ * DM, (size_t)WS_END, n_in, out_size, ws_size); grid = -1; return; }
        int dev = 0, cus = 0, per_cu = 0;
        if (hipGetDevice(&dev) != hipSuccess || hipDeviceGetAttribute(&cus, hipDeviceAttributeMultiprocessorCount, dev) != hipSuccess) { grid = -1; return; }
        if (hipFuncSetAttribute((const void*)fwd, hipFuncAttributeMaxDynamicSharedMemorySize, LDS_BYTES) != hipSuccess) { fprintf(stderr, "kernel_launch: hipFuncSetAttribute failed\n"); grid = -1; return; }
        if (hipOccupancyMaxActiveBlocksPerMultiprocessor(&per_cu, (const void*)fwd, NTHREADS, LDS_BYTES) != hipSuccess || per_cu < 1) fprintf(stderr, "kernel_launch: occupancy query says %d\n", per_cu);
        (void)hipGetLastError();
        grid = cus;
    }
    if (grid < 0) return;
    (void)hipMemsetAsync((char*)d_ws + WS_CTL, 0, CTL_BYTES, stream);
    Args a{};
    for (int i = 0; i < 31; ++i) a.in[i] = (const float*)d_in[i];
    a.out = (float*)d_out; a.ws = (unsigned char*)d_ws;
#if MK_PER_PHASE
    for (int p = 0; p < N_PHASES; ++p) { a.ph_lo = p; a.ph_hi = p + 1; hipLaunchKernelGGL(fwd, dim3(grid), dim3(NTHREADS), LDS_BYTES, stream, a); }
#else
    a.ph_lo = 0; a.ph_hi = N_PHASES;
    hipLaunchKernelGGL(fwd, dim3(grid), dim3(NTHREADS), LDS_BYTES, stream, a);
#endif
    const hipError_t le = hipPeekAtLastError();
    if (le != hipSuccess) fprintf(stderr, "kernel_launch: launch failed: %s\n", hipGetErrorName(le));
}
```

```cpp
#include <hip/hip_runtime.h>
#include <stdint.h>
#include <stdio.h>

#ifndef WC_MASK
#define WC_MASK 0
#endif
#ifndef WC_TAIL
#define WC_TAIL 0
#endif
#ifndef SM_NA
#define SM_NA 4096
#endif
#ifndef WC_ATT
#define WC_ATT 1
#endif
#ifndef AT_PLAN
#define AT_PLAN 1
#endif
#ifndef WC_NOUT1
#define WC_NOUT1 128
#endif
#ifndef WC_NOUT
#define WC_NOUT 176
#endif
#ifndef REP_PH
#define REP_PH -1
#endif
#ifndef MK_PER_PHASE
#define MK_PER_PHASE 0
#endif

typedef unsigned short bf16_t;
typedef short bf16x8 __attribute__((ext_vector_type(8)));
typedef short s16x4 __attribute__((ext_vector_type(4)));
typedef float f32x4 __attribute__((ext_vector_type(4)));
typedef float f32x16 __attribute__((ext_vector_type(16)));
typedef unsigned u32x4 __attribute__((ext_vector_type(4)));
typedef unsigned u32x2 __attribute__((ext_vector_type(2)));
typedef int i32x4 __attribute__((ext_vector_type(4)));
typedef int i32x8 __attribute__((ext_vector_type(8)));
#define LAS __attribute__((address_space(3)))

constexpr int DM = 2048, SEQ = 8192, NCTX = 256, NTOK = SEQ + NCTX, DEPTH = 2;
constexpr int GRIDW = 64;
constexpr int IN_W = 4640, ZW = 4864;
constexpr int ZC_GQ = 0, ZC_GK = 256, ZC_GV = 512, ZC_GG = 1024, ZC_AQ = 1536, ZC_AK = 2560, ZC_AV = 2816, ZC_DQ = 3072, ZC_DK = 3584, ZC_DV = 4096, ZC_DEC = 4608;
constexpr int NEXP = 64, TOPK = 8, EH = 512;
constexpr int NCHUNK = NTOK / 64;
constexpr float NORM_EPS = 1e-6f;
constexpr int HROWS = 92416;
constexpr int NTHREADS = 512;

constexpr size_t al256(size_t x) { return (x + 255) / 256 * 256; }
constexpr size_t WS_CTL   = 0;
constexpr size_t CTL_BYTES = 65536;
constexpr size_t WS_MOD   = WS_CTL + CTL_BYTES;
constexpr size_t WS_ROPE  = WS_MOD + al256((size_t)2 * 2 * 6 * DM * 4);
constexpr size_t WS_RWT   = WS_ROPE + al256((size_t)(128 * 32 * 2 + 128 * 16 * 2) * 4);
constexpr size_t WS_BTIN  = WS_RWT + al256((size_t)2 * NEXP * DM * 4);
constexpr size_t WS_BTOUT = WS_BTIN + al256((size_t)2 * ZW * DM * 2);
constexpr size_t WS_BTGU  = WS_BTOUT + al256((size_t)2 * DM * DM * 2);
constexpr size_t WS_BTD   = WS_BTGU + al256((size_t)2 * 65 * 1024 * DM * 2);
constexpr size_t WS_X     = WS_BTD + al256((size_t)2 * 65 * DM * EH * 2);
constexpr size_t WS_A     = WS_X + al256((size_t)NTOK * DM * 4);
constexpr size_t WS_Z     = WS_A + al256((size_t)NTOK * DM * 2);
constexpr size_t WS_GQK   = WS_Z + al256((size_t)NTOK * ZW * 2);
constexpr size_t WS_GVT   = WS_GQK + al256((size_t)NTOK * 4 * 256 * 2);
constexpr size_t WS_GU    = WS_GVT + al256((size_t)NCHUNK * 4 * 128 * 64 * 2);
constexpr size_t WS_GG    = WS_GU + al256((size_t)NCHUNK * 4 * 2 * 128 * 64 * 4);
constexpr size_t WS_GS    = WS_GG + al256((size_t)NCHUNK * 4 * 2 * 64 * 4);
constexpr size_t WS_MIX   = WS_GS + al256((size_t)NCHUNK * 4 * 2 * 128 * 64 * 2);
constexpr size_t WS_DSCR  = WS_MIX + al256((size_t)NTOK * DM * 2);
constexpr size_t WS_LIST  = WS_DSCR + al256((size_t)256 * 256 * 128 * 4);
constexpr size_t WS_TOKE  = WS_LIST + al256((size_t)NEXP * NTOK * 4);
constexpr size_t WS_TOKP  = WS_TOKE + al256((size_t)NTOK * 8 * 4);
constexpr size_t WS_TOKW  = WS_TOKP + al256((size_t)NTOK * 8 * 4);
constexpr size_t WS_H     = WS_TOKW + al256((size_t)NTOK * 8 * 4);
constexpr size_t WS_Y     = WS_H + al256((size_t)HROWS * EH * 2);
constexpr size_t WS_AF    = WS_Y + al256((size_t)HROWS * DM * 2);
constexpr size_t WS_A8    = WS_AF + al256((size_t)NTOK * DM * 4);
constexpr size_t WS_END   = WS_A8 + al256((size_t)NTOK * DM);
constexpr size_t WS_DUMMY = WS_END - WS_X;
constexpr size_t WS_DUMMY_BYTES = WS_H - WS_X;

constexpr int CW_BAR = 0;
constexpr int CW_CNT = 4096;
constexpr int CW_Q   = 4352;
constexpr int CW_DONE = 4800;
constexpr int CW_CNTD = 4608;

constexpr int LDS_STAGE = 131072;
constexpr int LDS_MISC  = 8192;
constexpr int LDS_BYTES = 163840;
constexpr int MS_CNT = 64;
constexpr int MS_RB  = 64 + 68 * 4;
constexpr int MS_TE  = MS_RB + 68 * 4;
constexpr int MS_TM  = MS_TE + 1024;
constexpr int MS_NT  = MS_TM + 1024;
constexpr int MS_F   = MS_NT + 16;

__device__ __forceinline__ unsigned cvt_pk_bf16(float lo, float hi) { unsigned r; asm volatile("v_cvt_pk_bf16_f32 %0, %1, %2" : "=v"(r) : "v"(lo), "v"(hi)); return r; }
__device__ __forceinline__ bf16_t f2bf(float x) { return (bf16_t)(cvt_pk_bf16(x, 0.f) & 0xffffu); }
__device__ __forceinline__ float clamp448(float x) { return __builtin_fminf(__builtin_fmaxf(x, -448.f), 448.f); }
__device__ __forceinline__ unsigned cvt4_fp8(float a, float b, float c, float d) { a = clamp448(a); b = clamp448(b); c = clamp448(c); d = clamp448(d); int w = __builtin_amdgcn_cvt_pk_fp8_f32(a, b, 0, false); w = __builtin_amdgcn_cvt_pk_fp8_f32(c, d, w, true); return (unsigned)w; }
__device__ __forceinline__ unsigned char f2fp8_x16(float x) { return (unsigned char)(__builtin_amdgcn_cvt_pk_fp8_f32(clamp448(x * 16.f), 0.f, 0, false) & 0xff); }
__device__ __forceinline__ float bf2f(bf16_t b) { return __uint_as_float(((unsigned)b) << 16); }
__device__ __forceinline__ float bflo(unsigned w) { return __uint_as_float(w << 16); }
__device__ __forceinline__ float bfhi(unsigned w) { return __uint_as_float(w & 0xffff0000u); }
__device__ __forceinline__ float wave_sum(float v) {
#pragma unroll
    for (int o = 32; o >= 1; o >>= 1) v += __shfl_xor(v, o, 64);
    return v;
}
__device__ __forceinline__ float wave_max(float v) {
#pragma unroll
    for (int o = 32; o >= 1; o >>= 1) v = fmaxf(v, __shfl_xor(v, o, 64));
    return v;
}
__device__ __forceinline__ float silu_f(float x) { return x / (1.f + __expf(-x)); }
__device__ __forceinline__ float sigmoid_f(float x) { return 1.f / (1.f + expf(-x)); }
__device__ __forceinline__ float logsigmoid_f(float x) { return fminf(x, 0.f) - __logf(1.f + __expf(-fabsf(x))); }
#define VM_WAIT() asm volatile("s_waitcnt vmcnt(0)" ::: "memory")

#define XB_TMO      128
#define XB_XCNT(j)  (256  + 64 * (j))
#define XB_XSUB(j)  (1280 + 64 * (j))
#define XB_XGEN(j)  (2304 + 64 * (j))
#define XB_TOP      3328
#define XB_TOPGEN   3392
#define XCD_BAR_WORDS 3456
#define XB_SPIN_CAP (1u << 22)
__device__ __forceinline__ unsigned xb_ld(unsigned* p)              { return __hip_atomic_load(p, __ATOMIC_RELAXED, __HIP_MEMORY_SCOPE_AGENT); }
__device__ __forceinline__ unsigned xb_add(unsigned* p, unsigned v) { return __hip_atomic_fetch_add(p, v, __ATOMIC_RELAXED, __HIP_MEMORY_SCOPE_AGENT); }
__device__ __forceinline__ unsigned xb_xcc_id() { return (unsigned)__builtin_amdgcn_s_getreg((3 << 11) | 20) & 0xFu; }
#define XB_SPIN(cond, bar) do { unsigned _sp = 0; while (cond) { __builtin_amdgcn_s_sleep(1); \
    if ((++_sp & 255u) == 0u) { if (xb_ld(&(bar)[XB_TMO])) break; if (_sp > XB_SPIN_CAP) { atomicAdd(&(bar)[XB_TMO], 1u); break; } } } } while (0)
struct XcdBarrier { unsigned* bar; unsigned x; volatile LAS unsigned* st; };
__device__ __forceinline__ XcdBarrier xcd_barrier_post(unsigned* bar, volatile LAS unsigned* st) {
    XcdBarrier b; b.bar = bar; b.x = xb_xcc_id(); b.st = st;
    if (threadIdx.x == 0) (void)xb_add(&bar[XB_XCNT(b.x)], 1u);
    return b;
}
__device__ __forceinline__ void xcd_barrier_complete(unsigned* bar, unsigned x, unsigned& nloc, unsigned& nx) {
    const unsigned G = gridDim.x * gridDim.y * gridDim.z;
    unsigned sum, cnt, mine, sp = 0u;
    for (;;) {
        sum = 0u; cnt = 0u; mine = 0u;
#pragma unroll
        for (unsigned j = 0; j < 16; ++j) { const unsigned c = xb_ld(&bar[XB_XCNT(j)]); sum += c; cnt += (c > 0u) ? 1u : 0u; mine = (j == x) ? c : mine; }
        if (sum == G) break;
        __builtin_amdgcn_s_sleep(1);
        if ((++sp & 255u) == 0u) { if (xb_ld(&bar[XB_TMO])) break; if (sp > XB_SPIN_CAP) { atomicAdd(&bar[XB_TMO], 1u); break; } }
    }
    nloc = mine > 0u ? mine : 1u; nx = cnt > 0u ? cnt : 1u;
}
__device__ __forceinline__ void xcd_barrier(const XcdBarrier& b) {
    asm volatile("s_waitcnt vmcnt(0)" ::: "memory");
    __syncthreads();
    if (threadIdx.x == 0) {
        unsigned* bar = b.bar;
        __builtin_amdgcn_s_waitcnt(0);
        unsigned nloc = b.st[0], nx = b.st[1];
        if (nloc == 0u) { xcd_barrier_complete(bar, b.x, nloc, nx); b.st[0] = nloc; b.st[1] = nx; }
        const unsigned old = xb_add(&bar[XB_XSUB(b.x)], 1u);
        const unsigned gen = old / nloc;
        if (old + 1u == (gen + 1u) * nloc) {
            __builtin_amdgcn_fence(__ATOMIC_RELEASE, "agent");
            asm volatile("s_waitcnt vmcnt(0)" ::: "memory");
            const unsigned og = xb_add(&bar[XB_TOP], 1u);
            const unsigned tg = og / nx;
            if (og + 1u == (tg + 1u) * nx) xb_add(&bar[XB_TOPGEN], 1u);
            else XB_SPIN(xb_ld(&bar[XB_TOPGEN]) == tg, bar);
            __builtin_amdgcn_fence(__ATOMIC_ACQUIRE, "agent");
            xb_add(&bar[XB_XGEN(b.x)], 1u);
            asm volatile("s_waitcnt vmcnt(0)" ::: "memory");
        } else {
            XB_SPIN(xb_ld(&bar[XB_XGEN(b.x)]) == gen, bar);
            __builtin_amdgcn_fence(__ATOMIC_ACQUIRE, "agent");
            asm volatile("s_waitcnt vmcnt(0)" ::: "memory");
        }
    }
    __syncthreads();
}

struct Args {
    const float* in[31];
    float* out;
    unsigned char* ws;
    int ph_lo, ph_hi;
};
struct Frame {
    LAS unsigned char* lds;
    unsigned char* ws;
    int tid, lane, wave, G, bid, vcu;
};
#define LOCAL_FRAME(F, F_) Frame F = F_; { int tz_ = threadIdx.x; asm volatile("" : "+v"(tz_)); F.tid = tz_; F.lane = tz_ & 63; }
enum { I_X = 0, I_C, I_CTX, I_CCTX, I_N1G, I_N2G, I_WMOD, I_BMOD, I_WIN, I_WAF, I_BAF, I_WAB, I_BAB, I_GLAG, I_QNG, I_KNG,
       I_LQ1, I_LK1, I_LQ2, I_LK2, I_DNG, I_WOUT, I_RW, I_RB, I_EWG, I_EWU, I_EWD, I_SWG, I_SWU, I_SWD, I_FG };
constexpr int WC_CH_E = 128;
constexpr int WC_CH_GU = 2 * 65 * WC_CH_E, WC_CH_D = 65 * WC_CH_E, WC_CH_LAYER = WC_CH_GU + WC_CH_D, WC_CH_TOTAL = DEPTH * WC_CH_LAYER;
constexpr int WC_TROW = 80, WC_TILE = 128 * WC_TROW;
struct WConv {};
__device__ __forceinline__ void wc_chunk(const Args& a, unsigned char* ws, LAS unsigned char* T, int c, int lane) {
    const int l = c / WC_CH_LAYER, r = c % WC_CH_LAYER;
    int kind, e, cb, kb, ld;
    if (r < WC_CH_GU) { kind = r / WC_CH_D; const int rr = r % WC_CH_D; e = rr / WC_CH_E; const int q = rr % WC_CH_E; cb = q >> 5; kb = q & 31; ld = EH; }
    else { kind = 2; const int rr = r - WC_CH_GU; e = rr / WC_CH_E; const int q = rr % WC_CH_E; cb = q >> 3; kb = q & 7; ld = DM; }
    const float* src = (kind == 0) ? ((e < NEXP) ? a.in[I_EWG] + ((size_t)l * NEXP + e) * DM * EH : a.in[I_SWG] + (size_t)l * DM * EH)
                     : (kind == 1) ? ((e < NEXP) ? a.in[I_EWU] + ((size_t)l * NEXP + e) * DM * EH : a.in[I_SWU] + (size_t)l * DM * EH)
                                   : ((e < NEXP) ? a.in[I_EWD] + ((size_t)l * NEXP + e) * EH * DM : a.in[I_SWD] + (size_t)l * EH * DM);
    const uintptr_t pb = (uintptr_t)src; const unsigned pl = __builtin_amdgcn_readfirstlane((unsigned)pb), ph = __builtin_amdgcn_readfirstlane((unsigned)(pb >> 32));
    const __amdgpu_buffer_rsrc_t rs = __builtin_amdgcn_make_buffer_rsrc((void*)(((uintptr_t)ph << 32) | pl), 0, 0x7fffffff, 0x00020000);
    const int h = lane >> 5, c4 = (lane & 31) * 4, ld4 = ld * 4;
    const int soff = __builtin_amdgcn_readfirstlane((kb * 64 * ld + cb * 128) * 4), vofs = (h * 32 * ld + c4) * 4;
    f32x4 v[32];
#pragma unroll
    for (int j = 0; j < 32; ++j) { const u32x4 t = __builtin_amdgcn_raw_buffer_load_b128(rs, vofs, soff + j * ld4, 2); v[j] = *reinterpret_cast<const f32x4*>(&t); }
    const float scale = (kind < 2) ? 64.f : 32.f;
#pragma unroll
    for (int jc = 0; jc < 4; ++jc) {
#pragma unroll
        for (int hh = 0; hh < 2; ++hh) { u32x4 w;
#pragma unroll
            for (int d = 0; d < 4; ++d) { const int j = hh * 16 + d * 4; w[d] = cvt4_fp8(v[j][jc] * scale, v[j + 1][jc] * scale, v[j + 2][jc] * scale, v[j + 3][jc] * scale); }
            *(LAS u32x4*)(T + (c4 + jc) * WC_TROW + h * 32 + hh * 16) = w; } }
    unsigned char* d0 = (kind < 2) ? ws + WS_BTGU + (((size_t)l * 65 + e) * 1024 + 8 * (cb * 32) + 4 * kind) * DM + kb * 64
                                   : ws + WS_BTD + (((size_t)l * 65 + e) * DM + cb * 128) * EH + kb * 64;
#pragma unroll
    for (int half = 0; half < 2; ++half) { const int n = lane + half * 64;
        unsigned char* dp = d0 + ((kind < 2) ? (size_t)(8 * (n >> 2) + (n & 3)) * DM : (size_t)n * EH);
        u32x4 w[4];
#pragma unroll
        for (int i = 0; i < 4; ++i) w[i] = *(const LAS u32x4*)(T + n * WC_TROW + i * 16);
#pragma unroll
        for (int i = 0; i < 4; ++i) *(u32x4*)(dp + i * 16) = w[i]; }
}
__device__ __forceinline__ void wc_work(const Args& a, unsigned char* ws, LAS unsigned char* lds, unsigned* ctl, int limit, unsigned* done, unsigned need) {
    int tz = threadIdx.x; asm volatile("" : "+v"(tz));
    const int tid = tz, lane = tz & 63, wave = __builtin_amdgcn_readfirstlane(tz >> 6); LAS unsigned char* T = lds + wave * WC_TILE;
    LAS int* slot = (LAS int*)(lds + 8 * WC_TILE);
    unsigned* q = ctl + CW_Q;
    unsigned tk = 0, dn = 0; bool have = false;
    if (tid == 0) { const unsigned hd = __hip_atomic_load(q, __ATOMIC_RELAXED, __HIP_MEMORY_SCOPE_AGENT);
        if ((int)(hd * 8u) < limit) { tk = __hip_atomic_fetch_add(q, 1u, __ATOMIC_RELAXED, __HIP_MEMORY_SCOPE_AGENT); have = true; } }
    for (int it = 0;; ++it) {
        if (tid == 0) {
            int c0 = -1, more = 0;
            if (have) { c0 = (int)(tk * 8u); if (c0 >= WC_CH_TOTAL) c0 = -1; }
            if (c0 >= 0) { more = (c0 < limit) ? 1 : 0; if (done && dn >= need) more = 0;
                if (more) { tk = __hip_atomic_fetch_add(q, 1u, __ATOMIC_RELAXED, __HIP_MEMORY_SCOPE_AGENT); if (done) dn = __hip_atomic_load(done, __ATOMIC_RELAXED, __HIP_MEMORY_SCOPE_AGENT); } }
            slot[(it & 1) * 2] = c0; slot[(it & 1) * 2 + 1] = more;
        }
        __syncthreads();
        const int c0 = __builtin_amdgcn_readfirstlane(slot[(it & 1) * 2]), more = __builtin_amdgcn_readfirstlane(slot[(it & 1) * 2 + 1]);
        if (c0 < 0) break;
        wc_chunk(a, ws, T, c0 + wave, lane);
        if (!more) break;
    }
    __syncthreads();
}
__device__ __forceinline__ int wc_geff(int units, int G) {
    if (G % 8 != 0 || units <= 0) return G;
    const int k = (units + G - 1) / G; int ge = (((units + k - 1) / k) + 7) & ~7;
    return ge < G ? ge : G;
}
namespace pg8 {
constexpr int BM = 256, BK = 64, HALF = 128, HTB = HALF * BK * 2, STAGE_BYTES = 8 * HTB;
__device__ __forceinline__ int lds_byte(int r, int c) { const int st = (r >> 4) * 2 + (c >> 5), rr = r & 15, cc = c & 31, ob = rr * 64 + cc * 2; return st * 1024 + (ob ^ (((ob >> 9) & 1) << 5)); }
__device__ __forceinline__ void stage_rc(int b, int& R, int& C) { const int st = b / 1024, sb = b % 1024, swz = sb ^ (((sb >> 9) & 1) << 5); R = (st >> 1) * 16 + swz / 64; C = (st & 1) * 32 + (swz % 64) / 2; }
__device__ __forceinline__ int perm32(int rho) { const int n = rho >> 4, i = rho & 15; return 8 * (i >> 2) + 4 * n + (i & 3); }

template <class Epi, class Sched, bool F8>
__device__ __forceinline__ void gemm_phase(LAS unsigned char* lds, const void* Aptr, const int RB, const Sched& S, const Epi& E) {
    typedef typename Sched::Unit Unit;
    int tz0 = threadIdx.x; asm volatile("" : "+v"(tz0));
    const int tid = tz0, wid = __builtin_amdgcn_readfirstlane(tid >> 6), lane = tid & 63, wr = wid >> 2, wc = wid & 3, fr = lane & 15, fq = lane >> 4;
    const int nt = RB / 128;
    int sR[2], sC[2]; unsigned voffB[2][2];
#pragma unroll
    for (int i = 0; i < 2; ++i) { int R, C; stage_rc(tid * 16 + i * 8192, R, C); sR[i] = R; sC[i] = C;
        if (Epi::PERM == 2) {
#pragma unroll
            for (int h = 0; h < 2; ++h) voffB[h][i] = (unsigned)((64 * (R >> 5) + 16 * ((R >> 2) & 3) + 8 * h + 4 * ((R >> 4) & 1) + (R & 3)) * RB + C * 2); }
        else { const int Rb = Epi::PERM ? ((R & ~31) + perm32(R & 31)) : R; voffB[0][i] = (unsigned)(Rb * RB + C * 2); voffB[1][i] = voffB[0][i] + (unsigned)HALF * (unsigned)RB; } }
    const unsigned kstep = 128u;
    __amdgpu_buffer_rsrc_t rsA, rsB;
    { const uintptr_t pa = (uintptr_t)Aptr, pb = (uintptr_t)S.Bbase();
      const unsigned al = __builtin_amdgcn_readfirstlane((unsigned)pa), ah = __builtin_amdgcn_readfirstlane((unsigned)(pa >> 32));
      const unsigned bl = __builtin_amdgcn_readfirstlane((unsigned)pb), bh = __builtin_amdgcn_readfirstlane((unsigned)(pb >> 32));
      rsA = __builtin_amdgcn_make_buffer_rsrc((void*)(((uintptr_t)ah << 32) | al), 0, 0x7fffffff, 0x00020000);
      rsB = __builtin_amdgcn_make_buffer_rsrc((void*)(((uintptr_t)bh << 32) | bl), 0, 0x7fffffff, 0x00020000); }
    const unsigned ldsw = (unsigned)wid * 1024u;
    const int aoff = lds_byte(wr * 64 + fr, fq * 8), boff = lds_byte(wc * 32 + fr, fq * 8);
#define PG8_SA(b, h) (((b) * 2 + (h)) * HTB)
#define PG8_SB(b, h) ((4 + (b) * 2 + (h)) * HTB)
#define PG8_STAGEB(bufoff, soff, h) do { _Pragma("unroll") for (int _i = 0; _i < 2; ++_i) \
        __builtin_amdgcn_raw_ptr_buffer_load_lds(rsB, (LAS void*)(lds + (bufoff) + ldsw + _i * 8192), 16, voffB[h][_i], (int)(soff), 0, 0); } while (0)
#define PG8_STAGEA(bufoff, soff, v0, v1) do { \
        __builtin_amdgcn_raw_ptr_buffer_load_lds(rsA, (LAS void*)(lds + (bufoff) + ldsw), 16, (v0), (int)(soff), 0, 0); \
        __builtin_amdgcn_raw_ptr_buffer_load_lds(rsA, (LAS void*)(lds + (bufoff) + ldsw + 8192), 16, (v1), (int)(soff), 0, 0); } while (0)
#define PG8_LDA(dst, b, h) do { _Pragma("unroll") for (int m = 0; m < 4; ++m) dst[m] = __builtin_shufflevector(*(const LAS i32x4*)(lds + PG8_SA(b, h) + aoff + m * 2048), *(const LAS i32x4*)(lds + PG8_SA(b, h) + aoff + m * 2048 + 1024), 0, 1, 2, 3, 4, 5, 6, 7); } while (0)
#define PG8_LDB(dst, b, h) do { _Pragma("unroll") for (int n = 0; n < 2; ++n) dst[n] = __builtin_shufflevector(*(const LAS i32x4*)(lds + PG8_SB(b, h) + boff + n * 2048), *(const LAS i32x4*)(lds + PG8_SB(b, h) + boff + n * 2048 + 1024), 0, 1, 2, 3, 4, 5, 6, 7); } while (0)
#define PG8_H0(x) ({ i32x4 t_ = __builtin_shufflevector(x, x, 0, 1, 2, 3); *reinterpret_cast<bf16x8*>(&t_); })
#define PG8_H1(x) ({ i32x4 t_ = __builtin_shufflevector(x, x, 4, 5, 6, 7); *reinterpret_cast<bf16x8*>(&t_); })
#define PG8_MMA(ai, bj, At, Bt) do { __builtin_amdgcn_s_setprio(1); \
        if (F8) { _Pragma("unroll") for (int m = 0; m < 4; ++m) _Pragma("unroll") for (int n = 0; n < 2; ++n) \
            asm volatile("v_mfma_scale_f32_16x16x128_f8f6f4 %0, %1, %2, %0, %3, %4 op_sel_hi:[0,0,0]" : "+v"(acc[ai][bj][m][n]) : "v"(Bt[n]), "v"(At[m]), "v"(sclW), "v"(sclA)); } \
        else { _Pragma("unroll") for (int m = 0; m < 4; ++m) _Pragma("unroll") for (int n = 0; n < 2; ++n) { \
            acc[ai][bj][m][n] = __builtin_amdgcn_mfma_f32_16x16x32_bf16(PG8_H0(Bt[n]), PG8_H0(At[m]), acc[ai][bj][m][n], 0, 0, 0); \
            acc[ai][bj][m][n] = __builtin_amdgcn_mfma_f32_16x16x32_bf16(PG8_H1(Bt[n]), PG8_H1(At[m]), acc[ai][bj][m][n], 0, 0, 0); } } \
        __builtin_amdgcn_s_setprio(0); } while (0)
#define PG8_WAIT_V(n) asm volatile("s_waitcnt vmcnt(" #n ")" ::: "memory")
#define PG8_WAIT_L(n) asm volatile("s_waitcnt lgkmcnt(" #n ")" ::: "memory")
#define PG8_BAR __builtin_amdgcn_s_barrier()
#define PG8_SCHED __builtin_amdgcn_sched_barrier(0)
#define PG8_AOFFS(u, o00, o01, o10, o11) do { o00 = (unsigned)(S.row(u, sR[0]) * RB + sC[0] * 2); o01 = (unsigned)(S.row(u, sR[1]) * RB + sC[1] * 2); \
        o10 = (unsigned)(S.row(u, sR[0] + HALF) * RB + sC[0] * 2); o11 = (unsigned)(S.row(u, sR[1] + HALF) * RB + sC[1] * 2); } while (0)
    int sclW = E.wscale, sclA = E.ascale; if (F8) { asm volatile("" : "+v"(sclW), "+v"(sclA)); }
    Unit cur, nxt; int ui = 0;
    if (!S.next(0, cur)) return;
    f32x4 acc[2][2][4][2];
#pragma unroll
    for (int a = 0; a < 2; ++a)
#pragma unroll
        for (int b = 0; b < 2; ++b)
#pragma unroll
            for (int m = 0; m < 4; ++m)
#pragma unroll
                for (int n = 0; n < 2; ++n) acc[a][b][m][n] = (f32x4){0.f, 0.f, 0.f, 0.f};
    i32x8 At[4], B0[2], B1[2];
    unsigned cB = (unsigned)__builtin_amdgcn_readfirstlane((int)cur.boff);
    unsigned c00, c01, c10, c11, n00, n01, n10, n11;
    PG8_AOFFS(cur, c00, c01, c10, c11);
    n00 = c00; n01 = c01; n10 = c10; n11 = c11;
    PG8_STAGEB(PG8_SB(0, 0), cB, 0); PG8_STAGEA(PG8_SA(0, 0), 0u, c00, c01); PG8_STAGEB(PG8_SB(0, 1), cB, 1); PG8_STAGEA(PG8_SA(0, 1), 0u, c10, c11);
    if (wr == 1) PG8_BAR;
    PG8_WAIT_V(4); PG8_BAR;
    PG8_STAGEB(PG8_SB(1, 0), cB + kstep, 0); PG8_STAGEA(PG8_SA(1, 0), kstep, c00, c01); PG8_STAGEB(PG8_SB(1, 1), cB + kstep, 1);
    PG8_WAIT_V(6); PG8_BAR;
    for (;;) {
        const bool has_next = S.next(ui + 1, nxt);
        const unsigned nB = (unsigned)__builtin_amdgcn_readfirstlane((int)(has_next ? nxt.boff : cB));
        if (has_next) { PG8_AOFFS(nxt, n00, n01, n10, n11); } else { n00 = c00; n01 = c01; n10 = c10; n11 = c11; }
#pragma clang loop unroll(disable)
        for (int t = 0; t < nt; t += 2) {
            const bool last = (t == nt - 2);
            const unsigned a1 = (unsigned)__builtin_amdgcn_readfirstlane((int)((unsigned)(t + 1) * kstep));
            const unsigned a2 = (unsigned)__builtin_amdgcn_readfirstlane((int)(last ? 0u : (unsigned)(t + 2) * kstep)), b2 = (unsigned)__builtin_amdgcn_readfirstlane((int)(last ? nB : cB + (unsigned)(t + 2) * kstep));
            const unsigned a3 = a2 + kstep, b3 = b2 + kstep;
            const unsigned x00 = last ? n00 : c00, x01 = last ? n01 : c01, x10 = last ? n10 : c10, x11 = last ? n11 : c11;
            PG8_LDB(B0, 0, 0); PG8_SCHED; PG8_LDA(At, 0, 0); PG8_STAGEA(PG8_SA(1, 1), a1, c10, c11);
            PG8_WAIT_L(8); PG8_BAR; PG8_WAIT_L(0); PG8_MMA(0, 0, At, B0); PG8_BAR; PG8_SCHED;
            PG8_LDB(B1, 0, 1); PG8_STAGEB(PG8_SB(0, 0), b2, 0);
            PG8_BAR; PG8_WAIT_L(0); PG8_MMA(0, 1, At, B1); PG8_BAR;
            PG8_LDA(At, 0, 1); PG8_STAGEA(PG8_SA(0, 0), a2, x00, x01);
            PG8_BAR; PG8_WAIT_L(0); PG8_MMA(1, 0, At, B0); PG8_BAR; PG8_SCHED;
            PG8_STAGEB(PG8_SB(0, 1), b2, 1);
            PG8_WAIT_V(6); PG8_BAR; PG8_MMA(1, 1, At, B1); PG8_BAR;
            PG8_LDB(B0, 1, 0); PG8_SCHED; PG8_LDA(At, 1, 0); PG8_STAGEA(PG8_SA(0, 1), a2, x10, x11);
            PG8_WAIT_L(8); PG8_BAR; PG8_WAIT_L(0); PG8_MMA(0, 0, At, B0); PG8_BAR; PG8_SCHED;
            PG8_LDB(B1, 1, 1); PG8_STAGEB(PG8_SB(1, 0), b3, 0);
            PG8_BAR; PG8_WAIT_L(0); PG8_MMA(0, 1, At, B1); PG8_BAR;
            PG8_LDA(At, 1, 1); PG8_STAGEA(PG8_SA(1, 0), a3, x00, x01);
            PG8_BAR; PG8_WAIT_L(0); PG8_MMA(1, 0, At, B0); PG8_BAR; PG8_SCHED;
            PG8_STAGEB(PG8_SB(1, 1), b3, 1);
            PG8_WAIT_V(6); PG8_BAR; PG8_MMA(1, 1, At, B1); PG8_BAR;
        }
        if (F8) asm volatile("s_nop 15\n\ts_nop 15" ::: "memory");
        { int tz1 = threadIdx.x; asm volatile("" : "+v"(tz1));
          const int wid1 = __builtin_amdgcn_readfirstlane(tz1 >> 6), lane1 = tz1 & 63;
          E(acc, cur, wid1 >> 2, wid1 & 3, lane1 & 15, lane1 >> 4); }
        if (!has_next) break;
#pragma unroll
        for (int a = 0; a < 2; ++a)
#pragma unroll
            for (int b = 0; b < 2; ++b)
#pragma unroll
                for (int m = 0; m < 4; ++m)
#pragma unroll
                    for (int n = 0; n < 2; ++n) acc[a][b][m][n] = (f32x4){0.f, 0.f, 0.f, 0.f};
        cur = nxt; cB = nB; c00 = n00; c01 = n01; c10 = n10; c11 = n11; ++ui;
    }
    PG8_WAIT_V(0);
    if (wr == 0) PG8_BAR;
    PG8_BAR;
#undef PG8_SA
#undef PG8_SB
#undef PG8_STAGEA
#undef PG8_STAGEB
#undef PG8_LDA
#undef PG8_LDB
#undef PG8_MMA
#undef PG8_H0
#undef PG8_H1
#undef PG8_WAIT_V
#undef PG8_WAIT_L
#undef PG8_BAR
#undef PG8_SCHED
#undef PG8_AOFFS
}
}

struct DenseSched {
    struct Unit { unsigned boff; int pm, pn, m0; };
    int nM, nN, nwg, G, c, row0, RB  ; const void* Bt;
    __device__ void init(int M, int N, int RB_, int G_, int c_, int row0_, const void* Bt_) { nM = M / 256; nN = N / 256; nwg = nM * nN; G = G_; c = c_; row0 = row0_; RB = RB_; Bt = Bt_; }
    __device__ __forceinline__ bool next(int i, Unit& u) const {
        const long L = (long)i * G + c; if (L >= nwg) return false;
        int wgid = (int)L; { const int q = nwg / 8, r = nwg % 8, xcd = wgid % 8, off = wgid / 8; wgid = (xcd < r ? xcd * (q + 1) : r * (q + 1) + (xcd - r) * q) + off; }
        const int nig = 8 * nN, gid = wgid / nig, fm = gid * 8, gsz = (nM - fm) < 8 ? (nM - fm) : 8;
        u.pm = fm + ((wgid % nig) % gsz); u.pn = (wgid % nig) / gsz; u.m0 = row0 + u.pm * 256;
        u.boff = (unsigned)u.pn * 256u * (unsigned)RB; return true;
    }
    __device__ __forceinline__ int row(const Unit& u, int r) const { return u.m0 + r; }
    __device__ __forceinline__ int nrows(const Unit&) const { return 256; }
    __device__ __forceinline__ const void* Bbase() const { return Bt; }
};
template <int NTS, bool GATHER>
struct MoeSched {
    struct Unit { unsigned boff; int e, mt, pn, rows, hrow0; };
    LAS unsigned char* misc; int G, c, RB  , tok0; const unsigned char* Bt; size_t bstride  ; const int* list;
    __device__ __forceinline__ bool next(int i, Unit& u) const {
        const int ntiles = *(const LAS int*)(misc + MS_NT);
        const long L = (long)i * G + c; if (L >= (long)ntiles * NTS) return false;
        const int t = (int)(L / NTS); u.pn = (int)(L % NTS);
        u.e = ((const LAS short*)(misc + MS_TE))[t]; u.mt = ((const LAS short*)(misc + MS_TM))[t];
        const int cnt = ((const LAS int*)(misc + MS_CNT))[u.e]; const int rem = cnt - u.mt * 256; u.rows = rem < 256 ? rem : 256;
        u.hrow0 = ((const LAS int*)(misc + MS_RB))[u.e] + u.mt * 256;
        u.boff = (unsigned)u.e * (unsigned)bstride + (unsigned)u.pn * 256u * (unsigned)RB; return true;
    }
    __device__ __forceinline__ int row(const Unit& u, int r) const {
        if (GATHER) {
            const int rr = r < u.rows ? r : u.rows - 1;
            if (u.e == NEXP) return tok0 + u.mt * 256 + rr;
            return list[(size_t)u.e * NTOK + u.mt * 256 + rr];
        } else return u.hrow0 + r;
    }
    __device__ __forceinline__ int nrows(const Unit& u) const { return u.rows; }
    __device__ __forceinline__ const void* Bbase() const { return Bt; }
};

struct EpiZ {
    static constexpr int PERM = 1; static constexpr int wscale = 127, ascale = 127;
    bf16_t* O; int ldc;
    template <class U> __device__ __forceinline__ void operator()(const f32x4 (&acc)[2][2][4][2], const U& u, int wr, int wc, int fr, int fq) const {
        const int row0 = u.m0 + wr * 64 + fr, col0 = u.pn * 256 + wc * 32 + 8 * fq;
#pragma unroll
        for (int ai = 0; ai < 2; ++ai)
#pragma unroll
            for (int m = 0; m < 4; ++m) { bf16_t* rowp = O + (size_t)(row0 + ai * 128 + m * 16) * ldc + col0;
#pragma unroll
                for (int bj = 0; bj < 2; ++bj) { const f32x4 v0 = acc[ai][bj][m][0], v1 = acc[ai][bj][m][1];
                    u32x4 w; w.x = cvt_pk_bf16(v0[0], v0[1]); w.y = cvt_pk_bf16(v0[2], v0[3]); w.z = cvt_pk_bf16(v1[0], v1[1]); w.w = cvt_pk_bf16(v1[2], v1[3]);
                    *(u32x4*)(rowp + bj * 128) = w; } }
    }
};
struct EpiOut {
    static constexpr int PERM = 1; static constexpr int wscale = 121, ascale = 123;
    bf16_t* X; const float* gctx; const float* gx; bf16_t* Xo;
    template <class U> __device__ __forceinline__ void operator()(const f32x4 (&acc)[2][2][4][2], const U& u, int wr, int wc, int fr, int fq) const {
        const int row0 = u.m0 + wr * 64 + fr, col0 = u.pn * 256 + wc * 32 + 8 * fq;
        const float* g = (u.m0 < NCTX) ? gctx : gx;
        f32x4 gv[2][2];
#pragma unroll
        for (int bj = 0; bj < 2; ++bj)
#pragma unroll
            for (int n = 0; n < 2; ++n) gv[bj][n] = *(const f32x4*)(g + col0 + bj * 128 + n * 4);
#pragma unroll
        for (int ai = 0; ai < 2; ++ai)
#pragma unroll
            for (int m = 0; m < 4; ++m) { const size_t ro = (size_t)(row0 + ai * 128 + m * 16) * DM + col0; const bf16_t* rowp = X + ro; bf16_t* rowo = Xo + ro;
#pragma unroll
                for (int bj = 0; bj < 2; ++bj) { const u32x4 b = *(const u32x4*)(rowp + bj * 128);
                    const f32x4 v0 = (f32x4){bflo(b.x), bfhi(b.x), bflo(b.y), bfhi(b.y)} + gv[bj][0] * acc[ai][bj][m][0], v1 = (f32x4){bflo(b.z), bfhi(b.z), bflo(b.w), bfhi(b.w)} + gv[bj][1] * acc[ai][bj][m][1];
                    u32x4 w; w.x = cvt_pk_bf16(v0[0], v0[1]); w.y = cvt_pk_bf16(v0[2], v0[3]); w.z = cvt_pk_bf16(v1[0], v1[1]); w.w = cvt_pk_bf16(v1[2], v1[3]);
                    *(u32x4*)(rowo + bj * 128) = w; } }
    }
};
struct EpiUp {
    static constexpr int PERM = 2; static constexpr int wscale = 121, ascale = 127;
    unsigned char* H; int nostore;
    template <class U> __device__ __forceinline__ void operator()(const f32x4 (&acc)[2][2][4][2], const U& u, int wr, int wc, int fr, int fq) const {
        if (nostore) return;
        const int r0 = wr * 64 + fr, col0 = u.pn * 128 + wc * 32 + 8 * fq;
#pragma unroll
        for (int ai = 0; ai < 2; ++ai)
#pragma unroll
            for (int m = 0; m < 4; ++m) { const int r = r0 + ai * 128 + m * 16;
                if (r < u.rows) { u32x2 w;
                    { const f32x4 g = acc[ai][0][m][0], up = acc[ai][0][m][1]; w.x = cvt4_fp8(silu_f(g[0]) * up[0], silu_f(g[1]) * up[1], silu_f(g[2]) * up[2], silu_f(g[3]) * up[3]); }
                    { const f32x4 g = acc[ai][1][m][0], up = acc[ai][1][m][1]; w.y = cvt4_fp8(silu_f(g[0]) * up[0], silu_f(g[1]) * up[1], silu_f(g[2]) * up[2], silu_f(g[3]) * up[3]); }
                    *(u32x2*)(H + (size_t)(u.hrow0 + r) * EH + col0) = w; } }
    }
};
struct EpiDown {
    static constexpr int PERM = 2; static constexpr int wscale = 122, ascale = 127;
    unsigned char* Y; int nostore;
    template <class U> __device__ __forceinline__ void operator()(const f32x4 (&acc)[2][2][4][2], const U& u, int wr, int wc, int fr, int fq) const {
        const int r0 = wr * 64 + fr, col0 = u.pn * 256 + wc * 64 + 16 * fq;
#pragma unroll
        for (int ai = 0; ai < 2; ++ai)
#pragma unroll
            for (int m = 0; m < 4; ++m) { const int r = r0 + ai * 128 + m * 16;
                if (r < u.rows && !nostore) { u32x4 w;
                    w.x = cvt4_fp8(acc[ai][0][m][0][0], acc[ai][0][m][0][1], acc[ai][0][m][0][2], acc[ai][0][m][0][3]); w.y = cvt4_fp8(acc[ai][0][m][1][0], acc[ai][0][m][1][1], acc[ai][0][m][1][2], acc[ai][0][m][1][3]);
                    w.z = cvt4_fp8(acc[ai][1][m][0][0], acc[ai][1][m][0][1], acc[ai][1][m][0][2], acc[ai][1][m][0][3]); w.w = cvt4_fp8(acc[ai][1][m][1][0], acc[ai][1][m][1][1], acc[ai][1][m][1][2], acc[ai][1][m][1][3]);
                    *(u32x4*)(Y + (size_t)(u.hrow0 + r) * DM + col0) = w; } }
    }
};

__device__ __forceinline__ void moe_tables(const Frame& F_, const unsigned* cnt_g, int ntok) {
    LOCAL_FRAME(F, F_);
    LAS unsigned char* misc = F.lds + LDS_STAGE;
    LAS int* cntS = (LAS int*)(misc + MS_CNT); LAS int* rbS = (LAS int*)(misc + MS_RB);
    LAS short* te = (LAS short*)(misc + MS_TE); LAS short* tm = (LAS short*)(misc + MS_TM);
    __syncthreads();
    if (F.tid < 64) {
        const int c = (int)cnt_g[F.tid]; const int nt = (c + 255) >> 8;
        int inc = nt;
#pragma unroll
        for (int o = 1; o < 64; o <<= 1) { const int v = __shfl_up(inc, o, 64); if (F.lane >= o) inc += v; }
        const int first = inc - nt;
        cntS[F.tid] = c; rbS[F.tid] = first * 256;
        for (int m = 0; m < nt; ++m) { te[first + m] = (short)F.tid; tm[first + m] = (short)m; }
        if (F.tid == 63) { const int nts = (ntok + 255) >> 8; cntS[NEXP] = ntok; rbS[NEXP] = inc * 256; rbS[NEXP + 1] = (inc + nts) * 256; *(LAS int*)(misc + MS_NT) = inc + nts;
            for (int m = 0; m < nts; ++m) { te[inc + m] = (short)NEXP; tm[inc + m] = (short)m; } }
    }
    __syncthreads();
}
namespace attn {
constexpr int NW = 8, QBLK = 32, KVBLK = 64;
constexpr float THR = 8.f;
constexpr int SHM_V = KVBLK * 128 * 2, SHM_K = KVBLK * 128 * 2;
constexpr int OFF_K = 2 * SHM_V, OFF_WS = 2 * SHM_V + 2 * SHM_K, LDS_ATTN = OFF_WS + NW * 64 * 4;
#define KSWZ128(row, colB) ((row) * 256 + ((colB) ^ (((row) & 7) << 4)))
#define KSWZ64(row, colB)  ((row) * 128 + ((colB) ^ ((((row) >> 1) & 7) << 4)))
#define SBAR() __builtin_amdgcn_sched_barrier(0)
__device__ __forceinline__ int crow(int r, int hi) { return (r & 3) + 8 * (r >> 2) + 4 * hi; }

template <int DQK>
__device__ __forceinline__ void partialSM(f32x16& p0, f32x16& p1, float& m_reg, float& mn, float& alpha) {
    constexpr float SCALE = (DQK == 128) ? 0.088388347648318440f : 0.125f;
    constexpr float C = SCALE * 1.4426950408889634f;
    float pmax = p0[0];
#pragma unroll
    for (int r = 1; r < 16; ++r) pmax = fmaxf(pmax, p0[r]);
#pragma unroll
    for (int r = 0; r < 16; ++r) pmax = fmaxf(pmax, p1[r]);
    { auto rr = __builtin_amdgcn_permlane32_swap(__float_as_uint(pmax), __float_as_uint(pmax), false, false);
      pmax = fmaxf(__uint_as_float(rr[0]), __uint_as_float(rr[1])); }
    if (__builtin_expect(__all(pmax - m_reg <= THR / SCALE), 1)) { mn = m_reg; alpha = 1.f; }
    else { mn = fmaxf(m_reg, pmax); alpha = __builtin_amdgcn_exp2f((m_reg - mn) * C); m_reg = mn; }
    const float mnC = -mn * C;
#pragma unroll
    for (int r = 0; r < 16; ++r) p0[r] = fmaf(p0[r], C, mnC);
#pragma unroll
    for (int r = 0; r < 16; ++r) p1[r] = fmaf(p1[r], C, mnC);
#pragma unroll
    for (int r = 0; r < 16; ++r) p0[r] = __builtin_amdgcn_exp2f(p0[r]);
}
__device__ __forceinline__ void finishSM(f32x16& p0, f32x16& p1, float alpha, float& l_reg, bf16x8& pa0, bf16x8& pa1, bf16x8& pa2, bf16x8& pa3) {
#pragma unroll
    for (int r = 0; r < 16; ++r) p1[r] = __builtin_amdgcn_exp2f(p1[r]);
    float ps = 0;
#pragma unroll
    for (int r = 0; r < 16; ++r) ps += p0[r];
#pragma unroll
    for (int r = 0; r < 16; ++r) ps += p1[r];
    { auto rr = __builtin_amdgcn_permlane32_swap(__float_as_uint(ps), __float_as_uint(ps), false, false);
      ps = __uint_as_float(rr[0]) + __uint_as_float(rr[1]); }
    l_reg = l_reg * alpha + ps;
#define PK4(P, BASE, OUT) do { unsigned a0 = cvt_pk_bf16(P[BASE + 0], P[BASE + 1]), a1 = cvt_pk_bf16(P[BASE + 2], P[BASE + 3]);   \
    unsigned b0 = cvt_pk_bf16(P[BASE + 4], P[BASE + 5]), b1 = cvt_pk_bf16(P[BASE + 6], P[BASE + 7]);                              \
    auto r0 = __builtin_amdgcn_permlane32_swap(a0, b0, false, false); auto r1 = __builtin_amdgcn_permlane32_swap(a1, b1, false, false); \
    u32x4 w = {r0[0], r1[0], r0[1], r1[1]}; OUT = *reinterpret_cast<bf16x8*>(&w); } while (0)
    PK4(p0, 0, pa0); PK4(p0, 8, pa1); PK4(p1, 0, pa2); PK4(p1, 8, pa3);
#undef PK4
}
template <int DQK>
__device__ __forceinline__ void qkt(f32x16& p0, f32x16& p1, const char* Ks, const bf16x8* qr, int r32, int hi) {
    p0 = f32x16{}; p1 = f32x16{};
#pragma unroll
    for (int d0 = 0; d0 < DQK / 16; ++d0) { const int cb = (d0 * 16 + hi * 8) * 2;
        bf16x8 b0, b1;
        if (DQK == 128) { b0 = *reinterpret_cast<const bf16x8*>(Ks + KSWZ128(r32, cb)); b1 = *reinterpret_cast<const bf16x8*>(Ks + KSWZ128(32 + r32, cb)); }
        else            { b0 = *reinterpret_cast<const bf16x8*>(Ks + KSWZ64(r32, cb));  b1 = *reinterpret_cast<const bf16x8*>(Ks + KSWZ64(32 + r32, cb)); }
        p0 = __builtin_amdgcn_mfma_f32_32x32x16_bf16(b0, qr[d0], p0, 0, 0, 0);
        p1 = __builtin_amdgcn_mfma_f32_32x32x16_bf16(b1, qr[d0], p1, 0, 0, 0); }
}
__device__ __forceinline__ int v_st(int k, int c) { const int kk = (k & ~0xC) | ((k & 4) << 1) | ((k & 8) >> 1); return ((kk >> 3) * 4 + (c >> 5)) * 512 + ((kk & 7) * 32 + (c & 31)) * 2; }
__device__ __forceinline__ int v_rd_base(int lane) { return ((lane & 3) << 3) | (((lane >> 2) & 3) << 6) | (((lane >> 4) & 1) << 5) | (((lane >> 5) & 1) << 8); }
constexpr int v_rd_off(int d0, int ks, int half) { return d0 * 512 + ks * 4096 + half * 2048; }
template <int OFF> __device__ __forceinline__ s16x4 tr_read(int vb) {
    s16x4 r; asm volatile("ds_read_b64_tr_b16 %0, %1 offset:%2" : "=&v"(r) : "v"(vb), "i"(OFF) : "memory"); return r;
}
template <int D0> __device__ __forceinline__ void pv_one(f32x16& od, int vb, bf16x8 pa0, bf16x8 pa1, bf16x8 pa2, bf16x8 pa3) {
    const s16x4 l0 = tr_read<v_rd_off(D0, 0, 0)>(vb), h0 = tr_read<v_rd_off(D0, 0, 1)>(vb), l1 = tr_read<v_rd_off(D0, 1, 0)>(vb), h1 = tr_read<v_rd_off(D0, 1, 1)>(vb);
    const s16x4 l2 = tr_read<v_rd_off(D0, 2, 0)>(vb), h2 = tr_read<v_rd_off(D0, 2, 1)>(vb), l3 = tr_read<v_rd_off(D0, 3, 0)>(vb), h3 = tr_read<v_rd_off(D0, 3, 1)>(vb);
    asm volatile("s_waitcnt lgkmcnt(0)" ::: "memory"); SBAR();
#define PK(L, H) (bf16x8){L[0], L[1], L[2], L[3], H[0], H[1], H[2], H[3]}
    od = __builtin_amdgcn_mfma_f32_32x32x16_bf16(pa0, PK(l0, h0), od, 0, 0, 0);
    od = __builtin_amdgcn_mfma_f32_32x32x16_bf16(pa1, PK(l1, h1), od, 0, 0, 0);
    od = __builtin_amdgcn_mfma_f32_32x32x16_bf16(pa2, PK(l2, h2), od, 0, 0, 0);
    od = __builtin_amdgcn_mfma_f32_32x32x16_bf16(pa3, PK(l3, h3), od, 0, 0, 0);
#undef PK
}
__device__ __forceinline__ void pv_d0(f32x16* o, int vb, bf16x8 pa0, bf16x8 pa1, bf16x8 pa2, bf16x8 pa3) {
    pv_one<0>(o[0], vb, pa0, pa1, pa2, pa3); pv_one<1>(o[1], vb, pa0, pa1, pa2, pa3); pv_one<2>(o[2], vb, pa0, pa1, pa2, pa3); pv_one<3>(o[3], vb, pa0, pa1, pa2, pa3);
}

struct OutArgs { unsigned char* mix; float* scr; float lam; float osc; const float* ng; };

struct BgArgs { WConv* c; const Args* a; unsigned char* ws; LAS unsigned char* ldsl; };
template <int DQK, int MODE, int BGL>
__device__ __forceinline__ void body(const bf16_t* __restrict__ Qb, const bf16_t* __restrict__ Kh, const bf16_t* __restrict__ Vh, int seq, char* lds, const OutArgs oa, const BgArgs bg) {
    constexpr int ND = DQK / 16;
    int tz0 = threadIdx.x; asm volatile("" : "+v"(tz0));
    const int tid = tz0, wid = tid >> 6, lane = tid & 63, r32 = lane & 31, hi = lane >> 5;
    __syncthreads();
    char* V_lds = lds; char* K_lds = lds + OFF_K;
    float* ws = (float*)(lds + OFF_WS) + wid * 64; float* li_l = ws; float* al_l = ws + 32;
    float m_reg = -1e30f, l_reg = 0; f32x16 o[4] = {}; bf16x8 qr[ND];
    const bf16_t* Qw = Qb + (size_t)(wid * QBLK + r32) * ZW + hi * 8;
#pragma unroll
    for (int d0 = 0; d0 < ND; ++d0) qr[d0] = *reinterpret_cast<const bf16x8*>(Qw + d0 * 16);
    const int sr = tid >> 4, sc = (tid & 15) * 8, vst0 = v_st(sr, sc), vst1 = v_st(32 + sr, sc);
    const int kr64 = tid >> 3, kc64 = (tid & 7) * 8;
    const int vb0 = (int)(uintptr_t)V_lds + v_rd_base(lane);
#ifndef WC_MODE
#define WC_MODE 0
#endif
    constexpr int SD = (BGL >= 0 && WC_MODE != 1) ? 1 : 2;
    struct { bf16x8 vs0, vs1, ks0, ks1; } sr_[SD];
    const unsigned voffS = (unsigned)(sr * ZW + sc) * 2u, voffK64 = (unsigned)(kr64 * ZW + kc64) * 2u;
    __amdgpu_buffer_rsrc_t rsK, rsV;
    { const uintptr_t pk = (uintptr_t)Kh, pv = (uintptr_t)Vh;
      const unsigned kl = __builtin_amdgcn_readfirstlane((unsigned)pk), kh = __builtin_amdgcn_readfirstlane((unsigned)(pk >> 32));
      const unsigned vl = __builtin_amdgcn_readfirstlane((unsigned)pv), vh = __builtin_amdgcn_readfirstlane((unsigned)(pv >> 32));
      rsK = __builtin_amdgcn_make_buffer_rsrc((void*)(((uintptr_t)kh << 32) | kl), 0, NTOK * ZW * 2, 0x00020000);
      rsV = __builtin_amdgcn_make_buffer_rsrc((void*)(((uintptr_t)vh << 32) | vl), 0, NTOK * ZW * 2, 0x00020000); }
#define BLD(rs, vo, so) ({ u32x4 t_ = __builtin_amdgcn_raw_buffer_load_b128(rs, vo, so, 0); *reinterpret_cast<bf16x8*>(&t_); })
#define SLOAD(i, k0) do { const int so_ = (k0) * (ZW * 2); \
    sr_[i].vs0 = BLD(rsV, voffS, so_); sr_[i].vs1 = BLD(rsV, voffS, so_ + 32 * ZW * 2); \
    if (DQK == 128) { sr_[i].ks0 = BLD(rsK, voffS, so_); sr_[i].ks1 = BLD(rsK, voffS, so_ + 32 * ZW * 2); } \
    else { sr_[i].ks0 = BLD(rsK, voffK64, so_); } } while (0)
#define SWRITE(b, i) do { *(bf16x8*)(V_lds + (b) * SHM_V + vst0) = sr_[i].vs0; *(bf16x8*)(V_lds + (b) * SHM_V + vst1) = sr_[i].vs1; \
    if (DQK == 128) { const int kc = sc * 2; *(bf16x8*)(K_lds + (b) * SHM_K + KSWZ128(sr, kc)) = sr_[i].ks0; *(bf16x8*)(K_lds + (b) * SHM_K + KSWZ128(32 + sr, kc)) = sr_[i].ks1; } \
    else { *(bf16x8*)(K_lds + (b) * SHM_K + KSWZ64(kr64, kc64 * 2)) = sr_[i].ks0; } } while (0)
#define SWAIT() do { if (SD == 2) { if (DQK == 128) asm volatile("s_waitcnt vmcnt(4)" ::: "memory"); else asm volatile("s_waitcnt vmcnt(3)" ::: "memory"); } \
    else if (BGL >= 0 && WC_MODE == 0) asm volatile("s_waitcnt vmcnt(2)" ::: "memory"); else asm volatile("s_waitcnt vmcnt(0)" ::: "memory"); } while (0)
#define BGSTEP(X) do { } while (0)
#define RESC(a) do { if (__any((a) < 1.f)) { if (hi == 0) al_l[r32] = (a); asm volatile("s_waitcnt lgkmcnt(0)" ::: "memory"); \
    _Pragma("unroll") for (int d = 0; d < 4; ++d) _Pragma("unroll") for (int r = 0; r < 16; ++r) o[d][r] *= al_l[crow(r, hi)]; } } while (0)
    f32x16 pA0, pA1, pB0, pB1; float mnA, mnB, alA, alB; bf16x8 pa0, pa1, pa2, pa3; const int NT = seq / KVBLK;
    constexpr int SE = 0, SO = SD - 1;
    SLOAD(SE, 0); asm volatile("s_waitcnt vmcnt(0)" ::: "memory"); SWRITE(0, SE); __syncthreads();
    qkt<DQK>(pA0, pA1, K_lds, qr, r32, hi); partialSM<DQK>(pA0, pA1, m_reg, mnA, alA);
    SLOAD(SO, KVBLK); if (SD == 2) { if (2 < NT) SLOAD(SE, 2 * KVBLK); }
    SWAIT(); SWRITE(1, SO); __syncthreads();
    for (int j = 1; j + 1 < NT; j += 2) {
        SBAR(); qkt<DQK>(pB0, pB1, K_lds + SHM_K, qr, r32, hi);
        finishSM(pA0, pA1, alA, l_reg, pa0, pa1, pa2, pa3); SBAR();
        SLOAD(SO, (j + SD) * KVBLK); BGSTEP(0); SBAR();
        pv_d0(o, vb0, pa0, pa1, pa2, pa3); partialSM<DQK>(pB0, pB1, m_reg, mnB, alB);
        __syncthreads(); SWAIT(); SWRITE(0, SE);
        RESC(alB); __syncthreads();
        SBAR(); qkt<DQK>(pA0, pA1, K_lds, qr, r32, hi);
        finishSM(pB0, pB1, alB, l_reg, pa0, pa1, pa2, pa3); SBAR();
        if (SD == 1 || j + 3 < NT) SLOAD(SE, (j + 1 + SD) * KVBLK); BGSTEP(1); SBAR();
        pv_d0(o, vb0 + SHM_V, pa0, pa1, pa2, pa3); partialSM<DQK>(pA0, pA1, m_reg, mnA, alA);
        __syncthreads(); SWAIT(); SWRITE(1, SO);
        RESC(alA); __syncthreads();
    }
    SBAR(); qkt<DQK>(pB0, pB1, K_lds + SHM_K, qr, r32, hi);
    finishSM(pA0, pA1, alA, l_reg, pa0, pa1, pa2, pa3); SBAR();
    pv_d0(o, vb0, pa0, pa1, pa2, pa3); partialSM<DQK>(pB0, pB1, m_reg, mnB, alB);
    __syncthreads(); RESC(alB);
    finishSM(pB0, pB1, alB, l_reg, pa0, pa1, pa2, pa3); SBAR();
    pv_d0(o, vb0 + SHM_V, pa0, pa1, pa2, pa3);
    if (hi == 0) li_l[r32] = l_reg; asm volatile("s_waitcnt lgkmcnt(0)" ::: "memory");
    float rli[16];
#pragma unroll
    for (int r = 0; r < 16; ++r) rli[r] = __builtin_amdgcn_rcpf(li_l[crow(r, hi)]);
    int tz = threadIdx.x; asm volatile("" : "+v"(tz));
    const int tid_e = tz, wid_e = tz >> 6, r32_e = tz & 31, hi_e = (tz >> 5) & 1;
#define tid tid_e
#define wid wid_e
#define r32 r32_e
#define hi hi_e
    if (MODE == 0) {
        unsigned char* Ow = oa.mix + (size_t)(wid * QBLK) * DM;
#pragma unroll
        for (int r = 0; r < 16; ++r) { const int orow = crow(r, hi);
#pragma unroll
            for (int d0 = 0; d0 < 4; ++d0) Ow[(size_t)orow * DM + d0 * 32 + r32] = f2fp8_x16(o[d0][r] * rli[r]); }
    } else if (MODE == 1) {
#pragma unroll
        for (int r = 0; r < 16; ++r)
#pragma unroll
            for (int d0 = 0; d0 < 4; ++d0) oa.scr[(r * 4 + d0) * 512 + tid] = o[d0][r] * rli[r];
    } else {
        unsigned char* Ow = oa.mix + (size_t)(wid * QBLK) * DM;
        float gn[4];
#pragma unroll
        for (int d0 = 0; d0 < 4; ++d0) gn[d0] = oa.ng[d0 * 32 + r32] * oa.osc;
#pragma unroll
        for (int r = 0; r < 16; ++r) { const int orow = crow(r, hi); float v[4]; float ss = 0.f;
#pragma unroll
            for (int d0 = 0; d0 < 4; ++d0) { v[d0] = oa.scr[(r * 4 + d0) * 512 + tid] - oa.lam * (o[d0][r] * rli[r]); ss += v[d0] * v[d0]; }
#pragma unroll
            for (int s = 16; s >= 1; s >>= 1) ss += __shfl_xor(ss, s, 64);
            const float rs = rsqrtf(ss * (1.f / 128.f) + NORM_EPS);
#pragma unroll
            for (int d0 = 0; d0 < 4; ++d0) Ow[(size_t)orow * DM + d0 * 32 + r32] = f2fp8_x16(v[d0] * rs * gn[d0]); }
    }
#undef tid
#undef wid
#undef r32
#undef hi
    asm volatile("s_waitcnt vmcnt(0) lgkmcnt(0)" ::: "memory");
    __syncthreads();
#undef SLOAD
#undef BGSTEP
#undef BLD
#undef SWRITE
#undef SWAIT
#undef RESC
}
}
__device__ __forceinline__ void mod_gemv(const Frame& F_, const float* c, const float* cctx, const float* wmod, const float* bmod, float* mod) {
    LOCAL_FRAME(F, F_);
    LAS float* sx = (LAS float*)F.lds;
    LAS float* sc = sx + DM;
    LAS float* red = sc + DM;
    __syncthreads();
    for (int i = F.tid; i < DM; i += NTHREADS) { const float a = c[i], b = cctx[i]; sx[i] = a / (1.f + expf(-a)); sc[i] = b / (1.f + expf(-b)); }
    __syncthreads();
    for (int item = F.bid; item < 256; item += F.G) {
        const int l = item >> 7, col0 = (item & 127) * 96;
        const float* W = wmod + (size_t)l * DM * (6 * DM) + col0;
        const int c4 = F.tid % 24, rg = F.tid / 24;
        if (rg < 21) {
            f32x4 ax = {0.f, 0.f, 0.f, 0.f}, ac = {0.f, 0.f, 0.f, 0.f};
            for (int d0 = rg; d0 < DM; d0 += 21 * 7) {
                f32x4 w[7];
#pragma unroll
                for (int u = 0; u < 7; ++u) { const int d = d0 + 21 * u; w[u] = (d < DM) ? *(const f32x4*)(W + (size_t)d * (6 * DM) + c4 * 4) : (f32x4){0.f, 0.f, 0.f, 0.f}; }
#pragma unroll
                for (int u = 0; u < 7; ++u) { const int d = d0 + 21 * u; if (d < DM) { ax += sx[d] * w[u]; ac += sc[d] * w[u]; } }
            }
#pragma unroll
            for (int j = 0; j < 4; ++j) { red[(rg * 2 + 0) * 96 + c4 * 4 + j] = ac[j]; red[(rg * 2 + 1) * 96 + c4 * 4 + j] = ax[j]; }
        }
        __syncthreads();
        if (F.tid < 192) { const int w = F.tid / 96, col = F.tid % 96; float s = 0.f;
            for (int r = 0; r < 21; ++r) s += red[(r * 2 + w) * 96 + col];
            mod[((size_t)l * 2 + w) * (6 * DM) + col0 + col] = s + bmod[(size_t)l * 6 * DM + col0 + col]; }
        __syncthreads();
    }
}
__device__ __forceinline__ void small_tables(const Frame& F_, float* rope, const float* rw, float* rwT) {
    LOCAL_FRAME(F, F_);
    for (int i = F.bid * NTHREADS + F.tid; i < 128 * 32 + 128 * 16; i += F.G * NTHREADS) {
        if (i < 128 * 32) { const int pos = i >> 5, j = i & 31; const float inv = powf(10000.f, -(float)j / 32.f); const float a = (float)pos * inv; rope[i] = cosf(a); rope[128 * 32 + i] = sinf(a); }
        else { const int k = i - 128 * 32, pos = k >> 4, j = k & 15; const float inv = powf(10000.f, -(float)j / 16.f); const float a = (float)pos * inv; rope[2 * 128 * 32 + k] = cosf(a); rope[2 * 128 * 32 + 128 * 16 + k] = sinf(a); }
    }
    bf16_t* rh = (bf16_t*)rwT;
    for (int i = F.bid * NTHREADS + F.tid; i < 2 * DM * NEXP; i += F.G * NTHREADS) { const int l = i / (DM * NEXP), r = i % (DM * NEXP), d = r / NEXP, e = r % NEXP;
        const float w = rw[i]; const bf16_t hi = f2bf(w); rh[((size_t)(l * 2 + 0) * NEXP + e) * DM + d] = hi; rh[((size_t)(l * 2 + 1) * NEXP + e) * DM + d] = f2bf(w - bf2f(hi)); }
}
struct CvtTile { const float* src0; const float* src1; unsigned char* dst; int ld, dstrb  ; float scale; int ilv, f8; };
__device__ __forceinline__ void cvt_decode(int idx, const Args& a, unsigned char* ws, CvtTile& t) {
    constexpr int N_IN = 76 * 16, N_OUT = 32 * 16, N_GU = 65 * 16 * 16, N_DN = 65 * 32 * 4, PER_L = N_IN + N_OUT;
    const int l = idx / PER_L; int r = idx % PER_L;
    t.scale = 1.f; t.ilv = 0; t.f8 = 0;
    if (r < N_IN) { const int nt = r / 16, kt = r % 16; const float* W = a.in[I_WIN] + (size_t)l * DM * IN_W + (size_t)kt * 128 * IN_W;
        t.ld = IN_W; t.dstrb = DM * 2; t.dst = ws + WS_BTIN + (((size_t)l * ZW + nt * 64) * DM + kt * 128) * 2;
        if (nt < 24) { t.src0 = W + nt * 64; t.src1 = t.src0 + 32; if (nt < 4) t.scale = 0.125f; }
        else if (nt < 72) { t.src0 = W + nt * 64 + 32; t.src1 = t.src0 + 32; }
        else if (nt == 72) { t.src0 = W + 1536; t.src1 = nullptr; }
        else { t.src0 = nullptr; t.src1 = nullptr; }
        return; }
    r -= N_IN;
    if (r < N_OUT) { const int nt = r / 16, kt = r % 16; const float* W = a.in[I_WOUT] + (size_t)l * DM * DM + (size_t)kt * 128 * DM;
        t.ld = DM; t.dstrb = DM; t.f8 = 1; t.scale = 64.f; t.dst = ws + WS_BTOUT + ((size_t)l * DM + nt * 64) * DM + kt * 128; t.src0 = W + nt * 64; t.src1 = t.src0 + 32; return; }
    r -= N_OUT;
    if (r < N_GU) { const int e = r / 256, q = r % 256, nt = q / 16, kt = q % 16;
        const float* Wg = (e < NEXP) ? a.in[I_EWG] + ((size_t)l * NEXP + e) * DM * EH : a.in[I_SWG] + (size_t)l * DM * EH;
        const float* Wu = (e < NEXP) ? a.in[I_EWU] + ((size_t)l * NEXP + e) * DM * EH : a.in[I_SWU] + (size_t)l * DM * EH;
        t.ld = EH; t.dstrb = DM; t.ilv = 1; t.f8 = 1; t.scale = 64.f; t.dst = ws + WS_BTGU + (((size_t)l * 65 + e) * 1024 + nt * 64) * DM + kt * 128;
        t.src0 = Wg + (size_t)kt * 128 * EH + nt * 32; t.src1 = Wu + (size_t)kt * 128 * EH + nt * 32; return; }
    r -= N_GU;
    { const int e = r / 128, q = r % 128, nt = q / 4, kt = q % 4;
        const float* Wd = (e < NEXP) ? a.in[I_EWD] + ((size_t)l * NEXP + e) * EH * DM : a.in[I_SWD] + (size_t)l * EH * DM;
        t.ld = DM; t.dstrb = EH; t.f8 = 1; t.scale = 32.f; t.dst = ws + WS_BTD + (((size_t)l * 65 + e) * DM + nt * 64) * EH + kt * 128;
        t.src0 = Wd + (size_t)kt * 128 * DM + nt * 64; t.src1 = t.src0 + 32; }
}
constexpr int CVT_ITEMS = 2 * (76 * 16 + 32 * 16);
__device__ __forceinline__ void convert_weights(const Frame& F_, const Args& a) {
    LOCAL_FRAME(F, F_);
    constexpr int TSB = 272;
    LAS unsigned char* tile = F.lds;
    const int kq = F.tid >> 4, s4 = (F.tid & 15) * 4;
    const int rs = F.tid >> 3, rk = (F.tid & 7) * 16;
    f32x4 v[2][4]; CvtTile t[2];
    __syncthreads();
    int it = F.bid, par = 0;
#define CV_LOAD(p, T) do { const float* s_ = (s4 < 32) ? (T).src0 : (T).src1; const int so_ = (s4 < 32) ? s4 : s4 - 32; \
        _Pragma("unroll") for (int i = 0; i < 4; ++i) v[p][i] = s_ ? __builtin_nontemporal_load((const f32x4*)(s_ + (size_t)(4 * kq + i) * (T).ld + so_)) : (f32x4){0.f, 0.f, 0.f, 0.f}; } while (0)
    if (it < CVT_ITEMS) { cvt_decode(it, a, F.ws, t[0]); CV_LOAD(0, t[0]); }
    while (it < CVT_ITEMS) {
        const int nx = it + F.G;
        if (par == 0) { if (nx < CVT_ITEMS) { cvt_decode(nx, a, F.ws, t[1]); CV_LOAD(1, t[1]); } }
        else          { if (nx < CVT_ITEMS) { cvt_decode(nx, a, F.ws, t[0]); CV_LOAD(0, t[0]); } }
        LAS unsigned char* tb = tile + par * 64 * TSB;
#define CV_PROC(p) do { const float sc_ = t[p].scale; \
        const int drow_ = t[p].ilv ? ((rs < 32) ? (8 * (rs >> 2) + (rs & 3)) : (8 * ((rs - 32) >> 2) + 4 + (rs & 3))) : rs; \
        if (t[p].f8) { _Pragma("unroll") for (int j = 0; j < 4; ++j) *(LAS unsigned*)(tb + (s4 + j) * TSB + 4 * kq) = cvt4_fp8(v[p][0][j] * sc_, v[p][1][j] * sc_, v[p][2][j] * sc_, v[p][3][j] * sc_); \
            __syncthreads(); \
            *(u32x4*)(t[p].dst + (size_t)drow_ * t[p].dstrb + rk) = *(const LAS u32x4*)(tb + rs * TSB + rk); } \
        else { _Pragma("unroll") for (int j = 0; j < 4; ++j) { u32x2 w_; w_.x = cvt_pk_bf16(v[p][0][j] * sc_, v[p][1][j] * sc_); w_.y = cvt_pk_bf16(v[p][2][j] * sc_, v[p][3][j] * sc_); *(LAS u32x2*)(tb + (s4 + j) * TSB + 8 * kq) = w_; } \
            __syncthreads(); \
            const u32x4 w0_ = *(const LAS u32x4*)(tb + rs * TSB + rk * 2), w1_ = *(const LAS u32x4*)(tb + rs * TSB + rk * 2 + 16); \
            u32x4* dp_ = (u32x4*)(t[p].dst + (size_t)drow_ * t[p].dstrb + rk * 2); dp_[0] = w0_; dp_[1] = w1_; } } while (0)
        if (par == 0) CV_PROC(0); else CV_PROC(1);
        it = nx; par ^= 1;
    }
    __syncthreads();
#undef CV_LOAD
#undef CV_PROC
}

__device__ __forceinline__ void norm_mod_row(const float* xr, bf16_t* xcopy, const float* g, const float* sh, const float* sc, bf16_t* out, int lane) {
    f32x4 v[8]; float ss = 0.f;
#pragma unroll
    for (int k = 0; k < 8; ++k) { v[k] = *(const f32x4*)(xr + k * 256 + lane * 4); ss += v[k][0] * v[k][0] + v[k][1] * v[k][1] + v[k][2] * v[k][2] + v[k][3] * v[k][3]; }
    ss = wave_sum(ss);
    const float rs = rsqrtf(ss * (1.f / DM) + NORM_EPS);
#pragma unroll
    for (int k = 0; k < 8; ++k) { const int i = k * 256 + lane * 4;
        const f32x4 gg = *(const f32x4*)(g + i), s0 = *(const f32x4*)(sh + i), s1 = *(const f32x4*)(sc + i);
        const f32x4 y = v[k] * rs * gg * (s1 + 1.f) + s0;
        u32x2 w; w.x = cvt_pk_bf16(y[0], y[1]); w.y = cvt_pk_bf16(y[2], y[3]);
        *(u32x2*)(out + i) = w;
        if (xcopy) { u32x2 xw; xw.x = cvt_pk_bf16(v[k][0], v[k][1]); xw.y = cvt_pk_bf16(v[k][2], v[k][3]); *(u32x2*)(xcopy + i) = xw; } }
}
__device__ __forceinline__ void phase_norm1(const Frame& F_, const Args& a) {
    LOCAL_FRAME(F, F_);
    bf16_t* X = (bf16_t*)(F.ws + WS_X); bf16_t* A = (bf16_t*)(F.ws + WS_A); const float* mod = (const float*)(F.ws + WS_MOD);
    const int lane = F.lane, stride = F.G * 8;
    f32x4 v[8], vn[8];
    int r = F.bid * 8 + F.wave;
#define N1_SRC(r_) (((r_) < NCTX) ? a.in[I_CTX] + (size_t)(r_) * DM : a.in[I_X] + (size_t)((r_) - NCTX) * DM)
    if (r < NTOK) { const float* src = N1_SRC(r);
#pragma unroll
        for (int k = 0; k < 8; ++k) v[k] = *(const f32x4*)(src + k * 256 + lane * 4); }
    while (r < NTOK) {
        const int rn = r + stride;
        if (rn < NTOK) { const float* src = N1_SRC(rn);
#pragma unroll
            for (int k = 0; k < 8; ++k) vn[k] = *(const f32x4*)(src + k * 256 + lane * 4); }
        const float* m = mod + (size_t)(r < NCTX ? 0 : 1) * 6 * DM; const float* g = a.in[I_N1G];
        float ss = 0.f;
#pragma unroll
        for (int k = 0; k < 8; ++k) ss += v[k][0] * v[k][0] + v[k][1] * v[k][1] + v[k][2] * v[k][2] + v[k][3] * v[k][3];
        ss = wave_sum(ss);
        const float rs = rsqrtf(ss * (1.f / DM) + NORM_EPS);
#pragma unroll
        for (int k = 0; k < 8; ++k) { const int i = k * 256 + lane * 4;
            const f32x4 gg = *(const f32x4*)(g + i), s0 = *(const f32x4*)(m + i), s1 = *(const f32x4*)(m + DM + i);
            const f32x4 y = v[k] * rs * gg * (s1 + 1.f) + s0;
            u32x2 w; w.x = cvt_pk_bf16(y[0], y[1]); w.y = cvt_pk_bf16(y[2], y[3]);
            *(u32x2*)(A + (size_t)r * DM + i) = w;
            u32x2 xw; xw.x = cvt_pk_bf16(v[k][0], v[k][1]); xw.y = cvt_pk_bf16(v[k][2], v[k][3]); *(u32x2*)(X + (size_t)r * DM + i) = xw; }
#pragma unroll
        for (int k = 0; k < 8; ++k) v[k] = vn[k];
        r = rn;
    }
#undef N1_SRC
}

__device__ __forceinline__ void qk_prep(const Frame& F_, const Args& a, int l, int dummy, int qb, int qG) {
    LOCAL_FRAME(F, F_);
    const bf16_t* Z = (const bf16_t*)(F.ws + WS_Z); bf16_t* Zo = (bf16_t*)(F.ws + (dummy ? WS_DUMMY : 0) + WS_Z);
    const float* rope = (const float*)(F.ws + WS_ROPE);
    const float* cg = rope; const float* sg = rope + 128 * 32; const float* cd = rope + 2 * 128 * 32; const float* sd = cd + 128 * 16;
    const float* qng = a.in[I_QNG] + l * 128; const float* kng = a.in[I_KNG] + l * 128;
#define QK_UNPACK(W_, X_) do { X_[0] = bflo(W_[0]); X_[1] = bfhi(W_[0]); X_[2] = bflo(W_[1]); X_[3] = bfhi(W_[1]); X_[4] = bflo(W_[2]); X_[5] = bfhi(W_[2]); X_[6] = bflo(W_[3]); X_[7] = bfhi(W_[3]); } while (0)
    { const int sub = F.tid & 7, half = sub >> 2, j0 = (sub & 3) * 8;
      for (int g0 = qb * 64; g0 < NTOK * 10; g0 += qG * 64) {
        const int g = g0 + (F.tid >> 3);
        if (g < NTOK * 10) {
            const int t = g / 10, hv = g - t * 10; const int col = ((hv < 8) ? ZC_AQ + hv * 128 : ZC_AK + (hv - 8) * 128) + half * 64 + j0;
            const float* gn = ((hv < 8) ? qng : kng) + half * 64 + j0;
            const u32x4 w1 = *(const u32x4*)(Z + (size_t)t * ZW + col), w2 = *(const u32x4*)(Z + (size_t)t * ZW + col + 32);
            const f32x4 ga = *(const f32x4*)gn, gb = *(const f32x4*)(gn + 4), gc = *(const f32x4*)(gn + 32), gd = *(const f32x4*)(gn + 36);
            const bool lat = t >= NCTX; const int p = t - NCTX, pos = lat ? (half == 0 ? (p >> 6) : (p & 63)) : 0;
            const f32x4 ca = *(const f32x4*)(cg + pos * 32 + j0), cb = *(const f32x4*)(cg + pos * 32 + j0 + 4), sa = *(const f32x4*)(sg + pos * 32 + j0), sb = *(const f32x4*)(sg + pos * 32 + j0 + 4);
            float x1[8], x2[8]; QK_UNPACK(w1, x1); QK_UNPACK(w2, x2);
            float ss = 0.f;
#pragma unroll
            for (int i = 0; i < 8; ++i) ss += x1[i] * x1[i] + x2[i] * x2[i];
            ss += __shfl_xor(ss, 1, 64); ss += __shfl_xor(ss, 2, 64); ss += __shfl_xor(ss, 4, 64);
            const float rs = rsqrtf(ss * (1.f / 128.f) + NORM_EPS);
            float o1[8], o2[8];
#pragma unroll
            for (int i = 0; i < 8; ++i) { const float g1 = (i < 4) ? ga[i & 3] : gb[i & 3], g2 = (i < 4) ? gc[i & 3] : gd[i & 3];
                const float cs = lat ? ((i < 4) ? ca[i & 3] : cb[i & 3]) : 1.f, sn = lat ? ((i < 4) ? sa[i & 3] : sb[i & 3]) : 0.f;
                const float y1 = x1[i] * rs * g1, y2 = x2[i] * rs * g2; o1[i] = y1 * cs - y2 * sn; o2[i] = y2 * cs + y1 * sn; }
            u32x4 r1, r2; r1.x = cvt_pk_bf16(o1[0], o1[1]); r1.y = cvt_pk_bf16(o1[2], o1[3]); r1.z = cvt_pk_bf16(o1[4], o1[5]); r1.w = cvt_pk_bf16(o1[6], o1[7]);
            r2.x = cvt_pk_bf16(o2[0], o2[1]); r2.y = cvt_pk_bf16(o2[2], o2[3]); r2.z = cvt_pk_bf16(o2[4], o2[5]); r2.w = cvt_pk_bf16(o2[6], o2[7]);
            *(u32x4*)(Zo + (size_t)t * ZW + col) = r1; *(u32x4*)(Zo + (size_t)t * ZW + col + 32) = r2;
        } } }
    { const int sub = F.tid & 3, half = sub >> 1, j0 = (sub & 1) * 8;
      for (int g0 = qb * 128; g0 < (NTOK - NCTX) * 16; g0 += qG * 128) {
        const int g = g0 + (F.tid >> 2);
        if (g < (NTOK - NCTX) * 16) {
            const int p = g >> 4, vi = g & 15, t = p + NCTX; const int col = ((vi < 8) ? ZC_DQ + vi * 64 : ZC_DK + (vi - 8) * 64) + half * 32 + j0;
            const u32x4 w1 = *(const u32x4*)(Z + (size_t)t * ZW + col), w2 = *(const u32x4*)(Z + (size_t)t * ZW + col + 16);
            const int pos = half == 0 ? (p >> 6) : (p & 63);
            const f32x4 ca = *(const f32x4*)(cd + pos * 16 + j0), cb = *(const f32x4*)(cd + pos * 16 + j0 + 4), sa = *(const f32x4*)(sd + pos * 16 + j0), sb = *(const f32x4*)(sd + pos * 16 + j0 + 4);
            float x1[8], x2[8]; QK_UNPACK(w1, x1); QK_UNPACK(w2, x2);
            float o1[8], o2[8];
#pragma unroll
            for (int i = 0; i < 8; ++i) { const float cs = (i < 4) ? ca[i & 3] : cb[i & 3], sn = (i < 4) ? sa[i & 3] : sb[i & 3]; o1[i] = x1[i] * cs - x2[i] * sn; o2[i] = x2[i] * cs + x1[i] * sn; }
            u32x4 r1, r2; r1.x = cvt_pk_bf16(o1[0], o1[1]); r1.y = cvt_pk_bf16(o1[2], o1[3]); r1.z = cvt_pk_bf16(o1[4], o1[5]); r1.w = cvt_pk_bf16(o1[6], o1[7]);
            r2.x = cvt_pk_bf16(o2[0], o2[1]); r2.y = cvt_pk_bf16(o2[2], o2[3]); r2.z = cvt_pk_bf16(o2[4], o2[5]); r2.w = cvt_pk_bf16(o2[6], o2[7]);
            *(u32x4*)(Zo + (size_t)t * ZW + col) = r1; *(u32x4*)(Zo + (size_t)t * ZW + col + 16) = r2;
        } } }
#undef QK_UNPACK
}

__device__ __forceinline__ void gla_prep_unit(const Frame& F, const Args& a, int l, int n, int h) {
    const bf16_t* Z = (const bf16_t*)(F.ws + WS_Z); bf16_t* GQK = (bf16_t*)(F.ws + WS_GQK); bf16_t* GVT = (bf16_t*)(F.ws + WS_GVT);
    float* GU = (float*)(F.ws + WS_GU); float* GG = (float*)(F.ws + WS_GG);
    LAS unsigned char* L = F.lds;
    LAS float* zz = (LAS float*)L;
    LAS float* waf = (LAS float*)(L + 8192);
    LAS float* wab = (LAS float*)(L + 12288);
    LAS float* baf = (LAS float*)(L + 16384);
    LAS float* bab = (LAS float*)(L + 16640);
    LAS float* LF = (LAS float*)(L + 17408);
    LAS float* LB = (LAS float*)(L + 34304);
    LAS float* segF = (LAS float*)(L + 51200);
    LAS float* segB = (LAS float*)(L + 53248);
    LAS bf16_t* keTf = (LAS bf16_t*)(L + 55296);
    LAS bf16_t* keTb = (LAS bf16_t*)(L + 64512);
    LAS bf16_t* vT = (LAS bf16_t*)(L + 73728);
    int tz0 = threadIdx.x; asm volatile("" : "+v"(tz0));
    const int tid = tz0, tok0 = n * 64;
    __syncthreads();
    if (tid < 256) { const int c = tid >> 2, p8 = (tid & 3) * 8; const u32x4 w = *(const u32x4*)(Z + (size_t)(tok0 + c) * ZW + ZC_DEC + p8);
        LAS float* d = zz + c * 32 + p8; d[0] = bflo(w.x); d[1] = bfhi(w.x); d[2] = bflo(w.y); d[3] = bfhi(w.y); d[4] = bflo(w.z); d[5] = bfhi(w.z); d[6] = bflo(w.w); d[7] = bfhi(w.w); }
    for (int i = tid; i < 1024; i += NTHREADS) { const int r = i >> 6, d = i & 63; waf[i] = a.in[I_WAF][((size_t)l * 16 + r) * 256 + h * 64 + d]; wab[i] = a.in[I_WAB][((size_t)l * 16 + r) * 256 + h * 64 + d]; }
    if (tid < 64) { baf[tid] = a.in[I_BAF][l * 256 + h * 64 + tid]; bab[tid] = a.in[I_BAB][l * 256 + h * 64 + tid]; }
    __syncthreads();
    const int c = tid >> 3, d8 = (tid & 7) * 8;
    { float af[8], ab[8];
#pragma unroll
      for (int e = 0; e < 8; ++e) { af[e] = baf[d8 + e]; ab[e] = bab[d8 + e]; }
#pragma unroll
      for (int r = 0; r < 16; ++r) { const float zf = zz[c * 32 + r], zb = zz[c * 32 + 16 + r];
#pragma unroll
          for (int e = 0; e < 8; ++e) { af[e] += zf * waf[r * 64 + d8 + e]; ab[e] += zb * wab[r * 64 + d8 + e]; } }
#pragma unroll
      for (int e = 0; e < 8; ++e) { LF[c * 65 + d8 + e] = logsigmoid_f(af[e]) * (1.f / 16.f); LB[c * 65 + d8 + e] = logsigmoid_f(ab[e]) * (1.f / 16.f); } }
    __syncthreads();
    { const int d = tid & 63, seg = tid >> 6; float run = 0.f;
#pragma unroll
      for (int i = 0; i < 8; ++i) { run += LF[(8 * seg + i) * 65 + d]; LF[(8 * seg + i) * 65 + d] = run; }
      segF[seg * 64 + d] = run; run = 0.f;
#pragma unroll
      for (int i = 7; i >= 0; --i) { run += LB[(8 * seg + i) * 65 + d]; LB[(8 * seg + i) * 65 + d] = run; }
      segB[seg * 64 + d] = run; }
    __syncthreads();
    { const int d = tid & 63, seg = tid >> 6; float of = 0.f, ob = 0.f;
      for (int s = 0; s < 8; ++s) { if (s < seg) of += segF[s * 64 + d]; if (s > seg) ob += segB[s * 64 + d]; }
#pragma unroll
      for (int i = 0; i < 8; ++i) { LF[(8 * seg + i) * 65 + d] += of; LB[(8 * seg + i) * 65 + d] += ob; } }
    __syncthreads();
    { const size_t zrow = (size_t)(tok0 + c) * ZW;
      const u32x4 qw = *(const u32x4*)(Z + zrow + ZC_GQ + h * 64 + d8), kw = *(const u32x4*)(Z + zrow + ZC_GK + h * 64 + d8);
      float q[8] = {bflo(qw.x), bfhi(qw.x), bflo(qw.y), bfhi(qw.y), bflo(qw.z), bfhi(qw.z), bflo(qw.w), bfhi(qw.w)};
      float k[8] = {bflo(kw.x), bfhi(kw.x), bflo(kw.y), bfhi(kw.y), bflo(kw.z), bfhi(kw.z), bflo(kw.w), bfhi(kw.w)};
      float qdf[8], kif[8], qdb[8], kib[8];
#pragma unroll
      for (int e = 0; e < 8; ++e) { const float cf = LF[c * 65 + d8 + e], cb = LB[c * 65 + d8 + e];
          qdf[e] = q[e] * __expf(cf); kif[e] = k[e] * __expf(-cf); qdb[e] = q[e] * __expf(cb); kib[e] = k[e] * __expf(-cb);
          keTf[(d8 + e) * 72 + c] = f2bf(k[e] * __expf(LF[63 * 65 + d8 + e] - cf)); keTb[(d8 + e) * 72 + c] = f2bf(k[e] * __expf(LB[d8 + e] - cb)); }
      bf16_t* go = GQK + (size_t)(tok0 + c) * 1024 + h * 64 + d8;
#define PK8(x) (u32x4){cvt_pk_bf16(x[0], x[1]), cvt_pk_bf16(x[2], x[3]), cvt_pk_bf16(x[4], x[5]), cvt_pk_bf16(x[6], x[7])}
      *(u32x4*)(go) = PK8(qdf); *(u32x4*)(go + 256) = PK8(kif); *(u32x4*)(go + 512) = PK8(qdb); *(u32x4*)(go + 768) = PK8(kib);
#undef PK8
#pragma unroll
      for (int i = 0; i < 2; ++i) { const int p = tid + NTHREADS * i, cc = p >> 4, v8 = (p & 15) * 8; const u32x4 w = *(const u32x4*)(Z + (size_t)(tok0 + cc) * ZW + ZC_GV + h * 128 + v8);
          vT[(v8 + 0) * 72 + cc] = (bf16_t)(w.x & 0xffff); vT[(v8 + 1) * 72 + cc] = (bf16_t)(w.x >> 16); vT[(v8 + 2) * 72 + cc] = (bf16_t)(w.y & 0xffff); vT[(v8 + 3) * 72 + cc] = (bf16_t)(w.y >> 16);
          vT[(v8 + 4) * 72 + cc] = (bf16_t)(w.z & 0xffff); vT[(v8 + 5) * 72 + cc] = (bf16_t)(w.z >> 16); vT[(v8 + 6) * 72 + cc] = (bf16_t)(w.w & 0xffff); vT[(v8 + 7) * 72 + cc] = (bf16_t)(w.w >> 16); }
      if (tid < 64) GG[((size_t)(n * 4 + h) * 2 + 0) * 64 + tid] = __expf(LF[63 * 65 + tid]);
      else if (tid < 128) GG[((size_t)(n * 4 + h) * 2 + 1) * 64 + tid - 64] = __expf(LB[tid - 64]); }
    __syncthreads();
    { const int v = tid >> 2, c16 = (tid & 3) * 16; const u32x4 w0 = *(const LAS u32x4*)(vT + v * 72 + c16), w1 = *(const LAS u32x4*)(vT + v * 72 + c16 + 8);
      u32x4* dp = (u32x4*)(GVT + ((size_t)(n * 4 + h) * 128 + v) * 64 + c16); dp[0] = w0; dp[1] = w1; }
    { const int w = tid >> 6, vb = w >> 1, db = w & 1, r32 = tid & 31, hi = (tid >> 5) & 1;
#pragma unroll
      for (int dir = 0; dir < 2; ++dir) { LAS bf16_t* keT = dir ? keTb : keTf; f32x16 acc = {};
#pragma unroll
          for (int ks = 0; ks < 4; ++ks) { const bf16x8 A = *(const LAS bf16x8*)(vT + (vb * 32 + r32) * 72 + 16 * ks + 8 * hi), B = *(const LAS bf16x8*)(keT + (db * 32 + r32) * 72 + 16 * ks + 8 * hi);
              acc = __builtin_amdgcn_mfma_f32_32x32x16_bf16(A, B, acc, 0, 0, 0); }
          float* up = GU + ((size_t)(n * 4 + h) * 2 + dir) * 8192;
#pragma unroll
          for (int r = 0; r < 16; ++r) up[(vb * 32 + attn::crow(r, hi)) * 64 + db * 32 + r32] = acc[r]; } }
}
__device__ __forceinline__ void gla_scan(const Frame& F_) {
    LOCAL_FRAME(F, F_);
    const float* GU = (const float*)(F.ws + WS_GU); const float* GG = (const float*)(F.ws + WS_GG); bf16_t* GS = (bf16_t*)(F.ws + WS_GS);
    constexpr int NS = 4, HS = NCHUNK / NS; static_assert(NCHUNK % NS == 0, "equal segments");
    LAS float* cs = (LAS float*)F.lds;
    LAS float* cp = cs + NS * 128;
    const int per = (4 * 2 * 8192 + F.G - 1) / F.G;
    __syncthreads();
    for (int base = 0; base < per; base += 128) {
        const int cl = F.tid & 127, ci = base + cl, seg = F.tid >> 7, g = F.bid * per + ci; const bool ok = ci < per && g < 4 * 2 * 8192;
        const int d = g & 63, vd = g & 8191, dir = (g >> 13) & 1, h = g >> 14;
        float uu[HS], gg[HS];
#define GS_OFF(i) ({ const int step_ = seg * HS + (i); const int nn_ = dir == 0 ? step_ : (step_ < 4 ? 3 - step_ : NCHUNK + 3 - step_); (nn_ * 4 + h) * 2 + dir; })
#pragma unroll
        for (int i = 0; i < HS; ++i) { const int ob = ok ? GS_OFF(i) : 0; uu[i] = GU[(size_t)ob * 8192 + vd]; gg[i] = GG[ob * 64 + d]; }
        float s = 0.f, P = 1.f;
#pragma unroll
        for (int i = 0; i < HS; ++i) { const float u = uu[i], gd = gg[i]; uu[i] = s; gg[i] = P; s = gd * s + u; P *= gd; }
        cs[seg * 128 + cl] = s; cp[seg * 128 + cl] = P;
        __syncthreads();
        float s_in = 0.f;
        for (int k = 0; k < seg; ++k) s_in = cp[k * 128 + cl] * s_in + cs[k * 128 + cl];
        if (ok) {
#pragma unroll
            for (int i = 0; i < HS; ++i) GS[(size_t)GS_OFF(i) * 8192 + vd] = f2bf(uu[i] + gg[i] * s_in); }
        __syncthreads();
#undef GS_OFF
    }
}
__device__ __forceinline__ void gla_out_unit(const Frame& F, const Args& a, int l, int n, int h, int dummy = 0) {
    const bf16_t* Z = (const bf16_t*)(F.ws + WS_Z); const bf16_t* GQK = (const bf16_t*)(F.ws + WS_GQK); const bf16_t* GVT = (const bf16_t*)(F.ws + WS_GVT);
    const bf16_t* GS = (const bf16_t*)(F.ws + WS_GS); unsigned char* MIX = F.ws + (dummy ? WS_DUMMY : 0) + WS_MIX;
    LAS bf16_t* T = (LAS bf16_t*)F.lds;
    LAS float* ssq = (LAS float*)(F.lds + 92160);
    int tz0 = threadIdx.x; asm volatile("" : "+v"(tz0));
    const int tid = tz0, tok0 = n * 64;
    __syncthreads();
    { const int c = tid >> 3, d8 = (tid & 7) * 8; const bf16_t* gp = GQK + (size_t)(tok0 + c) * 1024 + h * 64 + d8;
#pragma unroll
      for (int kd = 0; kd < 4; ++kd) *(LAS u32x4*)(T + kd * 4608 + c * 72 + d8) = *(const u32x4*)(gp + kd * 256);
#pragma unroll
      for (int i = 0; i < 2; ++i) { const int p = tid + NTHREADS * i, v = p >> 3, c8 = (p & 7) * 8;
          *(LAS u32x4*)(T + 18432 + v * 72 + c8) = *(const u32x4*)(GVT + ((size_t)(n * 4 + h) * 128 + v) * 64 + c8);
          *(LAS u32x4*)(T + 27648 + v * 72 + c8) = *(const u32x4*)(GS + ((size_t)(n * 4 + h) * 2 + 0) * 8192 + v * 64 + c8);
          *(LAS u32x4*)(T + 36864 + v * 72 + c8) = *(const u32x4*)(GS + ((size_t)(n * 4 + h) * 2 + 1) * 8192 + v * 64 + c8); } }
    __syncthreads();
    const int w = tid >> 6, cb = w & 1, vb = w >> 1, r32 = tid & 31, hi = (tid >> 5) & 1;
    f32x16 O = {};
#pragma unroll
    for (int dir = 0; dir < 2; ++dir) {
        LAS bf16_t* Q = T + (dir ? 9216 : 0); LAS bf16_t* Kt = T + (dir ? 13824 : 4608); LAS bf16_t* ST = T + (dir ? 36864 : 27648); LAS bf16_t* vT = T + 18432;
        bf16x8 qf[4];
#pragma unroll
        for (int ks = 0; ks < 4; ++ks) qf[ks] = *(const LAS bf16x8*)(Q + (cb * 32 + r32) * 72 + 16 * ks + 8 * hi);
#pragma unroll
        for (int ks = 0; ks < 4; ++ks) { const bf16x8 B = *(const LAS bf16x8*)(ST + (vb * 32 + r32) * 72 + 16 * ks + 8 * hi); O = __builtin_amdgcn_mfma_f32_32x32x16_bf16(qf[ks], B, O, 0, 0, 0); }
#pragma unroll
        for (int sb = 0; sb < 2; ++sb) {
            if ((dir == 0 && sb > cb) || (dir == 1 && sb < cb)) continue;
            f32x16 X = {};
#pragma unroll
            for (int ks = 0; ks < 4; ++ks) { const bf16x8 A = *(const LAS bf16x8*)(Kt + (sb * 32 + r32) * 72 + 16 * ks + 8 * hi); X = __builtin_amdgcn_mfma_f32_32x32x16_bf16(A, qf[ks], X, 0, 0, 0); }
            if (sb == cb) {
#pragma unroll
                for (int r = 0; r < 16; ++r) { const int s = attn::crow(r, hi); const bool keep = dir == 0 ? (s <= r32) : (s >= r32); X[r] = keep ? X[r] : 0.f; } }
#pragma unroll
            for (int kk = 0; kk < 2; ++kk) {
                u32x4 pw = {cvt_pk_bf16(X[8 * kk + 0], X[8 * kk + 1]), cvt_pk_bf16(X[8 * kk + 2], X[8 * kk + 3]), cvt_pk_bf16(X[8 * kk + 4], X[8 * kk + 5]), cvt_pk_bf16(X[8 * kk + 6], X[8 * kk + 7])};
                const bf16x8 pa = *reinterpret_cast<bf16x8*>(&pw);
                const u32x2 lo = *(const LAS u32x2*)(vT + (vb * 32 + r32) * 72 + sb * 32 + 16 * kk + 4 * hi), hh = *(const LAS u32x2*)(vT + (vb * 32 + r32) * 72 + sb * 32 + 16 * kk + 8 + 4 * hi);
                u32x4 bw = {lo.x, lo.y, hh.x, hh.y};
                O = __builtin_amdgcn_mfma_f32_32x32x16_bf16(pa, *reinterpret_cast<bf16x8*>(&bw), O, 0, 0, 0); }
        }
    }
#pragma unroll
    for (int r = 0; r < 16; ++r) { float ss = O[r] * O[r];
#pragma unroll
        for (int s = 16; s >= 1; s >>= 1) ss += __shfl_xor(ss, s, 64);
        if (r32 == 0) ssq[(cb * 32 + attn::crow(r, hi)) * 4 + vb] = ss; }
    __syncthreads();
    const float gn = a.in[I_GLAG][l * 128 + vb * 32 + r32];
#pragma unroll
    for (int r = 0; r < 16; ++r) { const int c = cb * 32 + attn::crow(r, hi); const f32x4 q4 = *(const LAS f32x4*)(ssq + c * 4);
        const float rs = rsqrtf((q4[0] + q4[1] + q4[2] + q4[3]) * (1.f / 128.f) + NORM_EPS);
        const float gate = bf2f(Z[(size_t)(tok0 + c) * ZW + ZC_GG + h * 128 + vb * 32 + r32]);
        const float on = O[r] * rs * gn;
        MIX[(size_t)(tok0 + c) * DM + h * 128 + vb * 32 + r32] = f2fp8_x16(on * silu_f(gate)); }
}
__device__ __forceinline__ void phase_router(const Frame& F_, const Args& a, int l, int tok0, int ntok, int dummy) {
    LOCAL_FRAME(F, F_);
    unsigned char* wso = F.ws + (dummy ? WS_DUMMY : 0);
    const bf16_t* X = (const bf16_t*)(F.ws + WS_X); unsigned char* A8 = F.ws + WS_A8;
    const float* mod = (const float*)(F.ws + WS_MOD) + (size_t)l * 2 * 6 * DM;
    const bf16_t* RH = (const bf16_t*)(F.ws + WS_RWT) + (size_t)l * 2 * NEXP * DM; const bf16_t* RL = RH + (size_t)NEXP * DM;
    const float* rb = a.in[I_RB] + l * NEXP; const float* n2g = a.in[I_N2G] + (size_t)l * DM;
    unsigned* cnt = (unsigned*)(F.ws + WS_CTL) + (dummy ? CW_CNTD : CW_CNT) + l * NEXP;
    int* list = (int*)(wso + WS_LIST); int* toke = (int*)(wso + WS_TOKE); int* tokp = (int*)(wso + WS_TOKP); float* tokw = (float*)(wso + WS_TOKW);
    constexpr int BT = 17;
    LAS unsigned char* up = F.lds + LDS_STAGE + LDS_MISC;
#define RT_HI(r) (F.lds + (r) * 4096)
#define RT_LO(r) (((r) < 15) ? F.lds + 69632 + (r) * 4096 : up + ((r) - 15) * 4096)
    LAS float* part = (LAS float*)(up + 8192);
    LAS int* selE = (LAS int*)(up + 8192 + 8704);
    LAS float* selW = (LAS float*)(up + 8192 + 8704 + 1536);
    LAS int* selR = (LAS int*)(up + 8192 + 8704 + 3072);
    LAS int* hist = (LAS int*)(up + 8192 + 8704 + 4608);
    LAS int* base = (LAS int*)(up + 8192 + 8704 + 4864);
    const int lane = F.lane;
    const int per = (ntok + F.G - 1) / F.G;
    const int t0 = F.bid * per, t1 = (t0 + per < ntok) ? t0 + per : ntok, nmine = t1 > t0 ? t1 - t0 : 0;
    __syncthreads();
    if (F.tid < 64) hist[F.tid] = 0;
    u32x2 xw[3][8];
#define RT_LOADX(b) do { _Pragma("unroll") for (int q = 0; q < 3; ++q) { const int jl_ = F.wave + 8 * q, j_ = (b) * BT + jl_; if (jl_ < BT) { \
        const bf16_t* xr_ = X + (size_t)(tok0 + t0 + (j_ < nmine ? j_ : 0)) * DM; \
        _Pragma("unroll") for (int k = 0; k < 8; ++k) xw[q][k] = *(const u32x2*)(xr_ + k * 256 + lane * 4); } } } while (0)
    if (nmine > 0) RT_LOADX(0);
    for (int b = 0; b * BT < nmine; ++b) {
#pragma unroll
        for (int q = 0; q < 3; ++q) { const int jl = F.wave + 8 * q, j = b * BT + jl;
            if (jl < BT && j < nmine) { const int t = tok0 + t0 + j; const float* m = mod + (size_t)(t < NCTX ? 0 : 1) * 6 * DM;
                LAS unsigned char* hr = RT_HI(jl); LAS unsigned char* lr = RT_LO(jl);
                f32x4 v[8]; float ss = 0.f;
#pragma unroll
                for (int k = 0; k < 8; ++k) { v[k] = (f32x4){bflo(xw[q][k].x), bfhi(xw[q][k].x), bflo(xw[q][k].y), bfhi(xw[q][k].y)}; ss += v[k][0] * v[k][0] + v[k][1] * v[k][1] + v[k][2] * v[k][2] + v[k][3] * v[k][3]; }
                ss = wave_sum(ss); const float rs = rsqrtf(ss * (1.f / DM) + NORM_EPS);
#pragma unroll
                for (int k = 0; k < 8; ++k) { const int i = k * 256 + lane * 4;
                    const f32x4 gg = *(const f32x4*)(n2g + i), s0 = *(const f32x4*)(m + 3 * DM + i), s1 = *(const f32x4*)(m + 4 * DM + i);
                    const f32x4 y = v[k] * rs * gg * (s1 + 1.f) + s0;
                    u32x2 wh; wh.x = cvt_pk_bf16(y[0], y[1]); wh.y = cvt_pk_bf16(y[2], y[3]);
                    u32x2 wl; wl.x = cvt_pk_bf16(y[0] - bflo(wh.x), y[1] - bfhi(wh.x)); wl.y = cvt_pk_bf16(y[2] - bflo(wh.y), y[3] - bfhi(wh.y));
                    const int sb = (i * 2) ^ ((jl & 15) << 4);
                    *(LAS u32x2*)(hr + sb) = wh; *(LAS u32x2*)(lr + sb) = wl;
                    *(unsigned*)(A8 + (size_t)t * DM + i) = cvt4_fp8(y[0], y[1], y[2], y[3]); } } }
        if ((b + 1) * BT < nmine) RT_LOADX(b + 1);
        __syncthreads();
        { const int i16 = lane & 15, k4 = lane >> 4, nt = F.wave & 3, kh = F.wave >> 2;
          const bool two = (b * BT + 16) < nmine;
          f32x4 acc0 = {0.f, 0.f, 0.f, 0.f}, acc1 = acc0;
          const bf16_t* bhp = RH + (size_t)(nt * 16 + i16) * DM + kh * 1024 + 8 * k4; const bf16_t* blp = RL + (size_t)(nt * 16 + i16) * DM + kh * 1024 + 8 * k4;
          LAS unsigned char* h0 = RT_HI(i16); LAS unsigned char* l0 = RT_LO(i16); LAS unsigned char* h1 = RT_HI(16); LAS unsigned char* l1 = RT_LO(16);
          constexpr int PG = 4;
          bf16x8 bh[PG], bl[PG];
#pragma unroll
          for (int u = 0; u < PG; ++u) { bh[u] = *(const bf16x8*)(bhp + u * 32); bl[u] = *(const bf16x8*)(blp + u * 32); }
#pragma unroll
          for (int g = 0; g < 32 / PG; ++g) { bf16x8 nh[PG], nl[PG];
              if (g + 1 < 32 / PG) {
#pragma unroll
                  for (int u = 0; u < PG; ++u) { nh[u] = *(const bf16x8*)(bhp + ((g + 1) * PG + u) * 32); nl[u] = *(const bf16x8*)(blp + ((g + 1) * PG + u) * 32); } }
#pragma unroll
              for (int u = 0; u < PG; ++u) { const int kb = (kh * 1024 + (g * PG + u) * 32 + 8 * k4) * 2;
                  const bf16x8 ah = *(const LAS bf16x8*)(h0 + (kb ^ (i16 << 4))), al = *(const LAS bf16x8*)(l0 + (kb ^ (i16 << 4)));
                  acc0 = __builtin_amdgcn_mfma_f32_16x16x32_bf16(al, bh[u], acc0, 0, 0, 0);
                  acc0 = __builtin_amdgcn_mfma_f32_16x16x32_bf16(ah, bl[u], acc0, 0, 0, 0);
                  acc0 = __builtin_amdgcn_mfma_f32_16x16x32_bf16(ah, bh[u], acc0, 0, 0, 0);
                  if (two) { const bf16x8 ch = *(const LAS bf16x8*)(h1 + kb), cl = *(const LAS bf16x8*)(l1 + kb);
                      acc1 = __builtin_amdgcn_mfma_f32_16x16x32_bf16(cl, bh[u], acc1, 0, 0, 0);
                      acc1 = __builtin_amdgcn_mfma_f32_16x16x32_bf16(ch, bl[u], acc1, 0, 0, 0);
                      acc1 = __builtin_amdgcn_mfma_f32_16x16x32_bf16(ch, bh[u], acc1, 0, 0, 0); } }
              if (g + 1 < 32 / PG) {
#pragma unroll
                  for (int u = 0; u < PG; ++u) { bh[u] = nh[u]; bl[u] = nl[u]; } } }
#pragma unroll
          for (int r = 0; r < 4; ++r) part[(kh * BT + 4 * k4 + r) * 64 + nt * 16 + i16] = acc0[r];
          if (two && k4 == 0) part[(kh * BT + 16) * 64 + nt * 16 + i16] = acc1[0]; }
        __syncthreads();
#pragma unroll 1
        for (int q = 0; q < 3; ++q) { const int jl = F.wave + 8 * q, j = b * BT + jl; if (jl >= BT || j >= nmine) break;
            const float lg = part[jl * 64 + lane] + part[(BT + jl) * 64 + lane];
            const float s = sigmoid_f(lg); float sv = s + rb[lane]; float ssum = 0.f, mys = 0.f; int myk = -1;
#pragma unroll
            for (int k = 0; k < TOPK; ++k) { const float mx = wave_max(sv); const unsigned long long bal = __ballot(sv == mx); const int win = __ffsll((long long)bal) - 1;
                const float ws_ = __shfl(s, win, 64); ssum += ws_; if (lane == win) { sv = -3.0e38f; myk = k; mys = s; } }
            if (myk >= 0) { const int rank = atomicAdd((int*)&hist[lane], 1); selE[j * 8 + myk] = lane; selW[j * 8 + myk] = mys / ssum * 2.5f; selR[j * 8 + myk] = rank; } }
    }
#undef RT_LOADX
#undef RT_HI
#undef RT_LO
    __syncthreads();
    if (F.tid < 64) base[F.tid] = hist[F.tid] > 0 ? (int)atomicAdd(&cnt[F.tid], (unsigned)hist[F.tid]) : 0;
    __syncthreads();
    for (int i = F.tid; i < nmine * 8; i += NTHREADS) { const int j = i >> 3, k = i & 7; const int tglob = tok0 + t0 + j; const int e = selE[i], pos = base[e] + selR[i];
        list[(size_t)e * NTOK + pos] = tglob; toke[(size_t)tglob * 8 + k] = e; tokp[(size_t)tglob * 8 + k] = pos; tokw[(size_t)tglob * 8 + k] = selW[i]; }
}

__device__ __forceinline__ void phase_combine(const Frame& F_, const Args& a, int l, int tok0, int ntok, int dummy) {
    LOCAL_FRAME(F, F_);
    unsigned char* wso = F.ws + (dummy ? WS_DUMMY : 0);
    const bf16_t* X = (const bf16_t*)(F.ws + WS_X); bf16_t* Xo = (bf16_t*)(wso + WS_X); bf16_t* A = (bf16_t*)(wso + WS_A); const unsigned char* Y = F.ws + WS_Y;
    const float* mod = (const float*)(F.ws + WS_MOD) + (size_t)l * 2 * 6 * DM;
    const int* toke = (const int*)(F.ws + WS_TOKE); const int* tokp = (const int*)(F.ws + WS_TOKP); const float* tokw = (const float*)(F.ws + WS_TOKW);
    const LAS int* rbS = (const LAS int*)(F.lds + LDS_STAGE + MS_RB);
    const int lane = F.lane;
    for (int tl = F.bid * 8 + F.wave; tl < ntok; tl += F.G * 8) { const int t = tok0 + tl;
        int rowv = 0; float wv = 0.f;
        if (lane < 8) { const int e = toke[(size_t)t * 8 + lane]; rowv = rbS[e] + tokp[(size_t)t * 8 + lane]; wv = tokw[(size_t)t * 8 + lane]; }
        int rows[9]; float wts[9];
#pragma unroll
        for (int s = 0; s < 8; ++s) { rows[s] = __builtin_amdgcn_readlane(rowv, s); wts[s] = __uint_as_float(__builtin_amdgcn_readlane(__float_as_uint(wv), s)); }
        rows[8] = rbS[NEXP] + tl; wts[8] = 1.f;
        f32x4 acc[8];
#pragma unroll
        for (int k = 0; k < 8; ++k) acc[k] = (f32x4){0.f, 0.f, 0.f, 0.f};
        { unsigned w[9][8];
#pragma unroll
          for (int r = 0; r < 9; ++r) { const unsigned char* yr = Y + (size_t)rows[r] * DM + lane * 4;
#pragma unroll
              for (int k = 0; k < 8; ++k) w[r][k] = *(const unsigned*)(yr + k * 256); }
#pragma unroll
          for (int r = 0; r < 9; ++r) { const float wg = wts[r];
#pragma unroll
              for (int k = 0; k < 8; ++k) { const auto lo = __builtin_amdgcn_cvt_pk_f32_fp8((int)w[r][k], false), hi = __builtin_amdgcn_cvt_pk_f32_fp8((int)w[r][k], true);
                  acc[k] += wg * (f32x4){lo[0], lo[1], hi[0], hi[1]}; } } }
        const float* m = mod + (size_t)(t < NCTX ? 0 : 1) * 6 * DM; const bf16_t* xr = X + (size_t)t * DM; bf16_t* xo = Xo + (size_t)t * DM; float ss = 0.f;
#pragma unroll
        for (int k = 0; k < 8; ++k) { const int i = k * 256 + lane * 4; const f32x4 g2 = *(const f32x4*)(m + 5 * DM + i); const u32x2 xw = *(const u32x2*)(xr + i); const f32x4 xv = {bflo(xw.x), bfhi(xw.x), bflo(xw.y), bfhi(xw.y)};
            acc[k] = xv + g2 * acc[k]; ss += acc[k][0] * acc[k][0] + acc[k][1] * acc[k][1] + acc[k][2] * acc[k][2] + acc[k][3] * acc[k][3]; }
        ss = wave_sum(ss); const float rs = rsqrtf(ss * (1.f / DM) + NORM_EPS);
        if (l + 1 < DEPTH) {
            const float* mn = (const float*)(F.ws + WS_MOD) + ((size_t)(l + 1) * 2 + (t < NCTX ? 0 : 1)) * 6 * DM; const float* g = a.in[I_N1G] + (size_t)(l + 1) * DM;
#pragma unroll
            for (int k = 0; k < 8; ++k) { const int i = k * 256 + lane * 4; { u32x2 xo2; xo2.x = cvt_pk_bf16(acc[k][0], acc[k][1]); xo2.y = cvt_pk_bf16(acc[k][2], acc[k][3]); *(u32x2*)(xo + i) = xo2; }
                const f32x4 gg = *(const f32x4*)(g + i), s0 = *(const f32x4*)(mn + i), s1 = *(const f32x4*)(mn + DM + i);
                const f32x4 y = acc[k] * rs * gg * (s1 + 1.f) + s0; u32x2 w; w.x = cvt_pk_bf16(y[0], y[1]); w.y = cvt_pk_bf16(y[2], y[3]); *(u32x2*)(A + (size_t)t * DM + i) = w; }
        } else {
            float* orow = (dummy ? (float*)(F.ws + WS_DUMMY + WS_X) : a.out) + (size_t)(t - NCTX) * DM; const float* g = a.in[I_FG];
#pragma unroll
            for (int k = 0; k < 8; ++k) { const int i = k * 256 + lane * 4; const f32x4 gg = *(const f32x4*)(g + i); *(f32x4*)(orow + i) = acc[k] * rs * gg; }
        }
    }
}

__device__ __forceinline__ float diff_lambda(const Args& a, int l) {
    float s1 = 0.f, s2 = 0.f;
    for (int i = 0; i < 64; ++i) { s1 += a.in[I_LQ1][l * 64 + i] * a.in[I_LK1][l * 64 + i]; s2 += a.in[I_LQ2][l * 64 + i] * a.in[I_LK2][l * 64 + i]; }
    const float lam = expf(s1) - expf(s2) + (l == 0 ? 0.2f : 0.35550907f);
    return __uint_as_float(__builtin_amdgcn_readfirstlane(__float_as_uint(lam)));
}
template <int BGL>
__device__ __forceinline__ void attn_gqa_unit(const Frame& F, int hq, int row0, int seq, const attn::BgArgs bg) {
    const bf16_t* Z = (const bf16_t*)(F.ws + WS_Z); unsigned char* MIX = F.ws + WS_MIX; const int kv = hq >> 2;
    attn::OutArgs oa; oa.mix = MIX + (size_t)row0 * DM + 512 + hq * 128; oa.scr = nullptr; oa.lam = 0.f; oa.osc = 0.f; oa.ng = nullptr;
    attn::body<128, 0, BGL>(Z + (size_t)row0 * ZW + ZC_AQ + hq * 128, Z + ZC_AK + kv * 128, Z + ZC_AV + kv * 128, seq, (char*)F.lds, oa, bg);
}
template <int BGL>
__device__ __forceinline__ void attn_diff_unit(const Frame& F, const Args& a, int l, int hd, int row0, int seq, float lam, const attn::BgArgs bg) {
    const bf16_t* Z = (const bf16_t*)(F.ws + WS_Z); unsigned char* MIX = F.ws + WS_MIX;
    attn::OutArgs oa; oa.mix = MIX + (size_t)row0 * DM + 1536 + hd * 128; oa.scr = (float*)(F.ws + WS_DSCR) + (size_t)F.bid * 256 * 128;
    oa.lam = lam; oa.osc = (l == 0 ? 0.8f : 0.64449093f); oa.ng = a.in[I_DNG] + l * 128;
    attn::body<64, 1, BGL>(Z + (size_t)row0 * ZW + ZC_DQ + hd * 128, Z + ZC_DK + hd * 128, Z + ZC_DV + hd * 128, seq, (char*)F.lds, oa, bg);
    attn::body<64, 2, BGL>(Z + (size_t)row0 * ZW + ZC_DQ + hd * 128 + 64, Z + ZC_DK + hd * 128 + 64, Z + ZC_DV + hd * 128, seq, (char*)F.lds, oa, bg);
}
struct AUnit { int type, p0, row0, seq; };
template <int l>
__device__ __forceinline__ bool attn_unit_of(int G, int bid, int vcu, int k, AUnit& u) {
    constexpr int nsmall = (l == 0 ? 12 : 0) + (l == 0 ? NCHUNK : NCHUNK - 4) * 4;
    int li;
    if (G == 256) { const int x = vcu >> 5, j = vcu & 31;
#if AT_PLAN == 1
        if (x < 4) { if (k == 0) li = x * 32 + j; else li = 384 + x * 32 + j + 128 * (k - 1); }
        else { if (k > 1) return false; li = 128 + (2 * (x - 4) + k) * 32 + j; }
#else
        if (j < 16) { if (k == 0) li = x * 16 + j; else { const int sm = x * 16 + j + 128 * (k - 1); if (sm >= SM_NA) return false; li = 384 + sm; } }
        else { if (k < 2) li = 128 + x * 32 + (j - 16) + 16 * k; else li = 384 + SM_NA + x * 16 + (j - 16) + 128 * (k - 2); }
#endif
    } else li = bid + k * G;
    if (li >= 384 + nsmall) return false;
    if (li < 128) { u.type = 1; u.p0 = li >> 5; u.row0 = NCTX + (li & 31) * 256; u.seq = NTOK; return true; }
    if (li < 384) { const int g = li - 128; u.type = 0; u.p0 = g >> 5; u.row0 = NCTX + (g & 31) * 256; u.seq = NTOK; return true; }
    int v = li - 384;
    if (l == 0) { if (v < 8) { u.type = 0; u.p0 = v; u.row0 = 0; u.seq = NCTX; return true; }
                  if (v < 12) { u.type = 1; u.p0 = v - 8; u.row0 = 0; u.seq = NCTX; return true; } v -= 12; }
    u.type = 2; u.p0 = v & 3; u.row0 = (l == 0) ? (v >> 2) : 4 + (v >> 2); u.seq = 0; return true;
}
template <int l>
__device__ __forceinline__ void phase_attention(const Frame& F, const Args& a) {
    const float lam = diff_lambda(a, l);
    const attn::BgArgs bg{nullptr, &a, F.ws, F.lds};
    for (int k = 0;; ++k) {
        AUnit u; if (!attn_unit_of<l>(F.G, F.bid, F.vcu, k, u)) break;
        const int nrep = ((REP_PH == 13 && u.type == 0) || (REP_PH == 14 && u.type == 1) || (REP_PH == 15 && u.type == 2)) ? 2 : 1;
        for (int rep = 0; rep < nrep; ++rep) {
        if (u.type == 0) attn_gqa_unit<-1>(F, u.p0, u.row0, u.seq, bg);
        else if (u.type == 1) attn_diff_unit<-1>(F, a, l, u.p0, u.row0, u.seq, lam, bg);
        else gla_out_unit(F, a, l, rep ? (u.row0 + 66) % NCHUNK : u.row0, u.p0, rep); }
    }
#if WC_ATT
    { unsigned* done = (unsigned*)(F.ws + WS_CTL) + CW_DONE + 32 * (8 + l);
      __syncthreads();
      if (F.tid == 0) __hip_atomic_fetch_add(done, 1u, __ATOMIC_RELAXED, __HIP_MEMORY_SCOPE_AGENT);
      wc_work(a, F.ws, F.lds, (unsigned*)(F.ws + WS_CTL), WC_CH_TOTAL, done, (unsigned)F.G); }
#endif
}

constexpr int PH_PRO = 0, PH_N1 = 1, PH_L0 = 2, PH_PER_LAYER = 9, N_PHASES = PH_L0 + DEPTH * PH_PER_LAYER;
#ifndef REP_PH
#define REP_PH -1
#endif
#if !MK_PER_PHASE
#define SEAM(k) do { if ((k) + 1 < hi) { xcd_barrier(bar); if (REP_PH == 12) xcd_barrier(bar); } } while (0)
#define LP_BAR , bar
#else
#define SEAM(k) do { } while (0)
#define LP_BAR
#endif
#ifdef ONLY_PH
#define PHSEL(k) (((k) < PH_L0 ? (k) : PH_L0 + ((k) - PH_L0) % PH_PER_LAYER) == ONLY_PH)
#else
#define PHSEL(k) true
#endif
#define IN(k) (PHSEL(k) && lo <= (k) && (k) < hi)
#define PHCLASS(k) ((k) < PH_L0 ? (k) : PH_L0 + ((k) - PH_L0) % PH_PER_LAYER)
#define NREP(k) ((PHCLASS(k) == REP_PH) ? 2 : 1)
template <int l>
__device__ __forceinline__ void layer_phases(const Frame& F, const Args& args, unsigned* ctl, const int lo, const int hi
#if !MK_PER_PHASE
    , const XcdBarrier& bar
#endif
    ) {
        const int pb = PH_L0 + l * PH_PER_LAYER;
        const int tok0 = (l == 0) ? 0 : NCTX, ntok = NTOK - tok0;
#define GEMM_DONE(k) (ctl + CW_DONE + 32 * (l * 4 + (k)))
#define SIGNAL_DONE(k) do { if (F.tid == 0) __hip_atomic_fetch_add(GEMM_DONE(k), 1u, __ATOMIC_RELAXED, __HIP_MEMORY_SCOPE_AGENT); } while (0)
        bf16_t* A = (bf16_t*)(F.ws + WS_A); bf16_t* Zb = (bf16_t*)(F.ws + WS_Z); bf16_t* X = (bf16_t*)(F.ws + WS_X);
        const float* mod = (const float*)(F.ws + WS_MOD) + (size_t)l * 2 * 6 * DM;
        if (IN(pb + 0)) {
            const int ge = (WC_TAIL & 1) ? F.G : wc_geff((NTOK / 256) * (ZW / 256), F.G);
            if (F.bid < ge) {
                DenseSched S; S.init(NTOK, ZW, DM * 2, ge, F.bid, 0, (const bf16_t*)(F.ws + WS_BTIN) + (size_t)l * ZW * DM);
                EpiZ E{Zb, ZW};
                for (int rep = 0; rep < NREP(pb + 0); ++rep) pg8::gemm_phase<EpiZ, DenseSched, false>(F.lds, A, DM * 2, S, E);
                SIGNAL_DONE(0);
                if (WC_TAIL & 1) wc_work(args, F.ws, F.lds, ctl, WC_CH_TOTAL, GEMM_DONE(0), (unsigned)ge);
            } else if (WC_MASK & 1) wc_work(args, F.ws, F.lds, ctl, WC_CH_TOTAL, GEMM_DONE(0), (unsigned)ge);
            SEAM(pb + 0);
        }
        if (IN(pb + 1)) {
            for (int rep = 0; rep < NREP(pb + 1); ++rep) for (int u = F.bid; u < NCHUNK * 4; u += F.G) gla_prep_unit(F, args, l, u >> 2, u & 3);
            { const int n3 = NCHUNK * 4 - 2 * F.G; const bool split = n3 > 0 && n3 < F.G;
              if (!split) { for (int rep = ((REP_PH == 16) ? 1 : 0); rep >= 0; --rep) qk_prep(F, args, l, rep, F.bid, F.G); }
              else if (F.bid >= n3) { for (int rep = ((REP_PH == 16) ? 1 : 0); rep >= 0; --rep) qk_prep(F, args, l, rep, F.bid - n3, F.G - n3); } }
            SEAM(pb + 1);
        }
        if (IN(pb + 2)) { for (int rep = 0; rep < NREP(pb + 2); ++rep) gla_scan(F); SEAM(pb + 2); }
        if (IN(pb + 3)) { for (int rep = 0; rep < NREP(pb + 3); ++rep) phase_attention<l>(F, args); SEAM(pb + 3); }
        if (IN(pb + 4)) {
            constexpr int NOUT = (l == 0) ? WC_NOUT : WC_NOUT1;
            const int ge = (F.G % 8 == 0 && F.G > NOUT) ? NOUT : F.G;
            if (F.bid < ge) {
                DenseSched S; S.init(ntok, DM, DM, ge, F.bid, tok0, F.ws + WS_BTOUT + (size_t)l * DM * DM);
                for (int rep = NREP(pb + 4) - 1; rep >= 0; --rep) { EpiOut E{X, mod + 2 * DM, mod + 6 * DM + 2 * DM, rep ? (bf16_t*)(F.ws + WS_DUMMY + WS_X) : X};
                    pg8::gemm_phase<EpiOut, DenseSched, true>(F.lds, F.ws + WS_MIX, DM, S, E); }
            }
            wc_work(args, F.ws, F.lds, ctl, l * WC_CH_LAYER + WC_CH_GU, nullptr, 0u);
            SEAM(pb + 4);
        }
        if (IN(pb + 5)) { wc_work(args, F.ws, F.lds, ctl, l * WC_CH_LAYER + WC_CH_GU, nullptr, 0u); __syncthreads();
            for (int rep = NREP(pb + 5) - 1; rep >= 0; --rep) phase_router(F, args, l, tok0, ntok, rep); SEAM(pb + 5); }
        if (IN(pb + 6)) {
            moe_tables(F, ctl + CW_CNT + l * NEXP, ntok);
            const int ge = wc_geff(*(const LAS int*)(F.lds + LDS_STAGE + MS_NT) * 4, F.G), ge8 = ge >> 3;
            const bool gemm_wg = (ge == F.G) || (F.bid >> 3) < ge8;
            MoeSched<4, true> S; S.misc = F.lds + LDS_STAGE; S.G = ge; S.c = (ge == F.G) ? F.vcu : (F.bid & 7) * ge8 + (F.bid >> 3); S.RB = DM; S.tok0 = tok0;
            S.Bt = F.ws + WS_BTGU + (size_t)l * 65 * 1024 * DM; S.bstride = (size_t)1024 * DM; S.list = (const int*)(F.ws + WS_LIST);
            if (gemm_wg) {
                for (int rep = ((REP_PH == 18 || REP_PH == 8) ? 1 : 0); rep >= 0; --rep) { EpiUp E{F.ws + WS_H, (REP_PH == 18 && rep) ? 1 : 0};
                    pg8::gemm_phase<EpiUp, MoeSched<4, true>, true>(F.lds, F.ws + WS_A8, DM, S, E); }
                SIGNAL_DONE(2);
            } else if (WC_MASK & 4) wc_work(args, F.ws, F.lds, ctl, WC_CH_TOTAL, GEMM_DONE(2), (unsigned)ge);
            wc_work(args, F.ws, F.lds, ctl, (l + 1) * WC_CH_LAYER, nullptr, 0u);
            SEAM(pb + 6);
        }
        if (IN(pb + 7)) {
            moe_tables(F, ctl + CW_CNT + l * NEXP, ntok);
            const int ge = wc_geff(*(const LAS int*)(F.lds + LDS_STAGE + MS_NT) * 8, F.G), ge8 = ge >> 3;
            const bool gemm_wg = (ge == F.G) || (F.bid >> 3) < ge8;
            MoeSched<8, false> S; S.misc = F.lds + LDS_STAGE; S.G = ge; S.c = (ge == F.G) ? F.vcu : (F.bid & 7) * ge8 + (F.bid >> 3); S.RB = EH; S.tok0 = tok0;
            S.Bt = F.ws + WS_BTD + (size_t)l * 65 * DM * EH; S.bstride = (size_t)DM * EH; S.list = nullptr;
            if (gemm_wg) {
                for (int rep = ((REP_PH == 17 || REP_PH == 9) ? 1 : 0); rep >= 0; --rep) { EpiDown E{F.ws + WS_Y, (REP_PH == 17 && rep) ? 1 : 0};
                    pg8::gemm_phase<EpiDown, MoeSched<8, false>, true>(F.lds, F.ws + WS_H, EH, S, E); }
                SIGNAL_DONE(3);
            } else if (WC_MASK & 8) wc_work(args, F.ws, F.lds, ctl, WC_CH_TOTAL, GEMM_DONE(3), (unsigned)ge);
            SEAM(pb + 7);
        }
        if (IN(pb + 8)) {
            moe_tables(F, ctl + CW_CNT + l * NEXP, ntok);
            for (int rep = NREP(pb + 8) - 1; rep >= 0; --rep) phase_combine(F, args, l, tok0, ntok, rep);
            SEAM(pb + 8);
        }
    }
__global__ void __launch_bounds__(NTHREADS, 2) fwd(Args args) {
    extern __shared__ __attribute__((aligned(16))) unsigned char lds_raw[];
    Frame F; F.lds = (LAS unsigned char*)lds_raw; F.ws = args.ws;
    F.tid = threadIdx.x; F.lane = F.tid & 63; F.wave = __builtin_amdgcn_readfirstlane(F.tid >> 6); F.G = gridDim.x; F.bid = blockIdx.x;
    F.vcu = (F.G % 8 == 0) ? (F.bid % 8) * (F.G / 8) + F.bid / 8 : F.bid;
    unsigned* ctl = (unsigned*)(F.ws + WS_CTL);
    const int lo = args.ph_lo, hi = args.ph_hi;
#if !MK_PER_PHASE
    if (F.tid < 4) ((LAS unsigned*)(F.lds + LDS_STAGE))[F.tid] = 0u;
    __syncthreads();
    XcdBarrier bar = xcd_barrier_post(ctl + CW_BAR, (volatile LAS unsigned*)(F.lds + LDS_STAGE));
#endif
    if (IN(PH_PRO)) {
        for (int rep = 0; rep < ((REP_PH == 11) ? 2 : 1); ++rep) mod_gemv(F, args.in[I_C], args.in[I_CCTX], args.in[I_WMOD], args.in[I_BMOD], (float*)(F.ws + WS_MOD));
        small_tables(F, (float*)(F.ws + WS_ROPE), args.in[I_RW], (float*)(F.ws + WS_RWT));
        for (int rep = 0; rep < NREP(PH_PRO); ++rep) { convert_weights(F, args);
            }
        SEAM(PH_PRO);
    }
    if (IN(PH_N1)) { for (int rep = 0; rep < NREP(PH_N1); ++rep) phase_norm1(F, args); SEAM(PH_N1); }
    layer_phases<0>(F, args, ctl, lo, hi LP_BAR);
    layer_phases<1>(F, args, ctl, lo, hi LP_BAR);
#undef IN
#undef SEAM
}

extern "C" void kernel_launch(void* const* d_in, const int* in_sizes, int n_in, void* d_out, int out_size, void* d_ws, size_t ws_size, hipStream_t stream) {
    static int grid = 0;
    if (grid == 0) {
        if (n_in != 31 || out_size != SEQ * DM || ws_size < WS_END + (REP_PH >= 0 ? WS_DUMMY_BYTES : 0)) { fprintf(stderr, "kernel_launch: expected 31 inputs, out %d, ws >= %zu; got n_in %d out %d ws %zu\n", SEQ * DM, (size_t)WS_END, n_in, out_size, ws_size); grid = -1; return; }
        int dev = 0, cus = 0, per_cu = 0;
        if (hipGetDevice(&dev) != hipSuccess || hipDeviceGetAttribute(&cus, hipDeviceAttributeMultiprocessorCount, dev) != hipSuccess) { grid = -1; return; }
        if (hipFuncSetAttribute((const void*)fwd, hipFuncAttributeMaxDynamicSharedMemorySize, LDS_BYTES) != hipSuccess) { fprintf(stderr, "kernel_launch: hipFuncSetAttribute failed\n"); grid = -1; return; }
        if (hipOccupancyMaxActiveBlocksPerMultiprocessor(&per_cu, (const void*)fwd, NTHREADS, LDS_BYTES) != hipSuccess || per_cu < 1) fprintf(stderr, "kernel_launch: occupancy query says %d\n", per_cu);
        (void)hipGetLastError();
        grid = cus;
    }
    if (grid < 0) return;
    (void)hipMemsetAsync((char*)d_ws + WS_CTL, 0, CTL_BYTES, stream);
    Args a{};
    for (int i = 0; i < 31; ++i) a.in[i] = (const float*)d_in[i];
    a.out = (float*)d_out; a.ws = (unsigned char*)d_ws;
#if MK_PER_PHASE
    for (int p = 0; p < N_PHASES; ++p) { a.ph_lo = p; a.ph_hi = p + 1; hipLaunchKernelGGL(fwd, dim3(grid), dim3(NTHREADS), LDS_BYTES, stream, a); }
#else
    a.ph_lo = 0; a.ph_hi = N_PHASES;
    hipLaunchKernelGGL(fwd, dim3(grid), dim3(NTHREADS), LDS_BYTES, stream, a);
#endif
    const hipError_t le = hipPeekAtLastError();
    if (le != hipSuccess) fprintf(stderr, "kernel_launch: launch failed: %s\n", hipGetErrorName(le));
}
```

```cpp
#include <hip/hip_runtime.h>
#include <stdint.h>
#include <stdio.h>

#ifndef WC_MASK
#define WC_MASK 0
#endif
#ifndef WC_TAIL
#define WC_TAIL 0
#endif
#ifndef SM_NA
#define SM_NA 4096
#endif
#ifndef WC_ATT
#define WC_ATT 0
#endif
#ifndef AT_PLAN
#define AT_PLAN 1
#endif
#ifndef SM_GQ
#define SM_GQ 128
#endif
#ifndef ATTN_F8
#define ATTN_F8 1
#endif
constexpr int QK8_ROW = 2304;
#ifndef INPROJ_F8
#define INPROJ_F8 1
#endif
#ifndef PRO_DEFER
#define PRO_DEFER 1
#endif
#ifndef WC_NOUT1
#define WC_NOUT1 128
#endif
#ifndef WC_NOUT
#define WC_NOUT 176
#endif
#ifndef REP_PH
#define REP_PH -1
#endif
#ifndef MK_PER_PHASE
#define MK_PER_PHASE 0
#endif

typedef unsigned short bf16_t;
typedef short bf16x8 __attribute__((ext_vector_type(8)));
typedef short s16x4 __attribute__((ext_vector_type(4)));
typedef float f32x4 __attribute__((ext_vector_type(4)));
typedef float f32x16 __attribute__((ext_vector_type(16)));
typedef unsigned u32x4 __attribute__((ext_vector_type(4)));
typedef unsigned u32x2 __attribute__((ext_vector_type(2)));
typedef int i32x4 __attribute__((ext_vector_type(4)));
typedef int i32x8 __attribute__((ext_vector_type(8)));
#define LAS __attribute__((address_space(3)))

constexpr int DM = 2048, SEQ = 8192, NCTX = 256, NTOK = SEQ + NCTX, DEPTH = 2;
constexpr int GRIDW = 64;
constexpr int IN_W = 4640, ZW = 4864;
constexpr int ZC_GQ = 0, ZC_GK = 256, ZC_GV = 512, ZC_GG = 1024, ZC_AQ = 1536, ZC_AK = 2560, ZC_AV = 2816, ZC_DQ = 3072, ZC_DK = 3584, ZC_DV = 4096, ZC_DEC = 4608;
constexpr int NEXP = 64, TOPK = 8, EH = 512;
constexpr int NCHUNK = NTOK / 64;
constexpr float NORM_EPS = 1e-6f;
constexpr int HROWS = 92416;
constexpr int NTHREADS = 512;

constexpr size_t al256(size_t x) { return (x + 255) / 256 * 256; }
constexpr size_t WS_CTL   = 0;
constexpr size_t CTL_BYTES = 65536;
constexpr size_t WS_MOD   = WS_CTL + CTL_BYTES;
constexpr size_t WS_ROPE  = WS_MOD + al256((size_t)2 * 2 * 6 * DM * 4);
constexpr size_t WS_RWT   = WS_ROPE + al256((size_t)(128 * 32 * 2 + 128 * 16 * 2) * 4);
constexpr size_t WS_BTIN  = WS_RWT + al256((size_t)2 * NEXP * DM * 4);
constexpr size_t WS_BTOUT = WS_BTIN + al256((size_t)2 * ZW * DM * 2);
constexpr size_t WS_BTGU  = WS_BTOUT + al256((size_t)2 * DM * DM * 2);
constexpr size_t WS_BTD   = WS_BTGU + al256((size_t)2 * 65 * 1024 * DM * 2);
constexpr size_t WS_X     = WS_BTD + al256((size_t)2 * 65 * DM * EH * 2);
constexpr size_t WS_A     = WS_X + al256((size_t)NTOK * DM * 4);
constexpr size_t WS_Z     = WS_A + al256((size_t)NTOK * DM * 2);
constexpr size_t WS_GQK   = WS_Z + al256((size_t)NTOK * ZW * 2);
constexpr size_t WS_GVT   = WS_GQK + al256((size_t)NTOK * 4 * 256 * 2);
constexpr size_t WS_GU    = WS_GVT + al256((size_t)NCHUNK * 4 * 128 * 64 * 2);
constexpr size_t WS_GG    = WS_GU + al256((size_t)NCHUNK * 4 * 2 * 128 * 64 * 4);
constexpr size_t WS_GS    = WS_GG + al256((size_t)NCHUNK * 4 * 2 * 64 * 4);
constexpr size_t WS_MIX   = WS_GS + al256((size_t)NCHUNK * 4 * 2 * 128 * 64 * 2);
constexpr size_t WS_DSCR  = WS_MIX + al256((size_t)NTOK * DM * 2);
constexpr size_t WS_LIST  = WS_DSCR + al256((size_t)256 * 256 * 128 * 4);
constexpr size_t WS_TOKE  = WS_LIST + al256((size_t)NEXP * NTOK * 4);
constexpr size_t WS_TOKP  = WS_TOKE + al256((size_t)NTOK * 8 * 4);
constexpr size_t WS_TOKW  = WS_TOKP + al256((size_t)NTOK * 8 * 4);
constexpr size_t WS_H     = WS_TOKW + al256((size_t)NTOK * 8 * 4);
constexpr size_t WS_Y     = WS_H + al256((size_t)HROWS * EH * 2);
constexpr size_t WS_AF    = WS_Y + al256((size_t)HROWS * DM * 2);
constexpr size_t WS_QK8   = WS_AF;
constexpr size_t WS_A8    = WS_AF + al256((size_t)NTOK * DM * 4);
constexpr size_t WS_END   = WS_A8 + al256((size_t)NTOK * DM);
constexpr size_t WS_DUMMY = WS_END - WS_X;
constexpr size_t WS_DUMMY_BYTES = WS_H - WS_X;

constexpr int CW_BAR = 0;
constexpr int CW_CNT = 4096;
constexpr int CW_Q   = 4352;
constexpr int CW_LEFT = 5600;
constexpr int CW_DONE = 4800;
constexpr int CW_CNTD = 4608;

constexpr int LDS_STAGE = 131072;
constexpr int LDS_MISC  = 8192;
constexpr int LDS_BYTES = 163840;
constexpr int MS_CNT = 64;
constexpr int MS_RB  = 64 + 68 * 4;
constexpr int MS_TE  = MS_RB + 68 * 4;
constexpr int MS_TM  = MS_TE + 1024;
constexpr int MS_NT  = MS_TM + 1024;
constexpr int MS_F   = MS_NT + 16;

__device__ __forceinline__ unsigned cvt_pk_bf16(float lo, float hi) { unsigned r; asm volatile("v_cvt_pk_bf16_f32 %0, %1, %2" : "=v"(r) : "v"(lo), "v"(hi)); return r; }
__device__ __forceinline__ bf16_t f2bf(float x) { return (bf16_t)(cvt_pk_bf16(x, 0.f) & 0xffffu); }
__device__ __forceinline__ float clamp448(float x) { return __builtin_amdgcn_fmed3f(x, -448.f, 448.f); }
__device__ __forceinline__ unsigned cvt4_fp8(float a, float b, float c, float d) { a = clamp448(a); b = clamp448(b); c = clamp448(c); d = clamp448(d); int w = __builtin_amdgcn_cvt_pk_fp8_f32(a, b, 0, false); w = __builtin_amdgcn_cvt_pk_fp8_f32(c, d, w, true); return (unsigned)w; }
__device__ __forceinline__ unsigned char f2fp8_x16(float x) { return (unsigned char)(__builtin_amdgcn_cvt_pk_fp8_f32(clamp448(x * 16.f), 0.f, 0, false) & 0xff); }
__device__ __forceinline__ float bf2f(bf16_t b) { return __uint_as_float(((unsigned)b) << 16); }
__device__ __forceinline__ float bflo(unsigned w) { return __uint_as_float(w << 16); }
__device__ __forceinline__ float bfhi(unsigned w) { return __uint_as_float(w & 0xffff0000u); }
__device__ __forceinline__ float wave_sum(float v) {
#pragma unroll
    for (int o = 32; o >= 1; o >>= 1) v += __shfl_xor(v, o, 64);
    return v;
}
__device__ __forceinline__ float wave_max(float v) {
#pragma unroll
    for (int o = 32; o >= 1; o >>= 1) v = fmaxf(v, __shfl_xor(v, o, 64));
    return v;
}
__device__ __forceinline__ float silu_f(float x) { return x * __builtin_amdgcn_rcpf(1.f + __expf(-x)); }
__device__ __forceinline__ float sigmoid_f(float x) { return 1.f / (1.f + expf(-x)); }
__device__ __forceinline__ float logsigmoid_f(float x) { return fminf(x, 0.f) - __logf(1.f + __expf(-fabsf(x))); }
#define VM_WAIT() asm volatile("s_waitcnt vmcnt(0)" ::: "memory")

#define XB_TMO      128
#define XB_XCNT(j)  (256  + 64 * (j))
#define XB_XSUB(j)  (1280 + 64 * (j))
#define XB_XGEN(j)  (2304 + 64 * (j))
#define XB_TOP      3328
#define XB_TOPGEN   3392
#define XCD_BAR_WORDS 3456
#define XB_SPIN_CAP (1u << 22)
__device__ __forceinline__ unsigned xb_ld(unsigned* p)              { return __hip_atomic_load(p, __ATOMIC_RELAXED, __HIP_MEMORY_SCOPE_AGENT); }
__device__ __forceinline__ unsigned xb_add(unsigned* p, unsigned v) { return __hip_atomic_fetch_add(p, v, __ATOMIC_RELAXED, __HIP_MEMORY_SCOPE_AGENT); }
__device__ __forceinline__ unsigned xb_xcc_id() { return (unsigned)__builtin_amdgcn_s_getreg((3 << 11) | 20) & 0xFu; }
#define XB_SPIN(cond, bar) do { unsigned _sp = 0; while (cond) { __builtin_amdgcn_s_sleep(1); \
    if ((++_sp & 255u) == 0u) { if (xb_ld(&(bar)[XB_TMO])) break; if (_sp > XB_SPIN_CAP) { atomicAdd(&(bar)[XB_TMO], 1u); break; } } } } while (0)
struct XcdBarrier { unsigned* bar; unsigned x; volatile LAS unsigned* st; };
__device__ __forceinline__ XcdBarrier xcd_barrier_post(unsigned* bar, volatile LAS unsigned* st) {
    XcdBarrier b; b.bar = bar; b.x = xb_xcc_id(); b.st = st;
    if (threadIdx.x == 0) (void)xb_add(&bar[XB_XCNT(b.x)], 1u);
    return b;
}
__device__ __forceinline__ void xcd_barrier_complete(unsigned* bar, unsigned x, unsigned& nloc, unsigned& nx) {
    const unsigned G = gridDim.x * gridDim.y * gridDim.z;
    unsigned sum, cnt, mine, sp = 0u;
    for (;;) {
        sum = 0u; cnt = 0u; mine = 0u;
#pragma unroll
        for (unsigned j = 0; j < 16; ++j) { const unsigned c = xb_ld(&bar[XB_XCNT(j)]); sum += c; cnt += (c > 0u) ? 1u : 0u; mine = (j == x) ? c : mine; }
        if (sum == G) break;
        __builtin_amdgcn_s_sleep(1);
        if ((++sp & 255u) == 0u) { if (xb_ld(&bar[XB_TMO])) break; if (sp > XB_SPIN_CAP) { atomicAdd(&bar[XB_TMO], 1u); break; } }
    }
    nloc = mine > 0u ? mine : 1u; nx = cnt > 0u ? cnt : 1u;
}
__device__ __forceinline__ void xcd_barrier(const XcdBarrier& b) {
    asm volatile("s_waitcnt vmcnt(0)" ::: "memory");
    __syncthreads();
    if (threadIdx.x == 0) {
        unsigned* bar = b.bar;
        __builtin_amdgcn_s_waitcnt(0);
        unsigned nloc = b.st[0], nx = b.st[1];
        if (nloc == 0u) { xcd_barrier_complete(bar, b.x, nloc, nx); b.st[0] = nloc; b.st[1] = nx; }
        const unsigned old = xb_add(&bar[XB_XSUB(b.x)], 1u);
        const unsigned gen = old / nloc;
        if (old + 1u == (gen + 1u) * nloc) {
            __builtin_amdgcn_fence(__ATOMIC_RELEASE, "agent");
            asm volatile("s_waitcnt vmcnt(0)" ::: "memory");
            const unsigned og = xb_add(&bar[XB_TOP], 1u);
            const unsigned tg = og / nx;
            if (og + 1u == (tg + 1u) * nx) xb_add(&bar[XB_TOPGEN], 1u);
            else XB_SPIN(xb_ld(&bar[XB_TOPGEN]) == tg, bar);
            __builtin_amdgcn_fence(__ATOMIC_ACQUIRE, "agent");
            xb_add(&bar[XB_XGEN(b.x)], 1u);
            asm volatile("s_waitcnt vmcnt(0)" ::: "memory");
        } else {
            XB_SPIN(xb_ld(&bar[XB_XGEN(b.x)]) == gen, bar);
            __builtin_amdgcn_fence(__ATOMIC_ACQUIRE, "agent");
            asm volatile("s_waitcnt vmcnt(0)" ::: "memory");
        }
    }
    __syncthreads();
}

struct Args {
    const float* in[31];
    float* out;
    unsigned char* ws;
    int ph_lo, ph_hi;
};
struct Frame {
    LAS unsigned char* lds;
    unsigned char* ws;
    int tid, lane, wave, G, bid, vcu;
};
#define LOCAL_FRAME(F, F_) Frame F = F_; { int tz_ = threadIdx.x; asm volatile("" : "+v"(tz_)); F.tid = tz_; F.lane = tz_ & 63; }
enum { I_X = 0, I_C, I_CTX, I_CCTX, I_N1G, I_N2G, I_WMOD, I_BMOD, I_WIN, I_WAF, I_BAF, I_WAB, I_BAB, I_GLAG, I_QNG, I_KNG,
       I_LQ1, I_LK1, I_LQ2, I_LK2, I_DNG, I_WOUT, I_RW, I_RB, I_EWG, I_EWU, I_EWD, I_SWG, I_SWU, I_SWD, I_FG };
constexpr int WC_CH_E = 128;
constexpr int WC_CH_GU = 2 * 65 * WC_CH_E, WC_CH_D = 65 * WC_CH_E, WC_CH_LAYER = WC_CH_GU + WC_CH_D, WC_CH_TOTAL = DEPTH * WC_CH_LAYER;
constexpr int WC_TROW = 80, WC_TILE = 128 * WC_TROW;
struct WConv {};
__device__ __forceinline__ void wc_chunk(const Args& a, unsigned char* ws, LAS unsigned char* T, int c, int lane) {
    const int l = c / WC_CH_LAYER, r = c % WC_CH_LAYER;
    int kind, e, cb, kb, ld;
    if (r < WC_CH_GU) { kind = r / WC_CH_D; const int rr = r % WC_CH_D; e = rr / WC_CH_E; const int q = rr % WC_CH_E; cb = q >> 5; kb = q & 31; ld = EH; }
    else { kind = 2; const int rr = r - WC_CH_GU; e = rr / WC_CH_E; const int q = rr % WC_CH_E; cb = q >> 3; kb = q & 7; ld = DM; }
    const float* src = (kind == 0) ? ((e < NEXP) ? a.in[I_EWG] + ((size_t)l * NEXP + e) * DM * EH : a.in[I_SWG] + (size_t)l * DM * EH)
                     : (kind == 1) ? ((e < NEXP) ? a.in[I_EWU] + ((size_t)l * NEXP + e) * DM * EH : a.in[I_SWU] + (size_t)l * DM * EH)
                                   : ((e < NEXP) ? a.in[I_EWD] + ((size_t)l * NEXP + e) * EH * DM : a.in[I_SWD] + (size_t)l * EH * DM);
    const uintptr_t pb = (uintptr_t)src; const unsigned pl = __builtin_amdgcn_readfirstlane((unsigned)pb), ph = __builtin_amdgcn_readfirstlane((unsigned)(pb >> 32));
    const __amdgpu_buffer_rsrc_t rs = __builtin_amdgcn_make_buffer_rsrc((void*)(((uintptr_t)ph << 32) | pl), 0, 0x7fffffff, 0x00020000);
    const int h = lane >> 5, c4 = (lane & 31) * 4, ld4 = ld * 4;
    const int soff = __builtin_amdgcn_readfirstlane((kb * 64 * ld + cb * 128) * 4), vofs = (h * 32 * ld + c4) * 4;
    f32x4 v[32];
#pragma unroll
    for (int j = 0; j < 32; ++j) { const u32x4 t = __builtin_amdgcn_raw_buffer_load_b128(rs, vofs, soff + j * ld4, 2); v[j] = *reinterpret_cast<const f32x4*>(&t); }
    const float scale = (kind < 2) ? 64.f : 32.f;
#pragma unroll
    for (int jc = 0; jc < 4; ++jc) {
#pragma unroll
        for (int hh = 0; hh < 2; ++hh) { u32x4 w;
#pragma unroll
            for (int d = 0; d < 4; ++d) { const int j = hh * 16 + d * 4; w[d] = cvt4_fp8(v[j][jc] * scale, v[j + 1][jc] * scale, v[j + 2][jc] * scale, v[j + 3][jc] * scale); }
            *(LAS u32x4*)(T + (c4 + jc) * WC_TROW + h * 32 + hh * 16) = w; } }
    unsigned char* d0 = (kind < 2) ? ws + WS_BTGU + (((size_t)l * 65 + e) * 1024 + 8 * (cb * 32) + 4 * kind) * DM + kb * 64
                                   : ws + WS_BTD + (((size_t)l * 65 + e) * DM + cb * 128) * EH + kb * 64;
#pragma unroll
    for (int half = 0; half < 2; ++half) { const int n = lane + half * 64;
        unsigned char* dp = d0 + ((kind < 2) ? (size_t)(8 * (n >> 2) + (n & 3)) * DM : (size_t)n * EH);
        u32x4 w[4];
#pragma unroll
        for (int i = 0; i < 4; ++i) w[i] = *(const LAS u32x4*)(T + n * WC_TROW + i * 16);
#pragma unroll
        for (int i = 0; i < 4; ++i) *(u32x4*)(dp + i * 16) = w[i]; }
}
__device__ __forceinline__ void wc_work(const Args& a, unsigned char* ws, LAS unsigned char* lds, unsigned* ctl, int limit, unsigned* done, unsigned need) {
    int tz = threadIdx.x; asm volatile("" : "+v"(tz));
    const int tid = tz, lane = tz & 63, wave = __builtin_amdgcn_readfirstlane(tz >> 6); LAS unsigned char* T = lds + wave * WC_TILE;
    LAS int* slot = (LAS int*)(lds + 8 * WC_TILE);
    unsigned* q = ctl + CW_Q; unsigned* left = ctl + CW_LEFT + blockIdx.x;
    unsigned tk = 0, dn = 0; bool have = false;
    if (tid == 0) { const unsigned pend = __hip_atomic_load(left, __ATOMIC_RELAXED, __HIP_MEMORY_SCOPE_AGENT);
        if (pend) { if ((int)((pend - 1u) * 8u) < limit) { tk = pend - 1u; have = true; __hip_atomic_store(left, 0u, __ATOMIC_RELAXED, __HIP_MEMORY_SCOPE_AGENT); } }
        else { const unsigned hd = __hip_atomic_load(q, __ATOMIC_RELAXED, __HIP_MEMORY_SCOPE_AGENT);
            if ((int)(hd * 8u) < limit) { tk = __hip_atomic_fetch_add(q, 1u, __ATOMIC_RELAXED, __HIP_MEMORY_SCOPE_AGENT); have = true; } } }
    for (int it = 0;; ++it) {
        if (tid == 0) {
            int c0 = -1;
            if (have) { c0 = (int)(tk * 8u);
                if (c0 >= WC_CH_TOTAL) c0 = -1;
                else if (c0 >= limit || (done && dn >= need)) { __hip_atomic_store(left, tk + 1u, __ATOMIC_RELAXED, __HIP_MEMORY_SCOPE_AGENT); c0 = -1; } }
            if (c0 >= 0) { tk = __hip_atomic_fetch_add(q, 1u, __ATOMIC_RELAXED, __HIP_MEMORY_SCOPE_AGENT); if (done) dn = __hip_atomic_load(done, __ATOMIC_RELAXED, __HIP_MEMORY_SCOPE_AGENT); }
            slot[(it & 1) * 2] = c0;
        }
        __syncthreads();
        const int c0 = __builtin_amdgcn_readfirstlane(slot[(it & 1) * 2]);
        if (c0 < 0) break;
        wc_chunk(a, ws, T, c0 + wave, lane);
    }
    __syncthreads();
}
__device__ __forceinline__ int wc_geff(int units, int G) {
    if (G % 8 != 0 || units <= 0) return G;
    const int k = (units + G - 1) / G; int ge = (((units + k - 1) / k) + 7) & ~7;
    return ge < G ? ge : G;
}
namespace pg8 {
constexpr int BM = 256, BK = 64, HALF = 128, HTB = HALF * BK * 2, STAGE_BYTES = 8 * HTB;
__device__ __forceinline__ int lds_byte(int r, int c) { const int st = (r >> 4) * 2 + (c >> 5), rr = r & 15, cc = c & 31, ob = rr * 64 + cc * 2; return st * 1024 + (ob ^ (((ob >> 9) & 1) << 5)); }
__device__ __forceinline__ void stage_rc(int b, int& R, int& C) { const int st = b / 1024, sb = b % 1024, swz = sb ^ (((sb >> 9) & 1) << 5); R = (st >> 1) * 16 + swz / 64; C = (st & 1) * 32 + (swz % 64) / 2; }
__device__ __forceinline__ int perm32(int rho) { const int n = rho >> 4, i = rho & 15; return 8 * (i >> 2) + 4 * n + (i & 3); }

template <class Epi, class Sched, bool F8>
__device__ __forceinline__ void gemm_phase(LAS unsigned char* lds, const void* Aptr, const int RB, const Sched& S, const Epi& E) {
    typedef typename Sched::Unit Unit;
    int tz0 = threadIdx.x; asm volatile("" : "+v"(tz0));
    const int tid = tz0, wid = __builtin_amdgcn_readfirstlane(tid >> 6), lane = tid & 63, wr = wid >> 2, wc = wid & 3, fr = lane & 15, fq = lane >> 4;
    const int nt = RB / 128;
    int sR[2], sC[2]; unsigned voffB[2][2];
#pragma unroll
    for (int i = 0; i < 2; ++i) { int R, C; stage_rc(tid * 16 + i * 8192, R, C); sR[i] = R; sC[i] = C;
        if (Epi::PERM == 2) {
#pragma unroll
            for (int h = 0; h < 2; ++h) voffB[h][i] = (unsigned)((64 * (R >> 5) + 16 * ((R >> 2) & 3) + 8 * h + 4 * ((R >> 4) & 1) + (R & 3)) * RB + C * 2); }
        else { const int Rb = Epi::PERM ? ((R & ~31) + perm32(R & 31)) : R; voffB[0][i] = (unsigned)(Rb * RB + C * 2); voffB[1][i] = voffB[0][i] + (unsigned)HALF * (unsigned)RB; } }
    const unsigned kstep = 128u;
    __amdgpu_buffer_rsrc_t rsA, rsB;
    { const uintptr_t pa = (uintptr_t)Aptr, pb = (uintptr_t)S.Bbase();
      const unsigned al = __builtin_amdgcn_readfirstlane((unsigned)pa), ah = __builtin_amdgcn_readfirstlane((unsigned)(pa >> 32));
      const unsigned bl = __builtin_amdgcn_readfirstlane((unsigned)pb), bh = __builtin_amdgcn_readfirstlane((unsigned)(pb >> 32));
      rsA = __builtin_amdgcn_make_buffer_rsrc((void*)(((uintptr_t)ah << 32) | al), 0, 0x7fffffff, 0x00020000);
      rsB = __builtin_amdgcn_make_buffer_rsrc((void*)(((uintptr_t)bh << 32) | bl), 0, 0x7fffffff, 0x00020000); }
    const unsigned ldsw = (unsigned)wid * 1024u;
    const int aoff = lds_byte(wr * 64 + fr, fq * 8), boff = lds_byte(wc * 32 + fr, fq * 8);
#define PG8_SA(b, h) (((b) * 2 + (h)) * HTB)
#define PG8_SB(b, h) ((4 + (b) * 2 + (h)) * HTB)
#define PG8_STAGEB(bufoff, soff, h) do { _Pragma("unroll") for (int _i = 0; _i < 2; ++_i) \
        __builtin_amdgcn_raw_ptr_buffer_load_lds(rsB, (LAS void*)(lds + (bufoff) + ldsw + _i * 8192), 16, voffB[h][_i], (int)(soff), 0, 0); } while (0)
#define PG8_STAGEA(bufoff, soff, v0, v1) do { \
        __builtin_amdgcn_raw_ptr_buffer_load_lds(rsA, (LAS void*)(lds + (bufoff) + ldsw), 16, (v0), (int)(soff), 0, 0); \
        __builtin_amdgcn_raw_ptr_buffer_load_lds(rsA, (LAS void*)(lds + (bufoff) + ldsw + 8192), 16, (v1), (int)(soff), 0, 0); } while (0)
#define PG8_LDA(dst, b, h) do { _Pragma("unroll") for (int m = 0; m < 4; ++m) dst[m] = __builtin_shufflevector(*(const LAS i32x4*)(lds + PG8_SA(b, h) + aoff + m * 2048), *(const LAS i32x4*)(lds + PG8_SA(b, h) + aoff + m * 2048 + 1024), 0, 1, 2, 3, 4, 5, 6, 7); } while (0)
#define PG8_LDB(dst, b, h) do { _Pragma("unroll") for (int n = 0; n < 2; ++n) dst[n] = __builtin_shufflevector(*(const LAS i32x4*)(lds + PG8_SB(b, h) + boff + n * 2048), *(const LAS i32x4*)(lds + PG8_SB(b, h) + boff + n * 2048 + 1024), 0, 1, 2, 3, 4, 5, 6, 7); } while (0)
#define PG8_H0(x) ({ i32x4 t_ = __builtin_shufflevector(x, x, 0, 1, 2, 3); *reinterpret_cast<bf16x8*>(&t_); })
#define PG8_H1(x) ({ i32x4 t_ = __builtin_shufflevector(x, x, 4, 5, 6, 7); *reinterpret_cast<bf16x8*>(&t_); })
#define PG8_MMA(ai, bj, At, Bt) do { __builtin_amdgcn_s_setprio(1); \
        if (F8) { _Pragma("unroll") for (int m = 0; m < 4; ++m) _Pragma("unroll") for (int n = 0; n < 2; ++n) \
            asm volatile("v_mfma_scale_f32_16x16x128_f8f6f4 %0, %1, %2, %0, %3, %4 op_sel_hi:[0,0,0]" : "+v"(acc[ai][bj][m][n]) : "v"(Bt[n]), "v"(At[m]), "v"(sclW), "v"(sclA)); } \
        else { _Pragma("unroll") for (int m = 0; m < 4; ++m) _Pragma("unroll") for (int n = 0; n < 2; ++n) { \
            acc[ai][bj][m][n] = __builtin_amdgcn_mfma_f32_16x16x32_bf16(PG8_H0(Bt[n]), PG8_H0(At[m]), acc[ai][bj][m][n], 0, 0, 0); \
            acc[ai][bj][m][n] = __builtin_amdgcn_mfma_f32_16x16x32_bf16(PG8_H1(Bt[n]), PG8_H1(At[m]), acc[ai][bj][m][n], 0, 0, 0); } } \
        __builtin_amdgcn_s_setprio(0); } while (0)
#define PG8_WAIT_V(n) asm volatile("s_waitcnt vmcnt(" #n ")" ::: "memory")
#define PG8_WAIT_L(n) asm volatile("s_waitcnt lgkmcnt(" #n ")" ::: "memory")
#define PG8_BAR __builtin_amdgcn_s_barrier()
#define PG8_SCHED __builtin_amdgcn_sched_barrier(0)
#define PG8_AOFFS(u, o00, o01, o10, o11) do { o00 = (unsigned)(S.row(u, sR[0]) * RB + sC[0] * 2); o01 = (unsigned)(S.row(u, sR[1]) * RB + sC[1] * 2); \
        o10 = (unsigned)(S.row(u, sR[0] + HALF) * RB + sC[0] * 2); o11 = (unsigned)(S.row(u, sR[1] + HALF) * RB + sC[1] * 2); } while (0)
    int sclW = E.wscale, sclA = E.ascale; if (F8) { asm volatile("" : "+v"(sclW), "+v"(sclA)); }
    Unit cur, nxt; int ui = 0;
    if (!S.next(0, cur)) return;
    f32x4 acc[2][2][4][2];
#pragma unroll
    for (int a = 0; a < 2; ++a)
#pragma unroll
        for (int b = 0; b < 2; ++b)
#pragma unroll
            for (int m = 0; m < 4; ++m)
#pragma unroll
                for (int n = 0; n < 2; ++n) acc[a][b][m][n] = (f32x4){0.f, 0.f, 0.f, 0.f};
    i32x8 At[4], B0[2], B1[2];
    unsigned cB = (unsigned)__builtin_amdgcn_readfirstlane((int)cur.boff);
    unsigned c00, c01, c10, c11, n00, n01, n10, n11;
    PG8_AOFFS(cur, c00, c01, c10, c11);
    n00 = c00; n01 = c01; n10 = c10; n11 = c11;
    PG8_STAGEB(PG8_SB(0, 0), cB, 0); PG8_STAGEA(PG8_SA(0, 0), 0u, c00, c01); PG8_STAGEB(PG8_SB(0, 1), cB, 1); PG8_STAGEA(PG8_SA(0, 1), 0u, c10, c11);
    if (wr == 1) PG8_BAR;
    PG8_WAIT_V(4); PG8_BAR;
    PG8_STAGEB(PG8_SB(1, 0), cB + kstep, 0); PG8_STAGEA(PG8_SA(1, 0), kstep, c00, c01); PG8_STAGEB(PG8_SB(1, 1), cB + kstep, 1);
    PG8_WAIT_V(6); PG8_BAR;
    for (;;) {
        const bool has_next = S.next(ui + 1, nxt);
        const unsigned nB = (unsigned)__builtin_amdgcn_readfirstlane((int)(has_next ? nxt.boff : cB));
        if (has_next) { PG8_AOFFS(nxt, n00, n01, n10, n11); } else { n00 = c00; n01 = c01; n10 = c10; n11 = c11; }
#pragma clang loop unroll(disable)
        for (int t = 0; t < nt; t += 2) {
            const bool last = (t == nt - 2);
            const unsigned a1 = (unsigned)__builtin_amdgcn_readfirstlane((int)((unsigned)(t + 1) * kstep));
            const unsigned a2 = (unsigned)__builtin_amdgcn_readfirstlane((int)(last ? 0u : (unsigned)(t + 2) * kstep)), b2 = (unsigned)__builtin_amdgcn_readfirstlane((int)(last ? nB : cB + (unsigned)(t + 2) * kstep));
            const unsigned a3 = a2 + kstep, b3 = b2 + kstep;
            const unsigned x00 = last ? n00 : c00, x01 = last ? n01 : c01, x10 = last ? n10 : c10, x11 = last ? n11 : c11;
            PG8_LDB(B0, 0, 0); PG8_SCHED; PG8_LDA(At, 0, 0); PG8_STAGEA(PG8_SA(1, 1), a1, c10, c11);
            PG8_WAIT_L(8); PG8_BAR; PG8_WAIT_L(0); PG8_MMA(0, 0, At, B0); PG8_BAR; PG8_SCHED;
            PG8_LDB(B1, 0, 1); PG8_STAGEB(PG8_SB(0, 0), b2, 0);
            PG8_BAR; PG8_WAIT_L(0); PG8_MMA(0, 1, At, B1); PG8_BAR;
            PG8_LDA(At, 0, 1); PG8_STAGEA(PG8_SA(0, 0), a2, x00, x01);
            PG8_BAR; PG8_WAIT_L(0); PG8_MMA(1, 0, At, B0); PG8_BAR; PG8_SCHED;
            PG8_STAGEB(PG8_SB(0, 1), b2, 1);
            PG8_WAIT_V(6); PG8_BAR; PG8_MMA(1, 1, At, B1); PG8_BAR;
            PG8_LDB(B0, 1, 0); PG8_SCHED; PG8_LDA(At, 1, 0); PG8_STAGEA(PG8_SA(0, 1), a2, x10, x11);
            PG8_WAIT_L(8); PG8_BAR; PG8_WAIT_L(0); PG8_MMA(0, 0, At, B0); PG8_BAR; PG8_SCHED;
            PG8_LDB(B1, 1, 1); PG8_STAGEB(PG8_SB(1, 0), b3, 0);
            PG8_BAR; PG8_WAIT_L(0); PG8_MMA(0, 1, At, B1); PG8_BAR;
            PG8_LDA(At, 1, 1); PG8_STAGEA(PG8_SA(1, 0), a3, x00, x01);
            PG8_BAR; PG8_WAIT_L(0); PG8_MMA(1, 0, At, B0); PG8_BAR; PG8_SCHED;
            PG8_STAGEB(PG8_SB(1, 1), b3, 1);
            PG8_WAIT_V(6); PG8_BAR; PG8_MMA(1, 1, At, B1); PG8_BAR;
        }
        if (F8) asm volatile("s_nop 15\n\ts_nop 15" ::: "memory");
        { int tz1 = threadIdx.x; asm volatile("" : "+v"(tz1));
          const int wid1 = __builtin_amdgcn_readfirstlane(tz1 >> 6), lane1 = tz1 & 63;
          E(acc, cur, wid1 >> 2, wid1 & 3, lane1 & 15, lane1 >> 4); }
        if (!has_next) break;
#pragma unroll
        for (int a = 0; a < 2; ++a)
#pragma unroll
            for (int b = 0; b < 2; ++b)
#pragma unroll
                for (int m = 0; m < 4; ++m)
#pragma unroll
                    for (int n = 0; n < 2; ++n) acc[a][b][m][n] = (f32x4){0.f, 0.f, 0.f, 0.f};
        cur = nxt; cB = nB; c00 = n00; c01 = n01; c10 = n10; c11 = n11; ++ui;
    }
    PG8_WAIT_V(0);
    if (wr == 0) PG8_BAR;
    PG8_BAR;
#undef PG8_SA
#undef PG8_SB
#undef PG8_STAGEA
#undef PG8_STAGEB
#undef PG8_LDA
#undef PG8_LDB
#undef PG8_MMA
#undef PG8_H0
#undef PG8_H1
#undef PG8_WAIT_V
#undef PG8_WAIT_L
#undef PG8_BAR
#undef PG8_SCHED
#undef PG8_AOFFS
}
}

struct DenseSched {
    struct Unit { unsigned boff; int pm, pn, m0; };
    int nM, nN, nwg, G, c, row0, RB  ; const void* Bt;
    __device__ void init(int M, int N, int RB_, int G_, int c_, int row0_, const void* Bt_) { nM = M / 256; nN = N / 256; nwg = nM * nN; G = G_; c = c_; row0 = row0_; RB = RB_; Bt = Bt_; }
    __device__ __forceinline__ bool next(int i, Unit& u) const {
        const long L = (long)i * G + c; if (L >= nwg) return false;
        int wgid = (int)L; { const int q = nwg / 8, r = nwg % 8, xcd = wgid % 8, off = wgid / 8; wgid = (xcd < r ? xcd * (q + 1) : r * (q + 1) + (xcd - r) * q) + off; }
        const int nig = 8 * nN, gid = wgid / nig, fm = gid * 8, gsz = (nM - fm) < 8 ? (nM - fm) : 8;
        u.pm = fm + ((wgid % nig) % gsz); u.pn = (wgid % nig) / gsz; u.m0 = row0 + u.pm * 256;
        u.boff = (unsigned)u.pn * 256u * (unsigned)RB; return true;
    }
    __device__ __forceinline__ int row(const Unit& u, int r) const { return u.m0 + r; }
    __device__ __forceinline__ int nrows(const Unit&) const { return 256; }
    __device__ __forceinline__ const void* Bbase() const { return Bt; }
};
template <int NTS, bool GATHER>
struct MoeSched {
    struct Unit { unsigned boff; int e, mt, pn, rows, hrow0; };
    LAS unsigned char* misc; int G, c, RB  , tok0; const unsigned char* Bt; size_t bstride  ; const int* list;
    __device__ __forceinline__ bool next(int i, Unit& u) const {
        const int ntiles = *(const LAS int*)(misc + MS_NT);
        const long L = (long)i * G + c; if (L >= (long)ntiles * NTS) return false;
        const int t = (int)(L / NTS); u.pn = (int)(L % NTS);
        u.e = ((const LAS short*)(misc + MS_TE))[t]; u.mt = ((const LAS short*)(misc + MS_TM))[t];
        const int cnt = ((const LAS int*)(misc + MS_CNT))[u.e]; const int rem = cnt - u.mt * 256; u.rows = rem < 256 ? rem : 256;
        u.hrow0 = ((const LAS int*)(misc + MS_RB))[u.e] + u.mt * 256;
        u.boff = (unsigned)u.e * (unsigned)bstride + (unsigned)u.pn * 256u * (unsigned)RB; return true;
    }
    __device__ __forceinline__ int row(const Unit& u, int r) const {
        if (GATHER) {
            const int rr = r < u.rows ? r : u.rows - 1;
            if (u.e == NEXP) return tok0 + u.mt * 256 + rr;
            return list[(size_t)u.e * NTOK + u.mt * 256 + rr];
        } else return u.hrow0 + r;
    }
    __device__ __forceinline__ int nrows(const Unit& u) const { return u.rows; }
    __device__ __forceinline__ const void* Bbase() const { return Bt; }
};

struct EpiZ {
    static constexpr int PERM = 1; static constexpr int wscale = INPROJ_F8 ? 121 : 127, ascale = 127;
    bf16_t* O; int ldc;
    template <class U> __device__ __forceinline__ void operator()(const f32x4 (&acc)[2][2][4][2], const U& u, int wr, int wc, int fr, int fq) const {
        const int row0 = u.m0 + wr * 64 + fr, col0 = u.pn * 256 + wc * 32 + 8 * fq;
#pragma unroll
        for (int ai = 0; ai < 2; ++ai)
#pragma unroll
            for (int m = 0; m < 4; ++m) { bf16_t* rowp = O + (size_t)(row0 + ai * 128 + m * 16) * ldc + col0;
#pragma unroll
                for (int bj = 0; bj < 2; ++bj) { const f32x4 v0 = acc[ai][bj][m][0], v1 = acc[ai][bj][m][1];
                    u32x4 w; w.x = cvt_pk_bf16(v0[0], v0[1]); w.y = cvt_pk_bf16(v0[2], v0[3]); w.z = cvt_pk_bf16(v1[0], v1[1]); w.w = cvt_pk_bf16(v1[2], v1[3]);
                    *(u32x4*)(rowp + bj * 128) = w; } }
    }
};
struct EpiOut {
    static constexpr int PERM = 1; static constexpr int wscale = 121, ascale = 123;
    bf16_t* X; const float* gctx; const float* gx; bf16_t* Xo;
    template <class U> __device__ __forceinline__ void operator()(const f32x4 (&acc)[2][2][4][2], const U& u, int wr, int wc, int fr, int fq) const {
        const int row0 = u.m0 + wr * 64 + fr, col0 = u.pn * 256 + wc * 32 + 8 * fq;
        const float* g = (u.m0 < NCTX) ? gctx : gx;
        f32x4 gv[2][2];
#pragma unroll
        for (int bj = 0; bj < 2; ++bj)
#pragma unroll
            for (int n = 0; n < 2; ++n) gv[bj][n] = *(const f32x4*)(g + col0 + bj * 128 + n * 4);
#pragma unroll
        for (int ai = 0; ai < 2; ++ai)
#pragma unroll
            for (int m = 0; m < 4; ++m) { const size_t ro = (size_t)(row0 + ai * 128 + m * 16) * DM + col0; const bf16_t* rowp = X + ro; bf16_t* rowo = Xo + ro;
#pragma unroll
                for (int bj = 0; bj < 2; ++bj) { const u32x4 b = *(const u32x4*)(rowp + bj * 128);
                    const f32x4 v0 = (f32x4){bflo(b.x), bfhi(b.x), bflo(b.y), bfhi(b.y)} + gv[bj][0] * acc[ai][bj][m][0], v1 = (f32x4){bflo(b.z), bfhi(b.z), bflo(b.w), bfhi(b.w)} + gv[bj][1] * acc[ai][bj][m][1];
                    u32x4 w; w.x = cvt_pk_bf16(v0[0], v0[1]); w.y = cvt_pk_bf16(v0[2], v0[3]); w.z = cvt_pk_bf16(v1[0], v1[1]); w.w = cvt_pk_bf16(v1[2], v1[3]);
                    *(u32x4*)(rowo + bj * 128) = w; } }
    }
};
struct EpiUp {
    static constexpr int PERM = 2; static constexpr int wscale = 121, ascale = 127;
    unsigned char* H; int nostore;
    template <class U> __device__ __forceinline__ void operator()(const f32x4 (&acc)[2][2][4][2], const U& u, int wr, int wc, int fr, int fq) const {
        if (nostore) return;
        const int r0 = wr * 64 + fr, col0 = u.pn * 128 + wc * 32 + 8 * fq;
#pragma unroll
        for (int ai = 0; ai < 2; ++ai)
#pragma unroll
            for (int m = 0; m < 4; ++m) { const int r = r0 + ai * 128 + m * 16;
                if (r < u.rows) { u32x2 w;
                    { const f32x4 g = acc[ai][0][m][0], up = acc[ai][0][m][1]; w.x = cvt4_fp8(silu_f(g[0]) * up[0], silu_f(g[1]) * up[1], silu_f(g[2]) * up[2], silu_f(g[3]) * up[3]); }
                    { const f32x4 g = acc[ai][1][m][0], up = acc[ai][1][m][1]; w.y = cvt4_fp8(silu_f(g[0]) * up[0], silu_f(g[1]) * up[1], silu_f(g[2]) * up[2], silu_f(g[3]) * up[3]); }
                    *(u32x2*)(H + (size_t)(u.hrow0 + r) * EH + col0) = w; } }
    }
};
struct EpiDown {
    static constexpr int PERM = 2; static constexpr int wscale = 122, ascale = 127;
    unsigned char* Y; int nostore;
    template <class U> __device__ __forceinline__ void operator()(const f32x4 (&acc)[2][2][4][2], const U& u, int wr, int wc, int fr, int fq) const {
        const int r0 = wr * 64 + fr, col0 = u.pn * 256 + wc * 64 + 16 * fq;
#pragma unroll
        for (int ai = 0; ai < 2; ++ai)
#pragma unroll
            for (int m = 0; m < 4; ++m) { const int r = r0 + ai * 128 + m * 16;
                if (r < u.rows && !nostore) { u32x4 w;
                    w.x = cvt4_fp8(acc[ai][0][m][0][0], acc[ai][0][m][0][1], acc[ai][0][m][0][2], acc[ai][0][m][0][3]); w.y = cvt4_fp8(acc[ai][0][m][1][0], acc[ai][0][m][1][1], acc[ai][0][m][1][2], acc[ai][0][m][1][3]);
                    w.z = cvt4_fp8(acc[ai][1][m][0][0], acc[ai][1][m][0][1], acc[ai][1][m][0][2], acc[ai][1][m][0][3]); w.w = cvt4_fp8(acc[ai][1][m][1][0], acc[ai][1][m][1][1], acc[ai][1][m][1][2], acc[ai][1][m][1][3]);
                    *(u32x4*)(Y + (size_t)(u.hrow0 + r) * DM + col0) = w; } }
    }
};

__device__ __forceinline__ void moe_tables(const Frame& F_, const unsigned* cnt_g, int ntok) {
    LOCAL_FRAME(F, F_);
    LAS unsigned char* misc = F.lds + LDS_STAGE;
    LAS int* cntS = (LAS int*)(misc + MS_CNT); LAS int* rbS = (LAS int*)(misc + MS_RB);
    LAS short* te = (LAS short*)(misc + MS_TE); LAS short* tm = (LAS short*)(misc + MS_TM);
    __syncthreads();
    if (F.tid < 64) {
        const int c = (int)cnt_g[F.tid]; const int nt = (c + 255) >> 8;
        int inc = nt;
#pragma unroll
        for (int o = 1; o < 64; o <<= 1) { const int v = __shfl_up(inc, o, 64); if (F.lane >= o) inc += v; }
        const int first = inc - nt;
        cntS[F.tid] = c; rbS[F.tid] = first * 256;
        for (int m = 0; m < nt; ++m) { te[first + m] = (short)F.tid; tm[first + m] = (short)m; }
        if (F.tid == 63) { const int nts = (ntok + 255) >> 8; cntS[NEXP] = ntok; rbS[NEXP] = inc * 256; rbS[NEXP + 1] = (inc + nts) * 256; *(LAS int*)(misc + MS_NT) = inc + nts;
            for (int m = 0; m < nts; ++m) { te[inc + m] = (short)NEXP; tm[inc + m] = (short)m; } }
    }
    __syncthreads();
}
namespace attn {
constexpr int NW = 8, QBLK = 32, KVBLK = 64;
constexpr float THR = 8.f;
constexpr int SHM_V = KVBLK * 128 * 2, SHM_K = KVBLK * 128 * 2;
constexpr int OFF_K = 2 * SHM_V, OFF_WS = 2 * SHM_V + 2 * SHM_K, LDS_ATTN = OFF_WS + NW * 64 * 4;
#define KSWZ128(row, colB) ((row) * 256 + ((colB) ^ (((row) & 7) << 4)))
#define KSWZ64(row, colB)  ((row) * 128 + ((colB) ^ ((((row) >> 1) & 7) << 4)))
#define SBAR() __builtin_amdgcn_sched_barrier(0)
__device__ __forceinline__ int crow(int r, int hi) { return (r & 3) + 8 * (r >> 2) + 4 * hi; }

template <int DQK>
__device__ __forceinline__ void partialSM(f32x16& p0, f32x16& p1, float& m_reg, float& mn, float& alpha) {
    constexpr float SCALE = (DQK == 128) ? 0.088388347648318440f : 0.125f;
    constexpr float C = SCALE * 1.4426950408889634f;
    float pmax = p0[0];
#pragma unroll
    for (int r = 1; r < 16; ++r) pmax = fmaxf(pmax, p0[r]);
#pragma unroll
    for (int r = 0; r < 16; ++r) pmax = fmaxf(pmax, p1[r]);
    { auto rr = __builtin_amdgcn_permlane32_swap(__float_as_uint(pmax), __float_as_uint(pmax), false, false);
      pmax = fmaxf(__uint_as_float(rr[0]), __uint_as_float(rr[1])); }
    if (__builtin_expect(__all(pmax - m_reg <= THR / SCALE), 1)) { mn = m_reg; alpha = 1.f; }
    else { mn = fmaxf(m_reg, pmax); alpha = __builtin_amdgcn_exp2f((m_reg - mn) * C); m_reg = mn; }
    const float mnC = -mn * C;
#pragma unroll
    for (int r = 0; r < 16; ++r) p0[r] = fmaf(p0[r], C, mnC);
#pragma unroll
    for (int r = 0; r < 16; ++r) p1[r] = fmaf(p1[r], C, mnC);
#pragma unroll
    for (int r = 0; r < 16; ++r) p0[r] = __builtin_amdgcn_exp2f(p0[r]);
}
template <bool FIRST>
__device__ __forceinline__ void partialSM_f8(f32x16& p0, f32x16& p1, float& M, float& alpha, f32x16& cinit) {
    constexpr float THR2 = THR * 1.4426950408889634f;
    float pmax;
#define MAX3(d, a, b, c) asm("v_max3_f32 %0, %1, %2, %3" : "=v"(d) : "v"(a), "v"(b), "v"(c))
    { float t0, t1, t2, t3, t4, t5, t6, t7, t8, t9, u0, u1, u2, u3;
      MAX3(t0, p0[0], p0[1], p0[2]); MAX3(t1, p0[3], p0[4], p0[5]); MAX3(t2, p0[6], p0[7], p0[8]); MAX3(t3, p0[9], p0[10], p0[11]); MAX3(t4, p0[12], p0[13], p0[14]);
      MAX3(t5, p1[0], p1[1], p1[2]); MAX3(t6, p1[3], p1[4], p1[5]); MAX3(t7, p1[6], p1[7], p1[8]); MAX3(t8, p1[9], p1[10], p1[11]); MAX3(t9, p1[12], p1[13], p1[14]);
      MAX3(u0, t0, t1, t2); MAX3(u1, t3, t4, t5); MAX3(u2, t6, t7, t8); MAX3(u3, t9, p0[15], p1[15]);
      float w0; MAX3(w0, u0, u1, u2); asm("v_max_f32 %0, %1, %2" : "=v"(pmax) : "v"(w0), "v"(u3)); }
#undef MAX3
    { auto rr = __builtin_amdgcn_permlane32_swap(__float_as_uint(pmax), __float_as_uint(pmax), false, false);
      pmax = fmaxf(__uint_as_float(rr[0]), __uint_as_float(rr[1])); }
    if (!FIRST && __builtin_expect(__all(pmax <= THR2), 1)) { alpha = 1.f; }
    else { const float d = FIRST ? pmax : fmaxf(pmax, 0.f); alpha = FIRST ? 1.f : __builtin_amdgcn_exp2f(-d); M += d;
#pragma unroll
        for (int r = 0; r < 16; ++r) { p0[r] -= d; p1[r] -= d; cinit[r] = -M; } }
#pragma unroll
    for (int r = 0; r < 16; ++r) p0[r] = __builtin_amdgcn_exp2f(p0[r]);
}
__device__ __forceinline__ void finishSM(f32x16& p0, f32x16& p1, float alpha, float& l_reg, bf16x8& pa0, bf16x8& pa1, bf16x8& pa2, bf16x8& pa3) {
#pragma unroll
    for (int r = 0; r < 16; ++r) p1[r] = __builtin_amdgcn_exp2f(p1[r]);
    float ps = 0;
#pragma unroll
    for (int r = 0; r < 16; ++r) ps += p0[r];
#pragma unroll
    for (int r = 0; r < 16; ++r) ps += p1[r];
    { auto rr = __builtin_amdgcn_permlane32_swap(__float_as_uint(ps), __float_as_uint(ps), false, false);
      ps = __uint_as_float(rr[0]) + __uint_as_float(rr[1]); }
    l_reg = l_reg * alpha + ps;
#define PK4(P, BASE, OUT) do { unsigned a0 = cvt_pk_bf16(P[BASE + 0], P[BASE + 1]), a1 = cvt_pk_bf16(P[BASE + 2], P[BASE + 3]);   \
    unsigned b0 = cvt_pk_bf16(P[BASE + 4], P[BASE + 5]), b1 = cvt_pk_bf16(P[BASE + 6], P[BASE + 7]);                              \
    auto r0 = __builtin_amdgcn_permlane32_swap(a0, b0, false, false); auto r1 = __builtin_amdgcn_permlane32_swap(a1, b1, false, false); \
    u32x4 w = {r0[0], r1[0], r0[1], r1[1]}; OUT = *reinterpret_cast<bf16x8*>(&w); } while (0)
    PK4(p0, 0, pa0); PK4(p0, 8, pa1); PK4(p1, 0, pa2); PK4(p1, 8, pa3);
#undef PK4
}
template <int DQK>
__device__ __forceinline__ void qkt(f32x16& p0, f32x16& p1, const char* Ks, const bf16x8* qr, int r32, int hi) {
    p0 = f32x16{}; p1 = f32x16{};
#pragma unroll
    for (int d0 = 0; d0 < DQK / 16; ++d0) { const int cb = (d0 * 16 + hi * 8) * 2;
        bf16x8 b0, b1;
        if (DQK == 128) { b0 = *reinterpret_cast<const bf16x8*>(Ks + KSWZ128(r32, cb)); b1 = *reinterpret_cast<const bf16x8*>(Ks + KSWZ128(32 + r32, cb)); }
        else            { b0 = *reinterpret_cast<const bf16x8*>(Ks + KSWZ64(r32, cb));  b1 = *reinterpret_cast<const bf16x8*>(Ks + KSWZ64(32 + r32, cb)); }
        p0 = __builtin_amdgcn_mfma_f32_32x32x16_bf16(b0, qr[d0], p0, 0, 0, 0);
        p1 = __builtin_amdgcn_mfma_f32_32x32x16_bf16(b1, qr[d0], p1, 0, 0, 0); }
}
#define KSWZ32(row, colB)  ((row) * 64 + ((colB) ^ ((((row) >> 2) & 3) << 4)))
template <int D8>
__device__ __forceinline__ void qkt_f8(f32x16& p0, f32x16& p1, const char* Ks, const i32x8* qf, int r32, int hi, const f32x16& cinit) {
    constexpr int NS = D8 / 64;
    int one = 127, qsc = 124; asm volatile("" : "+v"(one), "+v"(qsc));
#define QF8_K(row, cb) ((D8 == 128) ? KSWZ64(row, cb) : KSWZ32(row, cb))
#define QF8_FRAGS(s) const int cb = 64 * (s) + 32 * hi; \
      const i32x4 a0 = *reinterpret_cast<const i32x4*>(Ks + QF8_K(r32, cb)), a1 = *reinterpret_cast<const i32x4*>(Ks + QF8_K(r32, cb + 16)); \
      const i32x4 c0 = *reinterpret_cast<const i32x4*>(Ks + QF8_K(32 + r32, cb)), c1 = *reinterpret_cast<const i32x4*>(Ks + QF8_K(32 + r32, cb + 16)); \
      const i32x8 b0 = __builtin_shufflevector(a0, a1, 0, 1, 2, 3, 4, 5, 6, 7), b1 = __builtin_shufflevector(c0, c1, 0, 1, 2, 3, 4, 5, 6, 7)
    if (NS == 2) {
        { QF8_FRAGS(0);
          asm volatile("s_nop 1\n\tv_mfma_scale_f32_32x32x64_f8f6f4 %0, %1, %2, %3, %4, %5 op_sel_hi:[0,0,0]\n\ts_nop 3" : "=&v"(p0) : "v"(b0), "v"(qf[0]), "v"(cinit), "v"(one), "v"(qsc));
          asm volatile("s_nop 1\n\tv_mfma_scale_f32_32x32x64_f8f6f4 %0, %1, %2, %3, %4, %5 op_sel_hi:[0,0,0]\n\ts_nop 3" : "=&v"(p1) : "v"(b1), "v"(qf[0]), "v"(cinit), "v"(one), "v"(qsc)); }
        { QF8_FRAGS(1);
          asm volatile("s_nop 1\n\tv_mfma_scale_f32_32x32x64_f8f6f4 %0, %1, %2, %0, %3, %4 op_sel_hi:[0,0,0]\n\ts_nop 3" : "+v"(p0) : "v"(b0), "v"(qf[1]), "v"(one), "v"(qsc));
          asm volatile("s_nop 1\n\tv_mfma_scale_f32_32x32x64_f8f6f4 %0, %2, %3, %0, %4, %5 op_sel_hi:[0,0,0]\n\ts_nop 15\n\ts_nop 7" : "+v"(p1), "+v"(p0) : "v"(b1), "v"(qf[1]), "v"(one), "v"(qsc), "v"(cinit)); }
    } else {
        QF8_FRAGS(0);
        asm volatile("s_nop 1\n\tv_mfma_scale_f32_32x32x64_f8f6f4 %0, %1, %2, %3, %4, %5 op_sel_hi:[0,0,0]\n\ts_nop 3" : "=&v"(p0) : "v"(b0), "v"(qf[0]), "v"(cinit), "v"(one), "v"(qsc));
        asm volatile("s_nop 1\n\tv_mfma_scale_f32_32x32x64_f8f6f4 %0, %2, %3, %4, %5, %6 op_sel_hi:[0,0,0]\n\ts_nop 15\n\ts_nop 7" : "=&v"(p1), "+v"(p0) : "v"(b1), "v"(qf[0]), "v"(cinit), "v"(one), "v"(qsc));
    }
#undef QF8_FRAGS
#undef QF8_K
}
__device__ __forceinline__ int v_st(int k, int c) { const int kk = (k & ~0xC) | ((k & 4) << 1) | ((k & 8) >> 1); return ((kk >> 3) * 4 + (c >> 5)) * 512 + ((kk & 7) * 32 + (c & 31)) * 2; }
__device__ __forceinline__ int v_rd_base(int lane) { return ((lane & 3) << 3) | (((lane >> 2) & 3) << 6) | (((lane >> 4) & 1) << 5) | (((lane >> 5) & 1) << 8); }
constexpr int v_rd_off(int d0, int ks, int half) { return d0 * 512 + ks * 4096 + half * 2048; }
template <int OFF> __device__ __forceinline__ s16x4 tr_read(int vb) {
    s16x4 r; asm volatile("ds_read_b64_tr_b16 %0, %1 offset:%2" : "=&v"(r) : "v"(vb), "i"(OFF) : "memory"); return r;
}
template <int D0> __device__ __forceinline__ void pv_one(f32x16& od, int vb, bf16x8 pa0, bf16x8 pa1, bf16x8 pa2, bf16x8 pa3) {
    const s16x4 l0 = tr_read<v_rd_off(D0, 0, 0)>(vb), h0 = tr_read<v_rd_off(D0, 0, 1)>(vb), l1 = tr_read<v_rd_off(D0, 1, 0)>(vb), h1 = tr_read<v_rd_off(D0, 1, 1)>(vb);
    const s16x4 l2 = tr_read<v_rd_off(D0, 2, 0)>(vb), h2 = tr_read<v_rd_off(D0, 2, 1)>(vb), l3 = tr_read<v_rd_off(D0, 3, 0)>(vb), h3 = tr_read<v_rd_off(D0, 3, 1)>(vb);
    asm volatile("s_waitcnt lgkmcnt(0)" ::: "memory"); SBAR();
#define PK(L, H) (bf16x8){L[0], L[1], L[2], L[3], H[0], H[1], H[2], H[3]}
    od = __builtin_amdgcn_mfma_f32_32x32x16_bf16(pa0, PK(l0, h0), od, 0, 0, 0);
    od = __builtin_amdgcn_mfma_f32_32x32x16_bf16(pa1, PK(l1, h1), od, 0, 0, 0);
    od = __builtin_amdgcn_mfma_f32_32x32x16_bf16(pa2, PK(l2, h2), od, 0, 0, 0);
    od = __builtin_amdgcn_mfma_f32_32x32x16_bf16(pa3, PK(l3, h3), od, 0, 0, 0);
#undef PK
}
__device__ __forceinline__ void pv_d0(f32x16* o, int vb, bf16x8 pa0, bf16x8 pa1, bf16x8 pa2, bf16x8 pa3) {
    pv_one<0>(o[0], vb, pa0, pa1, pa2, pa3); pv_one<1>(o[1], vb, pa0, pa1, pa2, pa3); pv_one<2>(o[2], vb, pa0, pa1, pa2, pa3); pv_one<3>(o[3], vb, pa0, pa1, pa2, pa3);
}

struct OutArgs { unsigned char* mix; float* scr; float lam; float osc; const float* ng; };

struct BgArgs { WConv* c; const Args* a; unsigned char* ws; LAS unsigned char* ldsl; };
template <int DQK, int MODE, int BGL, int F8D = 0>
__device__ __forceinline__ void body(const bf16_t* __restrict__ Qb, const bf16_t* __restrict__ Kh, const bf16_t* __restrict__ Vh, int seq, char* lds, const OutArgs oa, const BgArgs bg) {
    constexpr bool F8 = F8D != 0; constexpr int NS8 = F8 ? F8D / 64 : 1;
    constexpr int ND = DQK / 16; constexpr int DSC = F8 ? F8D : DQK; constexpr int KSTR = F8 ? QK8_ROW : ZW * 2;
    int tz0 = threadIdx.x; asm volatile("" : "+v"(tz0));
    const int tid = tz0, wid = tid >> 6, lane = tid & 63, r32 = lane & 31, hi = lane >> 5;
    __syncthreads();
    char* V_lds = lds; char* K_lds = lds + OFF_K;
    float* ws = (float*)(lds + OFF_WS) + wid * 64; float* li_l = ws; float* al_l = ws + 32;
    float m_reg = F8 ? 0.f : -1e30f, l_reg = 0; f32x16 o[4] = {}; bf16x8 qr[F8 ? 1 : ND]; i32x8 qf[2]; f32x16 cinit = {};
    if (F8) { const unsigned char* Qw8 = (const unsigned char*)Qb + (size_t)(wid * QBLK + r32) * QK8_ROW + hi * 32;
#pragma unroll
        for (int s = 0; s < NS8; ++s) { const i32x4 lo = *reinterpret_cast<const i32x4*>(Qw8 + s * 64), hh = *reinterpret_cast<const i32x4*>(Qw8 + s * 64 + 16); qf[s] = __builtin_shufflevector(lo, hh, 0, 1, 2, 3, 4, 5, 6, 7); } }
    else { const bf16_t* Qw = Qb + (size_t)(wid * QBLK + r32) * ZW + hi * 8;
#pragma unroll
        for (int d0 = 0; d0 < ND; ++d0) qr[d0] = *reinterpret_cast<const bf16x8*>(Qw + d0 * 16); }
    const int sr = tid >> 4, sc = (tid & 15) * 8, vst0 = v_st(sr, sc), vst1 = v_st(32 + sr, sc);
    const int kr64 = (F8D == 64) ? ((tid & 255) >> 2) : (tid >> 3), kc64 = (F8D == 64) ? (tid & 3) * 8 : (tid & 7) * 8;
    const int vb0 = (int)(uintptr_t)V_lds + v_rd_base(lane);
#ifndef WC_MODE
#define WC_MODE 0
#endif
    constexpr int SD = (BGL >= 0 && WC_MODE != 1) ? 1 : 2;
    struct { bf16x8 vs0, vs1, ks0, ks1; } sr_[SD];
    const unsigned voffS = (unsigned)(sr * ZW + sc) * 2u, voffK64 = (unsigned)(kr64 * KSTR) + (unsigned)kc64 * 2u;
    __amdgpu_buffer_rsrc_t rsK, rsV;
    { const uintptr_t pk = (uintptr_t)Kh, pv = (uintptr_t)Vh;
      const unsigned kl = __builtin_amdgcn_readfirstlane((unsigned)pk), kh = __builtin_amdgcn_readfirstlane((unsigned)(pk >> 32));
      const unsigned vl = __builtin_amdgcn_readfirstlane((unsigned)pv), vh = __builtin_amdgcn_readfirstlane((unsigned)(pv >> 32));
      rsK = __builtin_amdgcn_make_buffer_rsrc((void*)(((uintptr_t)kh << 32) | kl), 0, NTOK * ZW * 2, 0x00020000);
      rsV = __builtin_amdgcn_make_buffer_rsrc((void*)(((uintptr_t)vh << 32) | vl), 0, NTOK * ZW * 2, 0x00020000); }
#define BLD(rs, vo, so) ({ u32x4 t_ = __builtin_amdgcn_raw_buffer_load_b128(rs, vo, so, 0); *reinterpret_cast<bf16x8*>(&t_); })
#define SLOAD(i, k0) do { const int so_ = (k0) * (ZW * 2); \
    sr_[i].vs0 = BLD(rsV, voffS, so_); sr_[i].vs1 = BLD(rsV, voffS, so_ + 32 * ZW * 2); \
    if (DQK == 128) { sr_[i].ks0 = BLD(rsK, voffS, so_); sr_[i].ks1 = BLD(rsK, voffS, so_ + 32 * ZW * 2); } \
    else { sr_[i].ks0 = BLD(rsK, voffK64, (k0) * KSTR); } } while (0)
#define SWRITE(b, i) do { *(bf16x8*)(V_lds + (b) * SHM_V + vst0) = sr_[i].vs0; *(bf16x8*)(V_lds + (b) * SHM_V + vst1) = sr_[i].vs1; \
    if (DQK == 128) { const int kc = sc * 2; *(bf16x8*)(K_lds + (b) * SHM_K + KSWZ128(sr, kc)) = sr_[i].ks0; *(bf16x8*)(K_lds + (b) * SHM_K + KSWZ128(32 + sr, kc)) = sr_[i].ks1; } \
    else if (F8D == 64) { if (tid < 256) *(bf16x8*)(K_lds + (b) * SHM_K + KSWZ32(kr64, kc64 * 2)) = sr_[i].ks0; } \
    else { *(bf16x8*)(K_lds + (b) * SHM_K + KSWZ64(kr64, kc64 * 2)) = sr_[i].ks0; } } while (0)
#define SWAIT() do { if (SD == 2) { if (DQK == 128) asm volatile("s_waitcnt vmcnt(4)" ::: "memory"); else asm volatile("s_waitcnt vmcnt(3)" ::: "memory"); } \
    else if (BGL >= 0 && WC_MODE == 0) asm volatile("s_waitcnt vmcnt(2)" ::: "memory"); else asm volatile("s_waitcnt vmcnt(0)" ::: "memory"); } while (0)
#define BGSTEP(X) do { } while (0)
#define QKT(P0, P1, KL, FIRST) do { if (F8) qkt_f8<F8 ? F8D : 128>(P0, P1, KL, qf, r32, hi, cinit); else qkt<DQK>(P0, P1, KL, qr, r32, hi); } while (0)
#define PSM(P0, P1, MN, AL, FIRST) do { if (F8) partialSM_f8<FIRST>(P0, P1, m_reg, AL, cinit); else partialSM<DSC>(P0, P1, m_reg, MN, AL); } while (0)
#define RESC(a) do { if (__any((a) < 1.f)) { if (hi == 0) al_l[r32] = (a); asm volatile("s_waitcnt lgkmcnt(0)" ::: "memory"); \
    _Pragma("unroll") for (int d = 0; d < 4; ++d) _Pragma("unroll") for (int r = 0; r < 16; ++r) o[d][r] *= al_l[crow(r, hi)]; } } while (0)
    f32x16 pA0, pA1, pB0, pB1; float mnA, mnB, alA, alB; bf16x8 pa0, pa1, pa2, pa3; const int NT = seq / KVBLK;
    constexpr int SE = 0, SO = SD - 1;
    SLOAD(SE, 0); asm volatile("s_waitcnt vmcnt(0)" ::: "memory"); SWRITE(0, SE); __syncthreads();
    QKT(pA0, pA1, K_lds, true); PSM(pA0, pA1, mnA, alA, true);
    SLOAD(SO, KVBLK); if (SD == 2) { if (2 < NT) SLOAD(SE, 2 * KVBLK); }
    SWAIT(); SWRITE(1, SO); __syncthreads();
    for (int j = 1; j + 1 < NT; j += 2) {
        SBAR(); QKT(pB0, pB1, K_lds + SHM_K, false);
        finishSM(pA0, pA1, alA, l_reg, pa0, pa1, pa2, pa3); SBAR();
        SLOAD(SO, (j + SD) * KVBLK); BGSTEP(0); SBAR();
        pv_d0(o, vb0, pa0, pa1, pa2, pa3); PSM(pB0, pB1, mnB, alB, false);
        __syncthreads(); SWAIT(); SWRITE(0, SE);
        RESC(alB); __syncthreads();
        SBAR(); QKT(pA0, pA1, K_lds, false);
        finishSM(pB0, pB1, alB, l_reg, pa0, pa1, pa2, pa3); SBAR();
        if (SD == 1 || j + 3 < NT) SLOAD(SE, (j + 1 + SD) * KVBLK); BGSTEP(1); SBAR();
        pv_d0(o, vb0 + SHM_V, pa0, pa1, pa2, pa3); PSM(pA0, pA1, mnA, alA, false);
        __syncthreads(); SWAIT(); SWRITE(1, SO);
        RESC(alA); __syncthreads();
    }
    SBAR(); QKT(pB0, pB1, K_lds + SHM_K, false);
    finishSM(pA0, pA1, alA, l_reg, pa0, pa1, pa2, pa3); SBAR();
    pv_d0(o, vb0, pa0, pa1, pa2, pa3); PSM(pB0, pB1, mnB, alB, false);
    __syncthreads(); RESC(alB);
    finishSM(pB0, pB1, alB, l_reg, pa0, pa1, pa2, pa3); SBAR();
    pv_d0(o, vb0 + SHM_V, pa0, pa1, pa2, pa3);
    if (hi == 0) li_l[r32] = l_reg; asm volatile("s_waitcnt lgkmcnt(0)" ::: "memory");
    float rli[16];
#pragma unroll
    for (int r = 0; r < 16; ++r) rli[r] = __builtin_amdgcn_rcpf(li_l[crow(r, hi)]);
    int tz = threadIdx.x; asm volatile("" : "+v"(tz));
    const int tid_e = tz, wid_e = tz >> 6, r32_e = tz & 31, hi_e = (tz >> 5) & 1;
#define tid tid_e
#define wid wid_e
#define r32 r32_e
#define hi hi_e
    if (MODE == 0) {
        unsigned char* Ow = oa.mix + (size_t)(wid * QBLK) * DM;
#pragma unroll
        for (int r = 0; r < 16; ++r) { const int orow = crow(r, hi);
#pragma unroll
            for (int d0 = 0; d0 < 4; ++d0) Ow[(size_t)orow * DM + d0 * 32 + r32] = f2fp8_x16(o[d0][r] * rli[r]); }
    } else if (MODE == 1) {
#pragma unroll
        for (int r = 0; r < 16; ++r)
#pragma unroll
            for (int d0 = 0; d0 < 4; ++d0) oa.scr[(r * 4 + d0) * 512 + tid] = o[d0][r] * rli[r];
    } else {
        unsigned char* Ow = oa.mix + (size_t)(wid * QBLK) * DM;
        float gn[4];
#pragma unroll
        for (int d0 = 0; d0 < 4; ++d0) gn[d0] = oa.ng[d0 * 32 + r32] * oa.osc;
#pragma unroll
        for (int r = 0; r < 16; ++r) { const int orow = crow(r, hi); float v[4]; float ss = 0.f;
#pragma unroll
            for (int d0 = 0; d0 < 4; ++d0) { v[d0] = oa.scr[(r * 4 + d0) * 512 + tid] - oa.lam * (o[d0][r] * rli[r]); ss += v[d0] * v[d0]; }
#pragma unroll
            for (int s = 16; s >= 1; s >>= 1) ss += __shfl_xor(ss, s, 64);
            const float rs = rsqrtf(ss * (1.f / 128.f) + NORM_EPS);
#pragma unroll
            for (int d0 = 0; d0 < 4; ++d0) Ow[(size_t)orow * DM + d0 * 32 + r32] = f2fp8_x16(v[d0] * rs * gn[d0]); }
    }
#undef tid
#undef wid
#undef r32
#undef hi
    asm volatile("s_waitcnt vmcnt(0) lgkmcnt(0)" ::: "memory");
    __syncthreads();
#undef SLOAD
#undef BGSTEP
#undef QKT
#undef PSM
#undef BLD
#undef SWRITE
#undef SWAIT
#undef RESC
}
}
__device__ __forceinline__ void mod_gemv(const Frame& F_, const float* c, const float* cctx, const float* wmod, const float* bmod, float* mod, int lo, int hi, int rank, int nranks) {
    LOCAL_FRAME(F, F_);
    LAS float* sx = (LAS float*)F.lds;
    LAS float* sc = sx + DM;
    LAS float* red = sc + DM;
    __syncthreads();
    for (int i = F.tid; i < DM; i += NTHREADS) { const float a = c[i], b = cctx[i]; sx[i] = a / (1.f + expf(-a)); sc[i] = b / (1.f + expf(-b)); }
    __syncthreads();
    for (int item = lo + rank; item < hi; item += nranks) {
        const int l = item >> 7, col0 = (item & 127) * 96;
        const float* W = wmod + (size_t)l * DM * (6 * DM) + col0;
        const int c4 = F.tid % 24, rg = F.tid / 24;
        if (rg < 21) {
            f32x4 ax = {0.f, 0.f, 0.f, 0.f}, ac = {0.f, 0.f, 0.f, 0.f};
            for (int d0 = rg; d0 < DM; d0 += 21 * 7) {
                f32x4 w[7];
#pragma unroll
                for (int u = 0; u < 7; ++u) { const int d = d0 + 21 * u; w[u] = (d < DM) ? *(const f32x4*)(W + (size_t)d * (6 * DM) + c4 * 4) : (f32x4){0.f, 0.f, 0.f, 0.f}; }
#pragma unroll
                for (int u = 0; u < 7; ++u) { const int d = d0 + 21 * u; if (d < DM) { ax += sx[d] * w[u]; ac += sc[d] * w[u]; } }
            }
#pragma unroll
            for (int j = 0; j < 4; ++j) { red[(rg * 2 + 0) * 96 + c4 * 4 + j] = ac[j]; red[(rg * 2 + 1) * 96 + c4 * 4 + j] = ax[j]; }
        }
        __syncthreads();
        if (F.tid < 192) { const int w = F.tid / 96, col = F.tid % 96; float s = 0.f;
            for (int r = 0; r < 21; ++r) s += red[(r * 2 + w) * 96 + col];
            mod[((size_t)l * 2 + w) * (6 * DM) + col0 + col] = s + bmod[(size_t)l * 6 * DM + col0 + col]; }
        __syncthreads();
    }
}
__device__ __forceinline__ void small_tables(const Frame& F_, float* rope, const float* rw, float* rwT) {
    LOCAL_FRAME(F, F_);
    for (int i = F.bid * NTHREADS + F.tid; i < 128 * 32 + 128 * 16; i += F.G * NTHREADS) {
        if (i < 128 * 32) { const int pos = i >> 5, j = i & 31; const float inv = powf(10000.f, -(float)j / 32.f); const float a = (float)pos * inv; rope[i] = cosf(a); rope[128 * 32 + i] = sinf(a); }
        else { const int k = i - 128 * 32, pos = k >> 4, j = k & 15; const float inv = powf(10000.f, -(float)j / 16.f); const float a = (float)pos * inv; rope[2 * 128 * 32 + k] = cosf(a); rope[2 * 128 * 32 + 128 * 16 + k] = sinf(a); }
    }
    bf16_t* rh = (bf16_t*)rwT;
    for (int i = F.bid * NTHREADS + F.tid; i < 2 * DM * NEXP; i += F.G * NTHREADS) { const int l = i / (DM * NEXP), r = i % (DM * NEXP), d = r / NEXP, e = r % NEXP;
        const float w = rw[i]; const bf16_t hi = f2bf(w); rh[((size_t)(l * 2 + 0) * NEXP + e) * DM + d] = hi; rh[((size_t)(l * 2 + 1) * NEXP + e) * DM + d] = f2bf(w - bf2f(hi)); }
}
struct CvtTile { const float* src0; const float* src1; unsigned char* dst; int ld, dstrb  ; float scale; int ilv, f8; };
__device__ __forceinline__ void cvt_decode(int idx, const Args& a, unsigned char* ws, CvtTile& t) {
    constexpr int N_IN = 76 * 16, N_OUT = 32 * 16, N_GU = 65 * 16 * 16, N_DN = 65 * 32 * 4, PER_L = N_IN + N_OUT;
    const int l = idx / PER_L; int r = idx % PER_L;
    t.scale = 1.f; t.ilv = 0; t.f8 = 0;
    if (r < N_IN) { const int nt = r / 16, kt = r % 16; const float* W = a.in[I_WIN] + (size_t)l * DM * IN_W + (size_t)kt * 128 * IN_W;
#if INPROJ_F8
        t.ld = IN_W; t.dstrb = DM; t.f8 = 1; t.scale = 64.f; t.dst = ws + WS_BTIN + ((size_t)l * ZW + nt * 64) * DM + kt * 128;
        if (nt < 24) { t.src0 = W + nt * 64; t.src1 = t.src0 + 32; if (nt < 4) t.scale = 8.f; }
#else
        t.ld = IN_W; t.dstrb = DM * 2; t.dst = ws + WS_BTIN + (((size_t)l * ZW + nt * 64) * DM + kt * 128) * 2;
        if (nt < 24) { t.src0 = W + nt * 64; t.src1 = t.src0 + 32; if (nt < 4) t.scale = 0.125f; }
#endif
        else if (nt < 72) { t.src0 = W + nt * 64 + 32; t.src1 = t.src0 + 32; }
        else if (nt == 72) { t.src0 = W + 1536; t.src1 = nullptr; }
        else { t.src0 = nullptr; t.src1 = nullptr; }
        return; }
    r -= N_IN;
    if (r < N_OUT) { const int nt = r / 16, kt = r % 16; const float* W = a.in[I_WOUT] + (size_t)l * DM * DM + (size_t)kt * 128 * DM;
        t.ld = DM; t.dstrb = DM; t.f8 = 1; t.scale = 64.f; t.dst = ws + WS_BTOUT + ((size_t)l * DM + nt * 64) * DM + kt * 128; t.src0 = W + nt * 64; t.src1 = t.src0 + 32; return; }
    r -= N_OUT;
    if (r < N_GU) { const int e = r / 256, q = r % 256, nt = q / 16, kt = q % 16;
        const float* Wg = (e < NEXP) ? a.in[I_EWG] + ((size_t)l * NEXP + e) * DM * EH : a.in[I_SWG] + (size_t)l * DM * EH;
        const float* Wu = (e < NEXP) ? a.in[I_EWU] + ((size_t)l * NEXP + e) * DM * EH : a.in[I_SWU] + (size_t)l * DM * EH;
        t.ld = EH; t.dstrb = DM; t.ilv = 1; t.f8 = 1; t.scale = 64.f; t.dst = ws + WS_BTGU + (((size_t)l * 65 + e) * 1024 + nt * 64) * DM + kt * 128;
        t.src0 = Wg + (size_t)kt * 128 * EH + nt * 32; t.src1 = Wu + (size_t)kt * 128 * EH + nt * 32; return; }
    r -= N_GU;
    { const int e = r / 128, q = r % 128, nt = q / 4, kt = q % 4;
        const float* Wd = (e < NEXP) ? a.in[I_EWD] + ((size_t)l * NEXP + e) * EH * DM : a.in[I_SWD] + (size_t)l * EH * DM;
        t.ld = DM; t.dstrb = EH; t.f8 = 1; t.scale = 32.f; t.dst = ws + WS_BTD + (((size_t)l * 65 + e) * DM + nt * 64) * EH + kt * 128;
        t.src0 = Wd + (size_t)kt * 128 * DM + nt * 64; t.src1 = t.src0 + 32; }
}
constexpr int CVT_ITEMS = 2 * (76 * 16 + 32 * 16);
__device__ __forceinline__ void convert_weights(const Frame& F_, const Args& a, int lo, int hi, int rank, int nranks) {
    LOCAL_FRAME(F, F_);
    constexpr int TSB = 272;
    LAS unsigned char* tile = F.lds;
    const int kq = F.tid >> 4, s4 = (F.tid & 15) * 4;
    const int rs = F.tid >> 3, rk = (F.tid & 7) * 16;
    f32x4 v[2][4]; CvtTile t[2];
    __syncthreads();
    int it = lo + rank, par = 0;
#define CV_LOAD(p, T) do { const float* s_ = (s4 < 32) ? (T).src0 : (T).src1; const int so_ = (s4 < 32) ? s4 : s4 - 32; \
        _Pragma("unroll") for (int i = 0; i < 4; ++i) v[p][i] = s_ ? __builtin_nontemporal_load((const f32x4*)(s_ + (size_t)(4 * kq + i) * (T).ld + so_)) : (f32x4){0.f, 0.f, 0.f, 0.f}; } while (0)
    if (it < hi) { cvt_decode(it, a, F.ws, t[0]); CV_LOAD(0, t[0]); }
    while (it < hi) {
        const int nx = it + nranks;
        if (par == 0) { if (nx < hi) { cvt_decode(nx, a, F.ws, t[1]); CV_LOAD(1, t[1]); } }
        else          { if (nx < hi) { cvt_decode(nx, a, F.ws, t[0]); CV_LOAD(0, t[0]); } }
        LAS unsigned char* tb = tile + par * 64 * TSB;
#define CV_PROC(p) do { const float sc_ = t[p].scale; \
        const int drow_ = t[p].ilv ? ((rs < 32) ? (8 * (rs >> 2) + (rs & 3)) : (8 * ((rs - 32) >> 2) + 4 + (rs & 3))) : rs; \
        if (t[p].f8) { _Pragma("unroll") for (int j = 0; j < 4; ++j) *(LAS unsigned*)(tb + (s4 + j) * TSB + 4 * kq) = cvt4_fp8(v[p][0][j] * sc_, v[p][1][j] * sc_, v[p][2][j] * sc_, v[p][3][j] * sc_); \
            __syncthreads(); \
            *(u32x4*)(t[p].dst + (size_t)drow_ * t[p].dstrb + rk) = *(const LAS u32x4*)(tb + rs * TSB + rk); } \
        else { _Pragma("unroll") for (int j = 0; j < 4; ++j) { u32x2 w_; w_.x = cvt_pk_bf16(v[p][0][j] * sc_, v[p][1][j] * sc_); w_.y = cvt_pk_bf16(v[p][2][j] * sc_, v[p][3][j] * sc_); *(LAS u32x2*)(tb + (s4 + j) * TSB + 8 * kq) = w_; } \
            __syncthreads(); \
            const u32x4 w0_ = *(const LAS u32x4*)(tb + rs * TSB + rk * 2), w1_ = *(const LAS u32x4*)(tb + rs * TSB + rk * 2 + 16); \
            u32x4* dp_ = (u32x4*)(t[p].dst + (size_t)drow_ * t[p].dstrb + rk * 2); dp_[0] = w0_; dp_[1] = w1_; } } while (0)
        if (par == 0) CV_PROC(0); else CV_PROC(1);
        it = nx; par ^= 1;
    }
    __syncthreads();
#undef CV_LOAD
#undef CV_PROC
}

__device__ __forceinline__ void norm_mod_row(const float* xr, bf16_t* xcopy, const float* g, const float* sh, const float* sc, bf16_t* out, int lane) {
    f32x4 v[8]; float ss = 0.f;
#pragma unroll
    for (int k = 0; k < 8; ++k) { v[k] = *(const f32x4*)(xr + k * 256 + lane * 4); ss += v[k][0] * v[k][0] + v[k][1] * v[k][1] + v[k][2] * v[k][2] + v[k][3] * v[k][3]; }
    ss = wave_sum(ss);
    const float rs = rsqrtf(ss * (1.f / DM) + NORM_EPS);
#pragma unroll
    for (int k = 0; k < 8; ++k) { const int i = k * 256 + lane * 4;
        const f32x4 gg = *(const f32x4*)(g + i), s0 = *(const f32x4*)(sh + i), s1 = *(const f32x4*)(sc + i);
        const f32x4 y = v[k] * rs * gg * (s1 + 1.f) + s0;
        u32x2 w; w.x = cvt_pk_bf16(y[0], y[1]); w.y = cvt_pk_bf16(y[2], y[3]);
        *(u32x2*)(out + i) = w;
        if (xcopy) { u32x2 xw; xw.x = cvt_pk_bf16(v[k][0], v[k][1]); xw.y = cvt_pk_bf16(v[k][2], v[k][3]); *(u32x2*)(xcopy + i) = xw; } }
}
__device__ __forceinline__ void phase_norm1(const Frame& F_, const Args& a) {
    LOCAL_FRAME(F, F_);
    bf16_t* X = (bf16_t*)(F.ws + WS_X); bf16_t* A = (bf16_t*)(F.ws + WS_A); const float* mod = (const float*)(F.ws + WS_MOD);
    const int lane = F.lane, stride = F.G * 8;
    f32x4 v[8], vn[8];
    int r = F.bid * 8 + F.wave;
#define N1_SRC(r_) (((r_) < NCTX) ? a.in[I_CTX] + (size_t)(r_) * DM : a.in[I_X] + (size_t)((r_) - NCTX) * DM)
    if (r < NTOK) { const float* src = N1_SRC(r);
#pragma unroll
        for (int k = 0; k < 8; ++k) v[k] = *(const f32x4*)(src + k * 256 + lane * 4); }
    while (r < NTOK) {
        const int rn = r + stride;
        if (rn < NTOK) { const float* src = N1_SRC(rn);
#pragma unroll
            for (int k = 0; k < 8; ++k) vn[k] = *(const f32x4*)(src + k * 256 + lane * 4); }
        const float* m = mod + (size_t)(r < NCTX ? 0 : 1) * 6 * DM; const float* g = a.in[I_N1G];
        float ss = 0.f;
#pragma unroll
        for (int k = 0; k < 8; ++k) ss += v[k][0] * v[k][0] + v[k][1] * v[k][1] + v[k][2] * v[k][2] + v[k][3] * v[k][3];
        ss = wave_sum(ss);
        const float rs = rsqrtf(ss * (1.f / DM) + NORM_EPS);
#pragma unroll
        for (int k = 0; k < 8; ++k) { const int i = k * 256 + lane * 4;
            const f32x4 gg = *(const f32x4*)(g + i), s0 = *(const f32x4*)(m + i), s1 = *(const f32x4*)(m + DM + i);
            const f32x4 y = v[k] * rs * gg * (s1 + 1.f) + s0;
#if INPROJ_F8
            *(unsigned*)((unsigned char*)A + (size_t)r * DM + i) = cvt4_fp8(y[0], y[1], y[2], y[3]);
#else
            u32x2 w; w.x = cvt_pk_bf16(y[0], y[1]); w.y = cvt_pk_bf16(y[2], y[3]);
            *(u32x2*)(A + (size_t)r * DM + i) = w;
#endif
            u32x2 xw; xw.x = cvt_pk_bf16(v[k][0], v[k][1]); xw.y = cvt_pk_bf16(v[k][2], v[k][3]); *(u32x2*)(X + (size_t)r * DM + i) = xw; }
#pragma unroll
        for (int k = 0; k < 8; ++k) v[k] = vn[k];
        r = rn;
    }
#undef N1_SRC
}

__device__ __forceinline__ void qk_prep(const Frame& F_, const Args& a, int l, int dummy, int qb, int qG) {
    LOCAL_FRAME(F, F_);
    const bf16_t* Z = (const bf16_t*)(F.ws + WS_Z); bf16_t* Zo = (bf16_t*)(F.ws + (dummy ? WS_DUMMY : 0) + WS_Z);
    const float* rope = (const float*)(F.ws + WS_ROPE);
    const float* cg = rope; const float* sg = rope + 128 * 32; const float* cd = rope + 2 * 128 * 32; const float* sd = cd + 128 * 16;
    const float* qng = a.in[I_QNG] + l * 128; const float* kng = a.in[I_KNG] + l * 128;
#define QK_UNPACK(W_, X_) do { X_[0] = bflo(W_[0]); X_[1] = bfhi(W_[0]); X_[2] = bflo(W_[1]); X_[3] = bfhi(W_[1]); X_[4] = bflo(W_[2]); X_[5] = bfhi(W_[2]); X_[6] = bflo(W_[3]); X_[7] = bfhi(W_[3]); } while (0)
    { const int sub = F.tid & 7, half = sub >> 2, j0 = (sub & 3) * 8;
      for (int g0 = qb * 64; g0 < NTOK * 10; g0 += qG * 64) {
        const int g = g0 + (F.tid >> 3);
        if (g < NTOK * 10) {
            const int t = g / 10, hv = g - t * 10; const int col = ((hv < 8) ? ZC_AQ + hv * 128 : ZC_AK + (hv - 8) * 128) + half * 64 + j0;
            const float* gn = ((hv < 8) ? qng : kng) + half * 64 + j0;
            const u32x4 w1 = *(const u32x4*)(Z + (size_t)t * ZW + col), w2 = *(const u32x4*)(Z + (size_t)t * ZW + col + 32);
            const f32x4 ga = *(const f32x4*)gn, gb = *(const f32x4*)(gn + 4), gc = *(const f32x4*)(gn + 32), gd = *(const f32x4*)(gn + 36);
            const bool lat = t >= NCTX; const int p = t - NCTX, pos = lat ? (half == 0 ? (p >> 6) : (p & 63)) : 0;
            const f32x4 ca = *(const f32x4*)(cg + pos * 32 + j0), cb = *(const f32x4*)(cg + pos * 32 + j0 + 4), sa = *(const f32x4*)(sg + pos * 32 + j0), sb = *(const f32x4*)(sg + pos * 32 + j0 + 4);
            float x1[8], x2[8]; QK_UNPACK(w1, x1); QK_UNPACK(w2, x2);
            float ss = 0.f;
#pragma unroll
            for (int i = 0; i < 8; ++i) ss += x1[i] * x1[i] + x2[i] * x2[i];
            ss += __shfl_xor(ss, 1, 64); ss += __shfl_xor(ss, 2, 64); ss += __shfl_xor(ss, 4, 64);
            const float rs = rsqrtf(ss * (1.f / 128.f) + NORM_EPS);
            float o1[8], o2[8];
#pragma unroll
            for (int i = 0; i < 8; ++i) { const float g1 = (i < 4) ? ga[i & 3] : gb[i & 3], g2 = (i < 4) ? gc[i & 3] : gd[i & 3];
                const float cs = lat ? ((i < 4) ? ca[i & 3] : cb[i & 3]) : 1.f, sn = lat ? ((i < 4) ? sa[i & 3] : sb[i & 3]) : 0.f;
                const float y1 = x1[i] * rs * g1, y2 = x2[i] * rs * g2; o1[i] = y1 * cs - y2 * sn; o2[i] = y2 * cs + y1 * sn; }
            u32x4 r1, r2; r1.x = cvt_pk_bf16(o1[0], o1[1]); r1.y = cvt_pk_bf16(o1[2], o1[3]); r1.z = cvt_pk_bf16(o1[4], o1[5]); r1.w = cvt_pk_bf16(o1[6], o1[7]);
            r2.x = cvt_pk_bf16(o2[0], o2[1]); r2.y = cvt_pk_bf16(o2[2], o2[3]); r2.z = cvt_pk_bf16(o2[4], o2[5]); r2.w = cvt_pk_bf16(o2[6], o2[7]);
#if ATTN_F8
            { unsigned char* q8 = F.ws + (dummy ? WS_DUMMY : 0) + WS_QK8 + (size_t)t * QK8_ROW + hv * 128 + half * 64 + j0;
              const float qs = (hv < 8) ? 0.088388347648318440f * 1.4426950408889634f * 8.f : 1.f;
#pragma unroll
              for (int i = 0; i < 8; ++i) { o1[i] *= qs; o2[i] *= qs; }
              u32x2 w1, w2; w1.x = cvt4_fp8(o1[0], o1[1], o1[2], o1[3]); w1.y = cvt4_fp8(o1[4], o1[5], o1[6], o1[7]); w2.x = cvt4_fp8(o2[0], o2[1], o2[2], o2[3]); w2.y = cvt4_fp8(o2[4], o2[5], o2[6], o2[7]);
              *(u32x2*)q8 = w1; *(u32x2*)(q8 + 32) = w2; (void)r1; (void)r2; }
#else
            *(u32x4*)(Zo + (size_t)t * ZW + col) = r1; *(u32x4*)(Zo + (size_t)t * ZW + col + 32) = r2;
#endif
        } } }
    { const int sub = F.tid & 3, half = sub >> 1, j0 = (sub & 1) * 8;
      for (int g0 = qb * 128; g0 < NTOK * 16; g0 += qG * 128) {
        const int g = g0 + (F.tid >> 2);
        if (g < NTOK * 16) {
            const int t = g >> 4, vi = g & 15, p = t - NCTX; const bool lat = t >= NCTX; const int col = ((vi < 8) ? ZC_DQ + vi * 64 : ZC_DK + (vi - 8) * 64) + half * 32 + j0;
#if !ATTN_F8
            if (!lat) continue;
#endif
            const u32x4 w1 = *(const u32x4*)(Z + (size_t)t * ZW + col), w2 = *(const u32x4*)(Z + (size_t)t * ZW + col + 16);
            const int pos = lat ? (half == 0 ? (p >> 6) : (p & 63)) : 0;
            const f32x4 ca = *(const f32x4*)(cd + pos * 16 + j0), cb = *(const f32x4*)(cd + pos * 16 + j0 + 4), sa = *(const f32x4*)(sd + pos * 16 + j0), sb = *(const f32x4*)(sd + pos * 16 + j0 + 4);
            float x1[8], x2[8]; QK_UNPACK(w1, x1); QK_UNPACK(w2, x2);
            float o1[8], o2[8];
#pragma unroll
            for (int i = 0; i < 8; ++i) { const float cs = lat ? ((i < 4) ? ca[i & 3] : cb[i & 3]) : 1.f, sn = lat ? ((i < 4) ? sa[i & 3] : sb[i & 3]) : 0.f; o1[i] = x1[i] * cs - x2[i] * sn; o2[i] = x2[i] * cs + x1[i] * sn; }
#if ATTN_F8
            { unsigned char* q8 = F.ws + (dummy ? WS_DUMMY : 0) + WS_QK8 + (size_t)t * QK8_ROW + 1280 + vi * 64 + half * 32 + j0;
              const float qs = (vi < 8) ? 0.125f * 1.4426950408889634f * 8.f : 1.f;
#pragma unroll
              for (int i = 0; i < 8; ++i) { o1[i] *= qs; o2[i] *= qs; }
              u32x2 v1, v2; v1.x = cvt4_fp8(o1[0], o1[1], o1[2], o1[3]); v1.y = cvt4_fp8(o1[4], o1[5], o1[6], o1[7]); v2.x = cvt4_fp8(o2[0], o2[1], o2[2], o2[3]); v2.y = cvt4_fp8(o2[4], o2[5], o2[6], o2[7]);
              *(u32x2*)q8 = v1; *(u32x2*)(q8 + 16) = v2; }
#else
            u32x4 r1, r2; r1.x = cvt_pk_bf16(o1[0], o1[1]); r1.y = cvt_pk_bf16(o1[2], o1[3]); r1.z = cvt_pk_bf16(o1[4], o1[5]); r1.w = cvt_pk_bf16(o1[6], o1[7]);
            r2.x = cvt_pk_bf16(o2[0], o2[1]); r2.y = cvt_pk_bf16(o2[2], o2[3]); r2.z = cvt_pk_bf16(o2[4], o2[5]); r2.w = cvt_pk_bf16(o2[6], o2[7]);
            *(u32x4*)(Zo + (size_t)t * ZW + col) = r1; *(u32x4*)(Zo + (size_t)t * ZW + col + 16) = r2;
#endif
        } } }
#undef QK_UNPACK
}

__device__ __forceinline__ void gla_prep_unit(const Frame& F, const Args& a, int l, int n, int h) {
    const bf16_t* Z = (const bf16_t*)(F.ws + WS_Z); bf16_t* GQK = (bf16_t*)(F.ws + WS_GQK); bf16_t* GVT = (bf16_t*)(F.ws + WS_GVT);
    float* GU = (float*)(F.ws + WS_GU); float* GG = (float*)(F.ws + WS_GG);
    LAS unsigned char* L = F.lds;
    LAS float* zz = (LAS float*)L;
    LAS float* waf = (LAS float*)(L + 8192);
    LAS float* wab = (LAS float*)(L + 12288);
    LAS float* baf = (LAS float*)(L + 16384);
    LAS float* bab = (LAS float*)(L + 16640);
    LAS float* LF = (LAS float*)(L + 17408);
    LAS float* LB = (LAS float*)(L + 34304);
    LAS float* segF = (LAS float*)(L + 51200);
    LAS float* segB = (LAS float*)(L + 53248);
    LAS bf16_t* keTf = (LAS bf16_t*)(L + 55296);
    LAS bf16_t* keTb = (LAS bf16_t*)(L + 64512);
    LAS bf16_t* vT = (LAS bf16_t*)(L + 73728);
    int tz0 = threadIdx.x; asm volatile("" : "+v"(tz0));
    const int tid = tz0, tok0 = n * 64;
    __syncthreads();
    if (tid < 256) { const int c = tid >> 2, p8 = (tid & 3) * 8; const u32x4 w = *(const u32x4*)(Z + (size_t)(tok0 + c) * ZW + ZC_DEC + p8);
        LAS float* d = zz + c * 32 + p8; d[0] = bflo(w.x); d[1] = bfhi(w.x); d[2] = bflo(w.y); d[3] = bfhi(w.y); d[4] = bflo(w.z); d[5] = bfhi(w.z); d[6] = bflo(w.w); d[7] = bfhi(w.w); }
    for (int i = tid; i < 1024; i += NTHREADS) { const int r = i >> 6, d = i & 63; waf[i] = a.in[I_WAF][((size_t)l * 16 + r) * 256 + h * 64 + d]; wab[i] = a.in[I_WAB][((size_t)l * 16 + r) * 256 + h * 64 + d]; }
    if (tid < 64) { baf[tid] = a.in[I_BAF][l * 256 + h * 64 + tid]; bab[tid] = a.in[I_BAB][l * 256 + h * 64 + tid]; }
    __syncthreads();
    const int c = tid >> 3, d8 = (tid & 7) * 8;
    { float af[8], ab[8];
#pragma unroll
      for (int e = 0; e < 8; ++e) { af[e] = baf[d8 + e]; ab[e] = bab[d8 + e]; }
#pragma unroll
      for (int r = 0; r < 16; ++r) { const float zf = zz[c * 32 + r], zb = zz[c * 32 + 16 + r];
#pragma unroll
          for (int e = 0; e < 8; ++e) { af[e] += zf * waf[r * 64 + d8 + e]; ab[e] += zb * wab[r * 64 + d8 + e]; } }
#pragma unroll
      for (int e = 0; e < 8; ++e) { LF[c * 65 + d8 + e] = logsigmoid_f(af[e]) * (1.f / 16.f); LB[c * 65 + d8 + e] = logsigmoid_f(ab[e]) * (1.f / 16.f); } }
    __syncthreads();
    { const int d = tid & 63, seg = tid >> 6; float run = 0.f;
#pragma unroll
      for (int i = 0; i < 8; ++i) { run += LF[(8 * seg + i) * 65 + d]; LF[(8 * seg + i) * 65 + d] = run; }
      segF[seg * 64 + d] = run; run = 0.f;
#pragma unroll
      for (int i = 7; i >= 0; --i) { run += LB[(8 * seg + i) * 65 + d]; LB[(8 * seg + i) * 65 + d] = run; }
      segB[seg * 64 + d] = run; }
    __syncthreads();
    { const int d = tid & 63, seg = tid >> 6; float of = 0.f, ob = 0.f;
      for (int s = 0; s < 8; ++s) { if (s < seg) of += segF[s * 64 + d]; if (s > seg) ob += segB[s * 64 + d]; }
#pragma unroll
      for (int i = 0; i < 8; ++i) { LF[(8 * seg + i) * 65 + d] += of; LB[(8 * seg + i) * 65 + d] += ob; } }
    __syncthreads();
    { const size_t zrow = (size_t)(tok0 + c) * ZW;
      const u32x4 qw = *(const u32x4*)(Z + zrow + ZC_GQ + h * 64 + d8), kw = *(const u32x4*)(Z + zrow + ZC_GK + h * 64 + d8);
      float q[8] = {bflo(qw.x), bfhi(qw.x), bflo(qw.y), bfhi(qw.y), bflo(qw.z), bfhi(qw.z), bflo(qw.w), bfhi(qw.w)};
      float k[8] = {bflo(kw.x), bfhi(kw.x), bflo(kw.y), bfhi(kw.y), bflo(kw.z), bfhi(kw.z), bflo(kw.w), bfhi(kw.w)};
      float qdf[8], kif[8], qdb[8], kib[8];
#pragma unroll
      for (int e = 0; e < 8; ++e) { const float cf = LF[c * 65 + d8 + e], cb = LB[c * 65 + d8 + e];
          qdf[e] = q[e] * __expf(cf); kif[e] = k[e] * __expf(-cf); qdb[e] = q[e] * __expf(cb); kib[e] = k[e] * __expf(-cb);
          keTf[(d8 + e) * 72 + c] = f2bf(k[e] * __expf(LF[63 * 65 + d8 + e] - cf)); keTb[(d8 + e) * 72 + c] = f2bf(k[e] * __expf(LB[d8 + e] - cb)); }
      bf16_t* go = GQK + (size_t)(tok0 + c) * 1024 + h * 64 + d8;
#define PK8(x) (u32x4){cvt_pk_bf16(x[0], x[1]), cvt_pk_bf16(x[2], x[3]), cvt_pk_bf16(x[4], x[5]), cvt_pk_bf16(x[6], x[7])}
      *(u32x4*)(go) = PK8(qdf); *(u32x4*)(go + 256) = PK8(kif); *(u32x4*)(go + 512) = PK8(qdb); *(u32x4*)(go + 768) = PK8(kib);
#undef PK8
#pragma unroll
      for (int i = 0; i < 2; ++i) { const int p = tid + NTHREADS * i, cc = p >> 4, v8 = (p & 15) * 8; const u32x4 w = *(const u32x4*)(Z + (size_t)(tok0 + cc) * ZW + ZC_GV + h * 128 + v8);
          vT[(v8 + 0) * 72 + cc] = (bf16_t)(w.x & 0xffff); vT[(v8 + 1) * 72 + cc] = (bf16_t)(w.x >> 16); vT[(v8 + 2) * 72 + cc] = (bf16_t)(w.y & 0xffff); vT[(v8 + 3) * 72 + cc] = (bf16_t)(w.y >> 16);
          vT[(v8 + 4) * 72 + cc] = (bf16_t)(w.z & 0xffff); vT[(v8 + 5) * 72 + cc] = (bf16_t)(w.z >> 16); vT[(v8 + 6) * 72 + cc] = (bf16_t)(w.w & 0xffff); vT[(v8 + 7) * 72 + cc] = (bf16_t)(w.w >> 16); }
      if (tid < 64) GG[((size_t)(n * 4 + h) * 2 + 0) * 64 + tid] = __expf(LF[63 * 65 + tid]);
      else if (tid < 128) GG[((size_t)(n * 4 + h) * 2 + 1) * 64 + tid - 64] = __expf(LB[tid - 64]); }
    __syncthreads();
    { const int v = tid >> 2, c16 = (tid & 3) * 16; const u32x4 w0 = *(const LAS u32x4*)(vT + v * 72 + c16), w1 = *(const LAS u32x4*)(vT + v * 72 + c16 + 8);
      u32x4* dp = (u32x4*)(GVT + ((size_t)(n * 4 + h) * 128 + v) * 64 + c16); dp[0] = w0; dp[1] = w1; }
    { const int w = tid >> 6, vb = w >> 1, db = w & 1, r32 = tid & 31, hi = (tid >> 5) & 1;
#pragma unroll
      for (int dir = 0; dir < 2; ++dir) { LAS bf16_t* keT = dir ? keTb : keTf; f32x16 acc = {};
#pragma unroll
          for (int ks = 0; ks < 4; ++ks) { const bf16x8 A = *(const LAS bf16x8*)(vT + (vb * 32 + r32) * 72 + 16 * ks + 8 * hi), B = *(const LAS bf16x8*)(keT + (db * 32 + r32) * 72 + 16 * ks + 8 * hi);
              acc = __builtin_amdgcn_mfma_f32_32x32x16_bf16(A, B, acc, 0, 0, 0); }
          float* up = GU + ((size_t)(n * 4 + h) * 2 + dir) * 8192;
#pragma unroll
          for (int r = 0; r < 16; ++r) up[(vb * 32 + attn::crow(r, hi)) * 64 + db * 32 + r32] = acc[r]; } }
}
__device__ __forceinline__ void gla_scan(const Frame& F_) {
    LOCAL_FRAME(F, F_);
    const float* GU = (const float*)(F.ws + WS_GU); const float* GG = (const float*)(F.ws + WS_GG); bf16_t* GS = (bf16_t*)(F.ws + WS_GS);
    constexpr int NS = 4, HS = NCHUNK / NS; static_assert(NCHUNK % NS == 0, "equal segments");
    LAS float* cs = (LAS float*)F.lds;
    LAS float* cp = cs + NS * 128;
    const int per = (4 * 2 * 8192 + F.G - 1) / F.G;
    __syncthreads();
    for (int base = 0; base < per; base += 128) {
        const int cl = F.tid & 127, ci = base + cl, seg = F.tid >> 7, g = F.bid * per + ci; const bool ok = ci < per && g < 4 * 2 * 8192;
        const int d = g & 63, vd = g & 8191, dir = (g >> 13) & 1, h = g >> 14;
        float uu[HS], gg[HS];
#define GS_OFF(i) ({ const int step_ = seg * HS + (i); const int nn_ = dir == 0 ? step_ : (step_ < 4 ? 3 - step_ : NCHUNK + 3 - step_); (nn_ * 4 + h) * 2 + dir; })
#pragma unroll
        for (int i = 0; i < HS; ++i) { const int ob = ok ? GS_OFF(i) : 0; uu[i] = GU[(size_t)ob * 8192 + vd]; gg[i] = GG[ob * 64 + d]; }
        float s = 0.f, P = 1.f;
#pragma unroll
        for (int i = 0; i < HS; ++i) { const float u = uu[i], gd = gg[i]; uu[i] = s; gg[i] = P; s = gd * s + u; P *= gd; }
        cs[seg * 128 + cl] = s; cp[seg * 128 + cl] = P;
        __syncthreads();
        float s_in = 0.f;
        for (int k = 0; k < seg; ++k) s_in = cp[k * 128 + cl] * s_in + cs[k * 128 + cl];
        if (ok) {
#pragma unroll
            for (int i = 0; i < HS; ++i) GS[(size_t)GS_OFF(i) * 8192 + vd] = f2bf(uu[i] + gg[i] * s_in); }
        __syncthreads();
#undef GS_OFF
    }
}
__device__ __forceinline__ void gla_out_unit(const Frame& F, const Args& a, int l, int n, int h, int dummy = 0) {
    const bf16_t* Z = (const bf16_t*)(F.ws + WS_Z); const bf16_t* GQK = (const bf16_t*)(F.ws + WS_GQK); const bf16_t* GVT = (const bf16_t*)(F.ws + WS_GVT);
    const bf16_t* GS = (const bf16_t*)(F.ws + WS_GS); unsigned char* MIX = F.ws + (dummy ? WS_DUMMY : 0) + WS_MIX;
    LAS bf16_t* T = (LAS bf16_t*)F.lds;
    LAS float* ssq = (LAS float*)(F.lds + 92160);
    int tz0 = threadIdx.x; asm volatile("" : "+v"(tz0));
    const int tid = tz0, tok0 = n * 64;
    __syncthreads();
    { const int c = tid >> 3, d8 = (tid & 7) * 8; const bf16_t* gp = GQK + (size_t)(tok0 + c) * 1024 + h * 64 + d8;
#pragma unroll
      for (int kd = 0; kd < 4; ++kd) *(LAS u32x4*)(T + kd * 4608 + c * 72 + d8) = *(const u32x4*)(gp + kd * 256);
#pragma unroll
      for (int i = 0; i < 2; ++i) { const int p = tid + NTHREADS * i, v = p >> 3, c8 = (p & 7) * 8;
          *(LAS u32x4*)(T + 18432 + v * 72 + c8) = *(const u32x4*)(GVT + ((size_t)(n * 4 + h) * 128 + v) * 64 + c8);
          *(LAS u32x4*)(T + 27648 + v * 72 + c8) = *(const u32x4*)(GS + ((size_t)(n * 4 + h) * 2 + 0) * 8192 + v * 64 + c8);
          *(LAS u32x4*)(T + 36864 + v * 72 + c8) = *(const u32x4*)(GS + ((size_t)(n * 4 + h) * 2 + 1) * 8192 + v * 64 + c8); } }
    __syncthreads();
    const int w = tid >> 6, cb = w & 1, vb = w >> 1, r32 = tid & 31, hi = (tid >> 5) & 1;
    f32x16 O = {};
#pragma unroll
    for (int dir = 0; dir < 2; ++dir) {
        LAS bf16_t* Q = T + (dir ? 9216 : 0); LAS bf16_t* Kt = T + (dir ? 13824 : 4608); LAS bf16_t* ST = T + (dir ? 36864 : 27648); LAS bf16_t* vT = T + 18432;
        bf16x8 qf[4];
#pragma unroll
        for (int ks = 0; ks < 4; ++ks) qf[ks] = *(const LAS bf16x8*)(Q + (cb * 32 + r32) * 72 + 16 * ks + 8 * hi);
#pragma unroll
        for (int ks = 0; ks < 4; ++ks) { const bf16x8 B = *(const LAS bf16x8*)(ST + (vb * 32 + r32) * 72 + 16 * ks + 8 * hi); O = __builtin_amdgcn_mfma_f32_32x32x16_bf16(qf[ks], B, O, 0, 0, 0); }
#pragma unroll
        for (int sb = 0; sb < 2; ++sb) {
            if ((dir == 0 && sb > cb) || (dir == 1 && sb < cb)) continue;
            f32x16 X = {};
#pragma unroll
            for (int ks = 0; ks < 4; ++ks) { const bf16x8 A = *(const LAS bf16x8*)(Kt + (sb * 32 + r32) * 72 + 16 * ks + 8 * hi); X = __builtin_amdgcn_mfma_f32_32x32x16_bf16(A, qf[ks], X, 0, 0, 0); }
            if (sb == cb) {
#pragma unroll
                for (int r = 0; r < 16; ++r) { const int s = attn::crow(r, hi); const bool keep = dir == 0 ? (s <= r32) : (s >= r32); X[r] = keep ? X[r] : 0.f; } }
#pragma unroll
            for (int kk = 0; kk < 2; ++kk) {
                u32x4 pw = {cvt_pk_bf16(X[8 * kk + 0], X[8 * kk + 1]), cvt_pk_bf16(X[8 * kk + 2], X[8 * kk + 3]), cvt_pk_bf16(X[8 * kk + 4], X[8 * kk + 5]), cvt_pk_bf16(X[8 * kk + 6], X[8 * kk + 7])};
                const bf16x8 pa = *reinterpret_cast<bf16x8*>(&pw);
                const u32x2 lo = *(const LAS u32x2*)(vT + (vb * 32 + r32) * 72 + sb * 32 + 16 * kk + 4 * hi), hh = *(const LAS u32x2*)(vT + (vb * 32 + r32) * 72 + sb * 32 + 16 * kk + 8 + 4 * hi);
                u32x4 bw = {lo.x, lo.y, hh.x, hh.y};
                O = __builtin_amdgcn_mfma_f32_32x32x16_bf16(pa, *reinterpret_cast<bf16x8*>(&bw), O, 0, 0, 0); }
        }
    }
    __syncthreads();
    LAS float* OI = (LAS float*)F.lds;
#pragma unroll
    for (int r = 0; r < 16; ++r) OI[(cb * 32 + attn::crow(r, hi)) * 132 + vb * 32 + r32] = O[r];
    __syncthreads();
    { const int c = tid >> 3, v0 = (tid & 7) * 16;
      f32x4 x[4]; float ss = 0.f;
#pragma unroll
      for (int q = 0; q < 4; ++q) { x[q] = *(const LAS f32x4*)(OI + c * 132 + v0 + q * 4); ss += x[q][0] * x[q][0] + x[q][1] * x[q][1] + x[q][2] * x[q][2] + x[q][3] * x[q][3]; }
      ss += __shfl_xor(ss, 1, 64); ss += __shfl_xor(ss, 2, 64); ss += __shfl_xor(ss, 4, 64);
      const float rs = rsqrtf(ss * (1.f / 128.f) + NORM_EPS);
      const bf16_t* gp = Z + (size_t)(tok0 + c) * ZW + ZC_GG + h * 128 + v0; const u32x4 g0 = *(const u32x4*)gp, g1 = *(const u32x4*)(gp + 8);
      const float* gnp = a.in[I_GLAG] + l * 128 + v0;
      float gate[16]; gate[0] = bflo(g0.x); gate[1] = bfhi(g0.x); gate[2] = bflo(g0.y); gate[3] = bfhi(g0.y); gate[4] = bflo(g0.z); gate[5] = bfhi(g0.z); gate[6] = bflo(g0.w); gate[7] = bfhi(g0.w);
      gate[8] = bflo(g1.x); gate[9] = bfhi(g1.x); gate[10] = bflo(g1.y); gate[11] = bfhi(g1.y); gate[12] = bflo(g1.z); gate[13] = bfhi(g1.z); gate[14] = bflo(g1.w); gate[15] = bfhi(g1.w);
      u32x4 w;
#pragma unroll
      for (int q = 0; q < 4; ++q) { const f32x4 gn = *(const f32x4*)(gnp + q * 4); float y[4];
#pragma unroll
          for (int e = 0; e < 4; ++e) y[e] = x[q][e] * rs * gn[e] * silu_f(gate[q * 4 + e]) * 16.f;
          w[q] = cvt4_fp8(y[0], y[1], y[2], y[3]); }
      *(u32x4*)(MIX + (size_t)(tok0 + c) * DM + h * 128 + v0) = w; }
}
__device__ __forceinline__ void phase_router(const Frame& F_, const Args& a, int l, int tok0, int ntok, int dummy) {
    LOCAL_FRAME(F, F_);
    unsigned char* wso = F.ws + (dummy ? WS_DUMMY : 0);
    const bf16_t* X = (const bf16_t*)(F.ws + WS_X); unsigned char* A8 = F.ws + WS_A8;
    const float* mod = (const float*)(F.ws + WS_MOD) + (size_t)l * 2 * 6 * DM;
    const bf16_t* RH = (const bf16_t*)(F.ws + WS_RWT) + (size_t)l * 2 * NEXP * DM; const bf16_t* RL = RH + (size_t)NEXP * DM;
    const float* rb = a.in[I_RB] + l * NEXP; const float* n2g = a.in[I_N2G] + (size_t)l * DM;
    unsigned* cnt = (unsigned*)(F.ws + WS_CTL) + (dummy ? CW_CNTD : CW_CNT) + l * NEXP;
    int* list = (int*)(wso + WS_LIST); int* toke = (int*)(wso + WS_TOKE); int* tokp = (int*)(wso + WS_TOKP); float* tokw = (float*)(wso + WS_TOKW);
    constexpr int BT = 17;
    LAS unsigned char* up = F.lds + LDS_STAGE + LDS_MISC;
#define RT_HI(r) (F.lds + (r) * 4096)
#define RT_LO(r) (((r) < 15) ? F.lds + 69632 + (r) * 4096 : up + ((r) - 15) * 4096)
    LAS float* part = (LAS float*)(up + 8192);
    LAS int* selE = (LAS int*)(up + 8192 + 8704);
    LAS float* selW = (LAS float*)(up + 8192 + 8704 + 1536);
    LAS int* selR = (LAS int*)(up + 8192 + 8704 + 3072);
    LAS int* hist = (LAS int*)(up + 8192 + 8704 + 4608);
    LAS int* base = (LAS int*)(up + 8192 + 8704 + 4864);
    const int lane = F.lane;
    const int per = (ntok + F.G - 1) / F.G;
    const int t0 = F.bid * per, t1 = (t0 + per < ntok) ? t0 + per : ntok, nmine = t1 > t0 ? t1 - t0 : 0;
    __syncthreads();
    if (F.tid < 64) hist[F.tid] = 0;
    u32x2 xw[3][8];
#define RT_LOADX(b) do { _Pragma("unroll") for (int q = 0; q < 3; ++q) { const int jl_ = F.wave + 8 * q, j_ = (b) * BT + jl_; if (jl_ < BT) { \
        const bf16_t* xr_ = X + (size_t)(tok0 + t0 + (j_ < nmine ? j_ : 0)) * DM; \
        _Pragma("unroll") for (int k = 0; k < 8; ++k) xw[q][k] = *(const u32x2*)(xr_ + k * 256 + lane * 4); } } } while (0)
    if (nmine > 0) RT_LOADX(0);
    for (int b = 0; b * BT < nmine; ++b) {
#pragma unroll
        for (int q = 0; q < 3; ++q) { const int jl = F.wave + 8 * q, j = b * BT + jl;
            if (jl < BT && j < nmine) { const int t = tok0 + t0 + j; const float* m = mod + (size_t)(t < NCTX ? 0 : 1) * 6 * DM;
                LAS unsigned char* hr = RT_HI(jl); LAS unsigned char* lr = RT_LO(jl);
                f32x4 v[8]; float ss = 0.f;
#pragma unroll
                for (int k = 0; k < 8; ++k) { v[k] = (f32x4){bflo(xw[q][k].x), bfhi(xw[q][k].x), bflo(xw[q][k].y), bfhi(xw[q][k].y)}; ss += v[k][0] * v[k][0] + v[k][1] * v[k][1] + v[k][2] * v[k][2] + v[k][3] * v[k][3]; }
                ss = wave_sum(ss); const float rs = rsqrtf(ss * (1.f / DM) + NORM_EPS);
#pragma unroll
                for (int k = 0; k < 8; ++k) { const int i = k * 256 + lane * 4;
                    const f32x4 gg = *(const f32x4*)(n2g + i), s0 = *(const f32x4*)(m + 3 * DM + i), s1 = *(const f32x4*)(m + 4 * DM + i);
                    const f32x4 y = v[k] * rs * gg * (s1 + 1.f) + s0;
                    u32x2 wh; wh.x = cvt_pk_bf16(y[0], y[1]); wh.y = cvt_pk_bf16(y[2], y[3]);
                    u32x2 wl; wl.x = cvt_pk_bf16(y[0] - bflo(wh.x), y[1] - bfhi(wh.x)); wl.y = cvt_pk_bf16(y[2] - bflo(wh.y), y[3] - bfhi(wh.y));
                    const int sb = (i * 2) ^ ((jl & 15) << 4);
                    *(LAS u32x2*)(hr + sb) = wh; *(LAS u32x2*)(lr + sb) = wl;
                    *(unsigned*)(A8 + (size_t)t * DM + i) = cvt4_fp8(y[0], y[1], y[2], y[3]); } } }
        if ((b + 1) * BT < nmine) RT_LOADX(b + 1);
        __syncthreads();
        { const int i16 = lane & 15, k4 = lane >> 4, nt = F.wave & 3, kh = F.wave >> 2;
          const bool two = (b * BT + 16) < nmine;
          f32x4 acc0 = {0.f, 0.f, 0.f, 0.f}, acc1 = acc0;
          const bf16_t* bhp = RH + (size_t)(nt * 16 + i16) * DM + kh * 1024 + 8 * k4; const bf16_t* blp = RL + (size_t)(nt * 16 + i16) * DM + kh * 1024 + 8 * k4;
          LAS unsigned char* h0 = RT_HI(i16); LAS unsigned char* l0 = RT_LO(i16); LAS unsigned char* h1 = RT_HI(16); LAS unsigned char* l1 = RT_LO(16);
          constexpr int PG = 4;
          bf16x8 bh[PG], bl[PG];
#pragma unroll
          for (int u = 0; u < PG; ++u) { bh[u] = *(const bf16x8*)(bhp + u * 32); bl[u] = *(const bf16x8*)(blp + u * 32); }
#pragma unroll
          for (int g = 0; g < 32 / PG; ++g) { bf16x8 nh[PG], nl[PG];
              if (g + 1 < 32 / PG) {
#pragma unroll
                  for (int u = 0; u < PG; ++u) { nh[u] = *(const bf16x8*)(bhp + ((g + 1) * PG + u) * 32); nl[u] = *(const bf16x8*)(blp + ((g + 1) * PG + u) * 32); } }
#pragma unroll
              for (int u = 0; u < PG; ++u) { const int kb = (kh * 1024 + (g * PG + u) * 32 + 8 * k4) * 2;
                  const bf16x8 ah = *(const LAS bf16x8*)(h0 + (kb ^ (i16 << 4))), al = *(const LAS bf16x8*)(l0 + (kb ^ (i16 << 4)));
                  acc0 = __builtin_amdgcn_mfma_f32_16x16x32_bf16(al, bh[u], acc0, 0, 0, 0);
                  acc0 = __builtin_amdgcn_mfma_f32_16x16x32_bf16(ah, bl[u], acc0, 0, 0, 0);
                  acc0 = __builtin_amdgcn_mfma_f32_16x16x32_bf16(ah, bh[u], acc0, 0, 0, 0);
                  if (two) { const bf16x8 ch = *(const LAS bf16x8*)(h1 + kb), cl = *(const LAS bf16x8*)(l1 + kb);
                      acc1 = __builtin_amdgcn_mfma_f32_16x16x32_bf16(cl, bh[u], acc1, 0, 0, 0);
                      acc1 = __builtin_amdgcn_mfma_f32_16x16x32_bf16(ch, bl[u], acc1, 0, 0, 0);
                      acc1 = __builtin_amdgcn_mfma_f32_16x16x32_bf16(ch, bh[u], acc1, 0, 0, 0); } }
              if (g + 1 < 32 / PG) {
#pragma unroll
                  for (int u = 0; u < PG; ++u) { bh[u] = nh[u]; bl[u] = nl[u]; } } }
#pragma unroll
          for (int r = 0; r < 4; ++r) part[(kh * BT + 4 * k4 + r) * 64 + nt * 16 + i16] = acc0[r];
          if (two && k4 == 0) part[(kh * BT + 16) * 64 + nt * 16 + i16] = acc1[0]; }
        __syncthreads();
#pragma unroll 1
        for (int q = 0; q < 3; ++q) { const int jl = F.wave + 8 * q, j = b * BT + jl; if (jl >= BT || j >= nmine) break;
            const float lg = part[jl * 64 + lane] + part[(BT + jl) * 64 + lane];
            const float s = sigmoid_f(lg); float sv = s + rb[lane]; float ssum = 0.f, mys = 0.f; int myk = -1;
#pragma unroll
            for (int k = 0; k < TOPK; ++k) { const float mx = wave_max(sv); const unsigned long long bal = __ballot(sv == mx); const int win = __ffsll((long long)bal) - 1;
                const float ws_ = __shfl(s, win, 64); ssum += ws_; if (lane == win) { sv = -3.0e38f; myk = k; mys = s; } }
            if (myk >= 0) { const int rank = atomicAdd((int*)&hist[lane], 1); selE[j * 8 + myk] = lane; selW[j * 8 + myk] = mys / ssum * 2.5f; selR[j * 8 + myk] = rank; } }
    }
#undef RT_LOADX
#undef RT_HI
#undef RT_LO
    __syncthreads();
    if (F.tid < 64) base[F.tid] = hist[F.tid] > 0 ? (int)atomicAdd(&cnt[F.tid], (unsigned)hist[F.tid]) : 0;
    __syncthreads();
    for (int i = F.tid; i < nmine * 8; i += NTHREADS) { const int j = i >> 3, k = i & 7; const int tglob = tok0 + t0 + j; const int e = selE[i], pos = base[e] + selR[i];
        list[(size_t)e * NTOK + pos] = tglob; toke[(size_t)tglob * 8 + k] = e; tokp[(size_t)tglob * 8 + k] = pos; tokw[(size_t)tglob * 8 + k] = selW[i]; }
}

__device__ __forceinline__ void phase_combine(const Frame& F_, const Args& a, int l, int tok0, int ntok, int dummy) {
    LOCAL_FRAME(F, F_);
    unsigned char* wso = F.ws + (dummy ? WS_DUMMY : 0);
    const bf16_t* X = (const bf16_t*)(F.ws + WS_X); bf16_t* Xo = (bf16_t*)(wso + WS_X); bf16_t* A = (bf16_t*)(wso + WS_A); const unsigned char* Y = F.ws + WS_Y;
    const float* mod = (const float*)(F.ws + WS_MOD) + (size_t)l * 2 * 6 * DM;
    const int* toke = (const int*)(F.ws + WS_TOKE); const int* tokp = (const int*)(F.ws + WS_TOKP); const float* tokw = (const float*)(F.ws + WS_TOKW);
    const LAS int* rbS = (const LAS int*)(F.lds + LDS_STAGE + MS_RB);
    const int lane = F.lane;
    for (int tl = F.bid * 8 + F.wave; tl < ntok; tl += F.G * 8) { const int t = tok0 + tl;
        int rowv = 0; float wv = 0.f;
        if (lane < 8) { const int e = toke[(size_t)t * 8 + lane]; rowv = rbS[e] + tokp[(size_t)t * 8 + lane]; wv = tokw[(size_t)t * 8 + lane]; }
        int rows[9]; float wts[9];
#pragma unroll
        for (int s = 0; s < 8; ++s) { rows[s] = __builtin_amdgcn_readlane(rowv, s); wts[s] = __uint_as_float(__builtin_amdgcn_readlane(__float_as_uint(wv), s)); }
        rows[8] = rbS[NEXP] + tl; wts[8] = 1.f;
        f32x4 acc[8];
#pragma unroll
        for (int k = 0; k < 8; ++k) acc[k] = (f32x4){0.f, 0.f, 0.f, 0.f};
        { unsigned w[9][8];
#pragma unroll
          for (int r = 0; r < 9; ++r) { const unsigned char* yr = Y + (size_t)rows[r] * DM + lane * 4;
#pragma unroll
              for (int k = 0; k < 8; ++k) w[r][k] = *(const unsigned*)(yr + k * 256); }
#pragma unroll
          for (int r = 0; r < 9; ++r) { const float wg = wts[r];
#pragma unroll
              for (int k = 0; k < 8; ++k) { const auto lo = __builtin_amdgcn_cvt_pk_f32_fp8((int)w[r][k], false), hi = __builtin_amdgcn_cvt_pk_f32_fp8((int)w[r][k], true);
                  acc[k] += wg * (f32x4){lo[0], lo[1], hi[0], hi[1]}; } } }
        const float* m = mod + (size_t)(t < NCTX ? 0 : 1) * 6 * DM; const bf16_t* xr = X + (size_t)t * DM; bf16_t* xo = Xo + (size_t)t * DM; float ss = 0.f;
#pragma unroll
        for (int k = 0; k < 8; ++k) { const int i = k * 256 + lane * 4; const f32x4 g2 = *(const f32x4*)(m + 5 * DM + i); const u32x2 xw = *(const u32x2*)(xr + i); const f32x4 xv = {bflo(xw.x), bfhi(xw.x), bflo(xw.y), bfhi(xw.y)};
            acc[k] = xv + g2 * acc[k]; ss += acc[k][0] * acc[k][0] + acc[k][1] * acc[k][1] + acc[k][2] * acc[k][2] + acc[k][3] * acc[k][3]; }
        ss = wave_sum(ss); const float rs = rsqrtf(ss * (1.f / DM) + NORM_EPS);
        if (l + 1 < DEPTH) {
            const float* mn = (const float*)(F.ws + WS_MOD) + ((size_t)(l + 1) * 2 + (t < NCTX ? 0 : 1)) * 6 * DM; const float* g = a.in[I_N1G] + (size_t)(l + 1) * DM;
#pragma unroll
            for (int k = 0; k < 8; ++k) { const int i = k * 256 + lane * 4; { u32x2 xo2; xo2.x = cvt_pk_bf16(acc[k][0], acc[k][1]); xo2.y = cvt_pk_bf16(acc[k][2], acc[k][3]); *(u32x2*)(xo + i) = xo2; }
                const f32x4 gg = *(const f32x4*)(g + i), s0 = *(const f32x4*)(mn + i), s1 = *(const f32x4*)(mn + DM + i);
                const f32x4 y = acc[k] * rs * gg * (s1 + 1.f) + s0;
#if INPROJ_F8
                *(unsigned*)((unsigned char*)A + (size_t)t * DM + i) = cvt4_fp8(y[0], y[1], y[2], y[3]); }
#else
                u32x2 w; w.x = cvt_pk_bf16(y[0], y[1]); w.y = cvt_pk_bf16(y[2], y[3]); *(u32x2*)(A + (size_t)t * DM + i) = w; }
#endif
        } else {
            float* orow = (dummy ? (float*)(F.ws + WS_DUMMY + WS_X) : a.out) + (size_t)(t - NCTX) * DM; const float* g = a.in[I_FG];
#pragma unroll
            for (int k = 0; k < 8; ++k) { const int i = k * 256 + lane * 4; const f32x4 gg = *(const f32x4*)(g + i); *(f32x4*)(orow + i) = acc[k] * rs * gg; }
        }
    }
}

__device__ __forceinline__ float diff_lambda(const Args& a, int l) {
    float s1 = 0.f, s2 = 0.f;
    for (int i = 0; i < 64; ++i) { s1 += a.in[I_LQ1][l * 64 + i] * a.in[I_LK1][l * 64 + i]; s2 += a.in[I_LQ2][l * 64 + i] * a.in[I_LK2][l * 64 + i]; }
    const float lam = expf(s1) - expf(s2) + (l == 0 ? 0.2f : 0.35550907f);
    return __uint_as_float(__builtin_amdgcn_readfirstlane(__float_as_uint(lam)));
}
template <int BGL>
__device__ __forceinline__ void attn_gqa_unit(const Frame& F, int hq, int row0, int seq, const attn::BgArgs bg) {
    const bf16_t* Z = (const bf16_t*)(F.ws + WS_Z); unsigned char* MIX = F.ws + WS_MIX; const int kv = hq >> 2;
    attn::OutArgs oa; oa.mix = MIX + (size_t)row0 * DM + 512 + hq * 128; oa.scr = nullptr; oa.lam = 0.f; oa.osc = 0.f; oa.ng = nullptr;
#if ATTN_F8
    const unsigned char* Q8 = F.ws + WS_QK8;
    attn::body<64, 0, BGL, 128>((const bf16_t*)(Q8 + (size_t)row0 * QK8_ROW + hq * 128), (const bf16_t*)(Q8 + 1024 + kv * 128), Z + ZC_AV + kv * 128, seq, (char*)F.lds, oa, bg);
#else
    attn::body<128, 0, BGL>(Z + (size_t)row0 * ZW + ZC_AQ + hq * 128, Z + ZC_AK + kv * 128, Z + ZC_AV + kv * 128, seq, (char*)F.lds, oa, bg);
#endif
}
template <int BGL>
__device__ __forceinline__ void attn_diff_unit(const Frame& F, const Args& a, int l, int hd, int row0, int seq, float lam, const attn::BgArgs bg) {
    const bf16_t* Z = (const bf16_t*)(F.ws + WS_Z); unsigned char* MIX = F.ws + WS_MIX;
    attn::OutArgs oa; oa.mix = MIX + (size_t)row0 * DM + 1536 + hd * 128; oa.scr = (float*)(F.ws + WS_DSCR) + (size_t)F.bid * 256 * 128;
    oa.lam = lam; oa.osc = (l == 0 ? 0.8f : 0.64449093f); oa.ng = a.in[I_DNG] + l * 128;
#if ATTN_F8
    const unsigned char* Q8 = F.ws + WS_QK8;
    attn::body<64, 1, BGL, 64>((const bf16_t*)(Q8 + (size_t)row0 * QK8_ROW + 1280 + hd * 128), (const bf16_t*)(Q8 + 1792 + hd * 128), Z + ZC_DV + hd * 128, seq, (char*)F.lds, oa, bg);
    attn::body<64, 2, BGL, 64>((const bf16_t*)(Q8 + (size_t)row0 * QK8_ROW + 1280 + hd * 128 + 64), (const bf16_t*)(Q8 + 1792 + hd * 128 + 64), Z + ZC_DV + hd * 128, seq, (char*)F.lds, oa, bg);
#else
    attn::body<64, 1, BGL>(Z + (size_t)row0 * ZW + ZC_DQ + hd * 128, Z + ZC_DK + hd * 128, Z + ZC_DV + hd * 128, seq, (char*)F.lds, oa, bg);
    attn::body<64, 2, BGL>(Z + (size_t)row0 * ZW + ZC_DQ + hd * 128 + 64, Z + ZC_DK + hd * 128 + 64, Z + ZC_DV + hd * 128, seq, (char*)F.lds, oa, bg);
#endif
}
struct AUnit { int type, p0, row0, seq; };
template <int l>
__device__ __forceinline__ bool attn_unit_of(int G, int bid, int vcu, int k, AUnit& u) {
    constexpr int nsmall = (l == 0 ? 12 : 0) + (l == 0 ? NCHUNK : NCHUNK - 4) * 4;
    int li;
    if (G == 256) { const int x = vcu >> 5, j = vcu & 31;
#if AT_PLAN == 1
        if (x < 4) { if (k == 0) li = x * 32 + j; else { const int sm = x * 32 + j + 128 * (k - 1); if (sm >= nsmall - SM_GQ) return false; li = 384 + sm; } }
        else { if (k < 2) li = 128 + (2 * (x - 4) + k) * 32 + j; else { const int sm = nsmall - SM_GQ + (x - 4) * 32 + j + 128 * (k - 2); if (sm >= nsmall) return false; li = 384 + sm; } }
#else
        if (j < 16) { if (k == 0) li = x * 16 + j; else { const int sm = x * 16 + j + 128 * (k - 1); if (sm >= SM_NA) return false; li = 384 + sm; } }
        else { if (k < 2) li = 128 + x * 32 + (j - 16) + 16 * k; else li = 384 + SM_NA + x * 16 + (j - 16) + 128 * (k - 2); }
#endif
    } else li = bid + k * G;
    if (li >= 384 + nsmall) return false;
    if (li < 128) { u.type = 1; u.p0 = li >> 5; u.row0 = NCTX + (li & 31) * 256; u.seq = NTOK; return true; }
    if (li < 384) { const int g = li - 128; u.type = 0; u.p0 = g >> 5; u.row0 = NCTX + (g & 31) * 256; u.seq = NTOK; return true; }
    int v = li - 384;
    if (l == 0) { if (v < 8) { u.type = 0; u.p0 = v; u.row0 = 0; u.seq = NCTX; return true; }
                  if (v < 12) { u.type = 1; u.p0 = v - 8; u.row0 = 0; u.seq = NCTX; return true; } v -= 12; }
    u.type = 2; u.p0 = v & 3; u.row0 = (l == 0) ? (v >> 2) : 4 + (v >> 2); u.seq = 0; return true;
}
template <int l>
__device__ __forceinline__ void phase_attention(const Frame& F, const Args& a) {
    const float lam = diff_lambda(a, l);
    const attn::BgArgs bg{nullptr, &a, F.ws, F.lds};
    for (int k = 0;; ++k) {
        AUnit u; if (!attn_unit_of<l>(F.G, F.bid, F.vcu, k, u)) break;
        const int nrep = ((REP_PH == 13 && u.type == 0) || (REP_PH == 14 && u.type == 1) || (REP_PH == 15 && u.type == 2)) ? 2 : 1;
        for (int rep = 0; rep < nrep; ++rep) {
        if (u.type == 0) attn_gqa_unit<-1>(F, u.p0, u.row0, u.seq, bg);
        else if (u.type == 1) attn_diff_unit<-1>(F, a, l, u.p0, u.row0, u.seq, lam, bg);
        else gla_out_unit(F, a, l, rep ? (u.row0 + 66) % NCHUNK : u.row0, u.p0, rep); }
    }
#if WC_ATT
    { unsigned* done = (unsigned*)(F.ws + WS_CTL) + CW_DONE + 32 * (8 + l);
      __syncthreads();
      if (F.tid == 0) __hip_atomic_fetch_add(done, 1u, __ATOMIC_RELAXED, __HIP_MEMORY_SCOPE_AGENT);
      wc_work(a, F.ws, F.lds, (unsigned*)(F.ws + WS_CTL), WC_CH_TOTAL, done, (unsigned)F.G); }
#endif
}

constexpr int PH_PRO = 0, PH_N1 = 1, PH_L0 = 2, PH_PER_LAYER = 9, N_PHASES = PH_L0 + DEPTH * PH_PER_LAYER;
#ifndef REP_PH
#define REP_PH -1
#endif
#if !MK_PER_PHASE
#define SEAM(k) do { if ((k) + 1 < hi) { xcd_barrier(bar); if (REP_PH == 12) xcd_barrier(bar); } } while (0)
#define LP_BAR , bar
#else
#define SEAM(k) do { } while (0)
#define LP_BAR
#endif
#ifdef ONLY_PH
#define PHSEL(k) (((k) < PH_L0 ? (k) : PH_L0 + ((k) - PH_L0) % PH_PER_LAYER) == ONLY_PH)
#else
#define PHSEL(k) true
#endif
#define IN(k) (PHSEL(k) && lo <= (k) && (k) < hi)
#define PHCLASS(k) ((k) < PH_L0 ? (k) : PH_L0 + ((k) - PH_L0) % PH_PER_LAYER)
#define NREP(k) ((PHCLASS(k) == REP_PH) ? 2 : 1)
template <int l>
__device__ __forceinline__ void layer_phases(const Frame& F, const Args& args, unsigned* ctl, const int lo, const int hi
#if !MK_PER_PHASE
    , const XcdBarrier& bar
#endif
    ) {
        const int pb = PH_L0 + l * PH_PER_LAYER;
        const int tok0 = (l == 0) ? 0 : NCTX, ntok = NTOK - tok0;
#define GEMM_DONE(k) (ctl + CW_DONE + 32 * (l * 4 + (k)))
#define SIGNAL_DONE(k) do { if (F.tid == 0) __hip_atomic_fetch_add(GEMM_DONE(k), 1u, __ATOMIC_RELAXED, __HIP_MEMORY_SCOPE_AGENT); } while (0)
        bf16_t* A = (bf16_t*)(F.ws + WS_A); bf16_t* Zb = (bf16_t*)(F.ws + WS_Z); bf16_t* X = (bf16_t*)(F.ws + WS_X);
        const float* mod = (const float*)(F.ws + WS_MOD) + (size_t)l * 2 * 6 * DM;
        if (IN(pb + 0)) {
            const int ge = (WC_TAIL & 1) ? F.G : wc_geff((NTOK / 256) * (ZW / 256), F.G);
            if (F.bid < ge) {
#if INPROJ_F8
                DenseSched S; S.init(NTOK, ZW, DM, ge, F.bid, 0, F.ws + WS_BTIN + (size_t)l * ZW * DM);
                EpiZ E{Zb, ZW};
                for (int rep = 0; rep < NREP(pb + 0); ++rep) pg8::gemm_phase<EpiZ, DenseSched, true>(F.lds, A, DM, S, E);
#else
                DenseSched S; S.init(NTOK, ZW, DM * 2, ge, F.bid, 0, (const bf16_t*)(F.ws + WS_BTIN) + (size_t)l * ZW * DM);
                EpiZ E{Zb, ZW};
                for (int rep = 0; rep < NREP(pb + 0); ++rep) pg8::gemm_phase<EpiZ, DenseSched, false>(F.lds, A, DM * 2, S, E);
#endif
                SIGNAL_DONE(0);
                if (WC_TAIL & 1) wc_work(args, F.ws, F.lds, ctl, WC_CH_TOTAL, GEMM_DONE(0), (unsigned)ge);
            } else if (l == 0 && PRO_DEFER) {
                mod_gemv(F, args.in[I_C], args.in[I_CCTX], args.in[I_WMOD], args.in[I_BMOD], (float*)(F.ws + WS_MOD), 128, 256, F.bid - ge, F.G - ge);
                if (PRO_DEFER > 1) convert_weights(F, args, CVT_ITEMS / 2, CVT_ITEMS, F.bid - ge, F.G - ge);
            } else if (WC_MASK & 1) wc_work(args, F.ws, F.lds, ctl, WC_CH_TOTAL, GEMM_DONE(0), (unsigned)ge);
            SEAM(pb + 0);
        }
        if (IN(pb + 1)) {
            for (int rep = 0; rep < NREP(pb + 1); ++rep) for (int u = F.bid; u < NCHUNK * 4; u += F.G) gla_prep_unit(F, args, l, u >> 2, u & 3);
            { const int n3 = NCHUNK * 4 - 2 * F.G; const bool split = n3 > 0 && n3 < F.G;
              if (!split) { for (int rep = ((REP_PH == 16) ? 1 : 0); rep >= 0; --rep) qk_prep(F, args, l, rep, F.bid, F.G); }
              else if (F.bid >= n3) { for (int rep = ((REP_PH == 16) ? 1 : 0); rep >= 0; --rep) qk_prep(F, args, l, rep, F.bid - n3, F.G - n3); } }
            SEAM(pb + 1);
        }
        if (IN(pb + 2)) { for (int rep = 0; rep < NREP(pb + 2); ++rep) gla_scan(F); SEAM(pb + 2); }
        if (IN(pb + 3)) { for (int rep = 0; rep < NREP(pb + 3); ++rep) phase_attention<l>(F, args); SEAM(pb + 3); }
        if (IN(pb + 4)) {
            constexpr int NOUT = (l == 0) ? WC_NOUT : WC_NOUT1;
            const int ge = (F.G % 8 == 0 && F.G > NOUT) ? NOUT : F.G;
            if (F.bid < ge) {
                DenseSched S; S.init(ntok, DM, DM, ge, F.bid, tok0, F.ws + WS_BTOUT + (size_t)l * DM * DM);
                for (int rep = NREP(pb + 4) - 1; rep >= 0; --rep) { EpiOut E{X, mod + 2 * DM, mod + 6 * DM + 2 * DM, rep ? (bf16_t*)(F.ws + WS_DUMMY + WS_X) : X};
                    pg8::gemm_phase<EpiOut, DenseSched, true>(F.lds, F.ws + WS_MIX, DM, S, E); }
            }
            wc_work(args, F.ws, F.lds, ctl, l * WC_CH_LAYER + WC_CH_GU, nullptr, 0u);
            SEAM(pb + 4);
        }
        if (IN(pb + 5)) { wc_work(args, F.ws, F.lds, ctl, l * WC_CH_LAYER + WC_CH_GU, nullptr, 0u); __syncthreads();
            for (int rep = NREP(pb + 5) - 1; rep >= 0; --rep) phase_router(F, args, l, tok0, ntok, rep); SEAM(pb + 5); }
        if (IN(pb + 6)) {
            moe_tables(F, ctl + CW_CNT + l * NEXP, ntok);
            const int ge = wc_geff(*(const LAS int*)(F.lds + LDS_STAGE + MS_NT) * 4, F.G), ge8 = ge >> 3;
            const bool gemm_wg = (ge == F.G) || (F.bid >> 3) < ge8;
            MoeSched<4, true> S; S.misc = F.lds + LDS_STAGE; S.G = ge; S.c = (ge == F.G) ? F.vcu : (F.bid & 7) * ge8 + (F.bid >> 3); S.RB = DM; S.tok0 = tok0;
            S.Bt = F.ws + WS_BTGU + (size_t)l * 65 * 1024 * DM; S.bstride = (size_t)1024 * DM; S.list = (const int*)(F.ws + WS_LIST);
            if (gemm_wg) {
                for (int rep = ((REP_PH == 18 || REP_PH == 8) ? 1 : 0); rep >= 0; --rep) { EpiUp E{F.ws + WS_H, (REP_PH == 18 && rep) ? 1 : 0};
                    pg8::gemm_phase<EpiUp, MoeSched<4, true>, true>(F.lds, F.ws + WS_A8, DM, S, E); }
                SIGNAL_DONE(2);
            } else if (WC_MASK & 4) wc_work(args, F.ws, F.lds, ctl, WC_CH_TOTAL, GEMM_DONE(2), (unsigned)ge);
            wc_work(args, F.ws, F.lds, ctl, (l + 1) * WC_CH_LAYER, nullptr, 0u);
            SEAM(pb + 6);
        }
        if (IN(pb + 7)) {
            moe_tables(F, ctl + CW_CNT + l * NEXP, ntok);
            const int ge = wc_geff(*(const LAS int*)(F.lds + LDS_STAGE + MS_NT) * 8, F.G), ge8 = ge >> 3;
            const bool gemm_wg = (ge == F.G) || (F.bid >> 3) < ge8;
            MoeSched<8, false> S; S.misc = F.lds + LDS_STAGE; S.G = ge; S.c = (ge == F.G) ? F.vcu : (F.bid & 7) * ge8 + (F.bid >> 3); S.RB = EH; S.tok0 = tok0;
            S.Bt = F.ws + WS_BTD + (size_t)l * 65 * DM * EH; S.bstride = (size_t)DM * EH; S.list = nullptr;
            if (gemm_wg) {
                for (int rep = ((REP_PH == 17 || REP_PH == 9) ? 1 : 0); rep >= 0; --rep) { EpiDown E{F.ws + WS_Y, (REP_PH == 17 && rep) ? 1 : 0};
                    pg8::gemm_phase<EpiDown, MoeSched<8, false>, true>(F.lds, F.ws + WS_H, EH, S, E); }
                SIGNAL_DONE(3);
            } else if (WC_MASK & 8) wc_work(args, F.ws, F.lds, ctl, WC_CH_TOTAL, GEMM_DONE(3), (unsigned)ge);
            SEAM(pb + 7);
        }
        if (IN(pb + 8)) {
            moe_tables(F, ctl + CW_CNT + l * NEXP, ntok);
            for (int rep = NREP(pb + 8) - 1; rep >= 0; --rep) phase_combine(F, args, l, tok0, ntok, rep);
            SEAM(pb + 8);
        }
    }
__global__ void __launch_bounds__(NTHREADS, 2) fwd(Args args) {
    extern __shared__ __attribute__((aligned(16))) unsigned char lds_raw[];
    Frame F; F.lds = (LAS unsigned char*)lds_raw; F.ws = args.ws;
    F.tid = threadIdx.x; F.lane = F.tid & 63; F.wave = __builtin_amdgcn_readfirstlane(F.tid >> 6); F.G = gridDim.x; F.bid = blockIdx.x;
    F.vcu = (F.G % 8 == 0) ? (F.bid % 8) * (F.G / 8) + F.bid / 8 : F.bid;
    unsigned* ctl = (unsigned*)(F.ws + WS_CTL);
    const int lo = args.ph_lo, hi = args.ph_hi;
#if !MK_PER_PHASE
    if (F.tid < 4) ((LAS unsigned*)(F.lds + LDS_STAGE))[F.tid] = 0u;
    __syncthreads();
    XcdBarrier bar = xcd_barrier_post(ctl + CW_BAR, (volatile LAS unsigned*)(F.lds + LDS_STAGE));
#endif
    if (IN(PH_PRO)) {
        const bool defer1 = PRO_DEFER && wc_geff((NTOK / 256) * (ZW / 256), F.G) < F.G;
        for (int rep = 0; rep < ((REP_PH == 11) ? 2 : 1); ++rep) mod_gemv(F, args.in[I_C], args.in[I_CCTX], args.in[I_WMOD], args.in[I_BMOD], (float*)(F.ws + WS_MOD), 0, defer1 ? 128 : 256, F.bid, F.G);
        small_tables(F, (float*)(F.ws + WS_ROPE), args.in[I_RW], (float*)(F.ws + WS_RWT));
        for (int rep = 0; rep < NREP(PH_PRO); ++rep) { convert_weights(F, args, 0, (defer1 && PRO_DEFER > 1) ? CVT_ITEMS / 2 : CVT_ITEMS, F.bid, F.G);
            }
        SEAM(PH_PRO);
    }
    if (IN(PH_N1)) { for (int rep = 0; rep < NREP(PH_N1); ++rep) phase_norm1(F, args); SEAM(PH_N1); }
    layer_phases<0>(F, args, ctl, lo, hi LP_BAR);
    layer_phases<1>(F, args, ctl, lo, hi LP_BAR);
#undef IN
#undef SEAM
}

extern "C" void kernel_launch(void* const* d_in, const int* in_sizes, int n_in, void* d_out, int out_size, void* d_ws, size_t ws_size, hipStream_t stream) {
    static int grid = 0;
    if (grid == 0) {
        if (n_in != 31 || out_size != SEQ * DM || ws_size < WS_END + (REP_PH >= 0 ? WS_DUMMY_BYTES : 0)) { fprintf(stderr, "kernel_launch: expected 31 inputs, out %d, ws >= %zu; got n_in %d out %d ws %zu\n", SEQ * DM, (size_t)WS_END, n_in, out_size, ws_size); grid = -1; return; }
        int dev = 0, cus = 0, per_cu = 0;
        if (hipGetDevice(&dev) != hipSuccess || hipDeviceGetAttribute(&cus, hipDeviceAttributeMultiprocessorCount, dev) != hipSuccess) { grid = -1; return; }
        if (hipFuncSetAttribute((const void*)fwd, hipFuncAttributeMaxDynamicSharedMemorySize, LDS_BYTES) != hipSuccess) { fprintf(stderr, "kernel_launch: hipFuncSetAttribute failed\n"); grid = -1; return; }
        if (hipOccupancyMaxActiveBlocksPerMultiprocessor(&per_cu, (const void*)fwd, NTHREADS, LDS_BYTES) != hipSuccess || per_cu < 1) fprintf(stderr, "kernel_launch: occupancy query says %d\n", per_cu);
        (void)hipGetLastError();
        grid = cus;
    }
    if (grid < 0) return;
    (void)hipMemsetAsync((char*)d_ws + WS_CTL, 0, CTL_BYTES, stream);
    Args a{};
    for (int i = 0; i < 31; ++i) a.in[i] = (const float*)d_in[i];
    a.out = (float*)d_out; a.ws = (unsigned char*)d_ws;
#if MK_PER_PHASE
    for (int p = 0; p < N_PHASES; ++p) { a.ph_lo = p; a.ph_hi = p + 1; hipLaunchKernelGGL(fwd, dim3(grid), dim3(NTHREADS), LDS_BYTES, stream, a); }
#else
    a.ph_lo = 0; a.ph_hi = N_PHASES;
    hipLaunchKernelGGL(fwd, dim3(grid), dim3(NTHREADS), LDS_BYTES, stream, a);
#endif
    const hipError_t le = hipPeekAtLastError();
    if (le != hipSuccess) fprintf(stderr, "kernel_launch: launch failed: %s\n", hipGetErrorName(le));
}
```
